# Optimizing an MI355X kernel written in HIP

```python
import math
import jax, jax.numpy as jnp
from jax import lax
import numpy as np

D_MODEL = 1024
BATCH = 8
SEQ = 2048
DEPTH = 1
DEC_BATCH = 128
DEC_SEQ = 8
PAST_LEN = 16384
PAGE_SIZE = 128

S5_WIDTH = D_MODEL // 2
S5_GROUP = 16
S5_GROUPS = S5_WIDTH // S5_GROUP
S5_STATE = 64
RWKV_WIDTH = D_MODEL - S5_WIDTH
RWKV_HEAD = 64
RWKV_HEADS = RWKV_WIDTH // RWKV_HEAD
W_LORA = 64
A_LORA = 64
G_LORA = 128
RWKV_COLS = 3 * RWKV_WIDTH + W_LORA + A_LORA + G_LORA
IN_COLS = S5_WIDTH + RWKV_COLS
PEER_HEADS = 8
N_KEYS = 128
N_EXPERTS = N_KEYS * N_KEYS
PEER_TOPK = 16
PEER_KEY_DIM = 128
PEER_HALF = PEER_KEY_DIM // 2
PEER_BLOCK = 128
NORM_EPS = 1e-6
GN_EPS = 64e-5

kernel_name = "hybrid_s5_rwkv7_peer_adaln_step"

F32 = jnp.float32


def rmsnorm(x, g):
    x32 = x.astype(F32)
    return x32 * lax.rsqrt(jnp.mean(x32 * x32, axis=-1, keepdims=True) + NORM_EPS) * g.astype(F32)


def s5_mixer(u, h_re0, h_im0, a_re, a_im, log_dt, b_re, b_im, c_re, c_im, d_skip, w_glu, b_glu):
    nb, T, _ = u.shape
    u32 = u.astype(F32)
    ug = u32.reshape(nb, T, S5_GROUPS, S5_GROUP)
    dt = jnp.exp(log_dt.astype(F32))[:, None]
    lam_re, lam_im = a_re.astype(F32), a_im.astype(F32)
    mag = jnp.exp(lam_re * dt)
    ang = lam_im * dt
    lb_re, lb_im = mag * jnp.cos(ang), mag * jnp.sin(ang)
    den = lam_re * lam_re + lam_im * lam_im
    n_re, n_im = lb_re - 1.0, lb_im
    coef_re = (n_re * lam_re + n_im * lam_im) / den
    coef_im = (n_im * lam_re - n_re * lam_im) / den
    b_re32, b_im32 = b_re.astype(F32), b_im.astype(F32)
    bb_re = coef_re[..., None] * b_re32 - coef_im[..., None] * b_im32
    bb_im = coef_re[..., None] * b_im32 + coef_im[..., None] * b_re32
    bu_re = jnp.einsum('btgh,gph->tbgp', ug, bb_re)
    bu_im = jnp.einsum('btgh,gph->tbgp', ug, bb_im)
    h_re0, h_im0 = h_re0.astype(F32), h_im0.astype(F32)
    bu_re = bu_re.at[0].add(lb_re * h_re0 - lb_im * h_im0)
    bu_im = bu_im.at[0].add(lb_re * h_im0 + lb_im * h_re0)
    a_re_t = jnp.broadcast_to(lb_re, (T, 1, S5_GROUPS, S5_STATE))
    a_im_t = jnp.broadcast_to(lb_im, (T, 1, S5_GROUPS, S5_STATE))

    def combine(left, right):
        ar1, ai1, br1, bi1 = left
        ar2, ai2, br2, bi2 = right
        return (ar2 * ar1 - ai2 * ai1, ar2 * ai1 + ai2 * ar1,
                ar2 * br1 - ai2 * bi1 + br2, ar2 * bi1 + ai2 * br1 + bi2)

    _, _, hs_re, hs_im = lax.associative_scan(combine, (a_re_t, a_im_t, bu_re, bu_im), axis=0)
    y = (jnp.einsum('ghp,tbgp->btgh', c_re.astype(F32), hs_re)
         - jnp.einsum('ghp,tbgp->btgh', c_im.astype(F32), hs_im))
    y = y.reshape(nb, T, S5_WIDTH) + d_skip.astype(F32) * u32
    y = jax.nn.gelu(y, approximate=False)
    y = y * jax.nn.sigmoid(y @ w_glu + b_glu)
    return y, hs_re[-1], hs_im[-1]


def rwkv7_mixer(p, shift0, S0, mu, w0, w2, a0, a2, g2, k_k, k_a, r_k, gn_w, gn_b):
    nb, T, _ = p.shape
    p = p.astype(F32)
    p_prev = jnp.concatenate([shift0.astype(F32)[:, None, :], p[:, :-1]], axis=1)
    ps = p + (p_prev - p) * mu.astype(F32)
    o1 = RWKV_WIDTH
    r, k, v, w_lo, a_lo, g_lo = jnp.split(
        ps, [o1, 2 * o1, 3 * o1, 3 * o1 + W_LORA, 3 * o1 + W_LORA + A_LORA], axis=-1)
    w_raw = -jax.nn.softplus(-(w0 + jnp.tanh(w_lo) @ w2)) - 0.5
    decay = jnp.exp(-jnp.exp(w_raw))
    a = jax.nn.sigmoid(a0 + a_lo @ a2)
    g = jax.nn.sigmoid(g_lo) @ g2

    def heads(t):
        return t.reshape(nb, T, RWKV_HEADS, RWKV_HEAD)

    kk = heads(k * k_k)
    kk = kk / jnp.maximum(jnp.linalg.norm(kk, axis=-1, keepdims=True), 1e-12)
    k = k * (1.0 + (a - 1.0) * k_a)
    r_h, w_h, k_h, v_h, a_h = heads(r), heads(decay), heads(k), heads(v), heads(a)

    def step(S, inp):
        r_t, w_t, k_t, v_t, kk_t, a_t = inp
        sa = jnp.einsum('bhvk,bhk->bhv', S, -kk_t)
        S = (S * w_t[:, :, None, :] + sa[..., None] * (kk_t * a_t)[:, :, None, :]
             + v_t[..., None] * k_t[:, :, None, :])
        return S, jnp.einsum('bhvk,bhk->bhv', S, r_t)

    xs = (jnp.swapaxes(r_h, 0, 1), jnp.swapaxes(w_h, 0, 1), jnp.swapaxes(k_h, 0, 1),
          jnp.swapaxes(v_h, 0, 1), jnp.swapaxes(kk, 0, 1), jnp.swapaxes(a_h, 0, 1))
    S_T, y = lax.scan(step, S0.astype(F32), xs)
    y = jnp.swapaxes(y, 0, 1)
    mean = jnp.mean(y, axis=-1, keepdims=True)
    var = jnp.mean(jnp.square(y - mean), axis=-1, keepdims=True)
    y = (y - mean) * lax.rsqrt(var + GN_EPS)
    y = y * gn_w.reshape(RWKV_HEADS, RWKV_HEAD) + gn_b.reshape(RWKV_HEADS, RWKV_HEAD)
    y = y + jnp.sum(r_h * k_h * r_k, axis=-1, keepdims=True) * v_h
    y = y.reshape(nb, T, RWKV_WIDTH) * g
    return y, S_T, p[:, -1]


def peer_ffn(h, w_q, keys1, keys2, u_tab, v_tab):
    T = h.shape[0]
    n_blk = -(-T // PEER_BLOCK)
    hb = jnp.pad(h, ((0, n_blk * PEER_BLOCK - T), (0, 0))).reshape(n_blk, PEER_BLOCK, D_MODEL)
    k1 = keys1.astype(F32)
    k2 = keys2.astype(F32)

    def block(xb):
        q = (xb @ w_q).astype(F32).reshape(PEER_BLOCK, PEER_HEADS, 2, PEER_HALF)
        s1 = jnp.einsum('thd,hnd->thn', q[:, :, 0], k1)
        s2 = jnp.einsum('thd,hnd->thn', q[:, :, 1], k2)
        v1, i1 = lax.top_k(s1, PEER_TOPK)
        v2, i2 = lax.top_k(s2, PEER_TOPK)
        cand = (v1[..., :, None] + v2[..., None, :]).reshape(PEER_BLOCK, PEER_HEADS, PEER_TOPK * PEER_TOPK)
        cidx = (i1[..., :, None] * N_KEYS + i2[..., None, :]).reshape(PEER_BLOCK, PEER_HEADS, PEER_TOPK * PEER_TOPK)
        sc, pos = lax.top_k(cand, PEER_TOPK)
        idx = jnp.take_along_axis(cidx, pos, axis=-1)
        gate = jax.nn.softmax(sc, axis=-1)
        act = jax.nn.gelu(jnp.einsum('thkd,td->thk', jnp.take(u_tab, idx, axis=0), xb), approximate=False)
        return jnp.einsum('thk,thkd->td', gate * act, jnp.take(v_tab, idx, axis=0))

    return lax.map(block, hb).reshape(n_blk * PEER_BLOCK, D_MODEL)[:T]


def hybrid_layer(x, c, s5_re, s5_im, wkv, shift, prm):
    nb, T, _ = x.shape
    mod = jax.nn.silu(c.astype(F32)) @ prm["w_ada"] + prm["b_ada"]
    sh1, sc1, ga1, sh2, sc2, ga2 = jnp.split(mod[:, None, :], 6, axis=-1)
    h = rmsnorm(x, prm["norm1_g"]) * (1.0 + sc1) + sh1
    proj = h @ prm["w_in"]
    y_s5, s5_re, s5_im = s5_mixer(proj[..., :S5_WIDTH], s5_re, s5_im, prm["s5_a_re"], prm["s5_a_im"],
                                  prm["s5_log_dt"], prm["s5_b_re"], prm["s5_b_im"], prm["s5_c_re"],
                                  prm["s5_c_im"], prm["s5_d"], prm["w_glu"], prm["b_glu"])
    y_rw, wkv, shift = rwkv7_mixer(proj[..., S5_WIDTH:], shift, wkv, prm["rwkv_mu"], prm["rwkv_w0"],
                                   prm["rwkv_w2"], prm["rwkv_a0"], prm["rwkv_a2"], prm["rwkv_g2"],
                                   prm["rwkv_k_k"], prm["rwkv_k_a"], prm["rwkv_r_k"],
                                   prm["rwkv_gn_w"], prm["rwkv_gn_b"])
    x = x + ga1 * (jnp.concatenate([y_s5, y_rw], axis=-1) @ prm["w_out"])
    h = rmsnorm(x, prm["norm2_g"]) * (1.0 + sc2) + sh2
    ff = peer_ffn(h.reshape(nb * T, D_MODEL), prm["peer_w_q"], prm["peer_keys1"], prm["peer_keys2"],
                  prm["peer_u"], prm["peer_v"]).reshape(nb, T, D_MODEL)
    x = x + ga2 * ff
    return x, s5_re, s5_im, wkv, shift


def setup_inputs(seed: int = 0) -> dict:
    key = jax.random.key(seed)
    ks = iter(jax.random.split(key, 48))

    def nrm(shape, scale):
        return scale * jax.random.normal(next(ks), shape, F32)

    L = DEPTH
    d = D_MODEL
    a_im = jnp.broadcast_to(jnp.pi * jnp.arange(S5_STATE, dtype=F32), (L, S5_GROUPS, S5_STATE))
    return {
        "x_prompt": nrm((BATCH, SEQ, d), 1.0),
        "x_sample": nrm((DEC_BATCH, DEC_SEQ, d), 1.0),
        "state_s5_re": nrm((L, DEC_BATCH, S5_GROUPS, S5_STATE), 0.1),
        "state_s5_im": nrm((L, DEC_BATCH, S5_GROUPS, S5_STATE), 0.1),
        "state_wkv": nrm((L, DEC_BATCH, RWKV_HEADS, RWKV_HEAD, RWKV_HEAD), 0.1),
        "state_shift": nrm((L, DEC_BATCH, RWKV_COLS), 1.0),
        "c_prompt": nrm((BATCH, d), 1.0),
        "c_sample": nrm((DEC_BATCH, d), 1.0),
        "w_ada": nrm((L, d, 6 * d), 0.5 * d ** -0.5),
        "b_ada": nrm((L, 6 * d), 0.01),
        "norm1_g": 1.0 + nrm((L, d), 0.02),
        "norm2_g": 1.0 + nrm((L, d), 0.02),
        "w_in": nrm((L, d, IN_COLS), d ** -0.5),
        "w_out": nrm((L, S5_WIDTH + RWKV_WIDTH, d), (S5_WIDTH + RWKV_WIDTH) ** -0.5),
        "s5_a_re": -0.5 + nrm((L, S5_GROUPS, S5_STATE), 0.01),
        "s5_a_im": a_im + nrm((L, S5_GROUPS, S5_STATE), 0.01),
        "s5_log_dt": jax.random.uniform(next(ks), (L, S5_GROUPS), F32, math.log(1e-3), math.log(1e-1)),
        "s5_b_re": nrm((L, S5_GROUPS, S5_STATE, S5_GROUP), (2 * S5_GROUP) ** -0.5),
        "s5_b_im": nrm((L, S5_GROUPS, S5_STATE, S5_GROUP), (2 * S5_GROUP) ** -0.5),
        "s5_c_re": nrm((L, S5_GROUPS, S5_GROUP, S5_STATE), S5_STATE ** -0.5),
        "s5_c_im": nrm((L, S5_GROUPS, S5_GROUP, S5_STATE), S5_STATE ** -0.5),
        "s5_d": nrm((L, S5_WIDTH), 1.0),
        "w_glu": nrm((L, S5_WIDTH, S5_WIDTH), S5_WIDTH ** -0.5),
        "b_glu": nrm((L, S5_WIDTH), 0.01),
        "rwkv_mu": jax.random.uniform(next(ks), (L, RWKV_COLS), F32, 0.0, 1.0),
        "rwkv_w0": jax.random.uniform(next(ks), (L, RWKV_WIDTH), F32, -6.0, -1.0),
        "rwkv_w2": nrm((L, W_LORA, RWKV_WIDTH), 0.1),
        "rwkv_a0": nrm((L, RWKV_WIDTH), 0.1),
        "rwkv_a2": nrm((L, A_LORA, RWKV_WIDTH), 0.1),
        "rwkv_g2": nrm((L, G_LORA, RWKV_WIDTH), G_LORA ** -0.5),
        "rwkv_k_k": 0.85 + nrm((L, RWKV_WIDTH), 0.05),
        "rwkv_k_a": 1.0 + nrm((L, RWKV_WIDTH), 0.05),
        "rwkv_r_k": nrm((L, RWKV_HEADS, RWKV_HEAD), 0.1),
        "rwkv_gn_w": 1.0 + nrm((L, RWKV_WIDTH), 0.02),
        "rwkv_gn_b": nrm((L, RWKV_WIDTH), 0.01),
        "peer_w_q": nrm((L, d, PEER_HEADS * PEER_KEY_DIM), d ** -0.5),
        "peer_keys1": nrm((L, PEER_HEADS, N_KEYS, PEER_HALF), PEER_HALF ** -0.5),
        "peer_keys2": nrm((L, PEER_HEADS, N_KEYS, PEER_HALF), PEER_HALF ** -0.5),
        "peer_u": nrm((L, N_EXPERTS, d), d ** -0.5),
        "peer_v": nrm((L, N_EXPERTS, d), 0.3),
        "final_norm_g": 1.0 + nrm((d,), 0.02),
    }


def reference(x_prompt, x_sample, state_s5_re, state_s5_im, state_wkv, state_shift, c_prompt, c_sample,
              w_ada, b_ada, norm1_g, norm2_g, w_in, w_out, s5_a_re, s5_a_im, s5_log_dt, s5_b_re, s5_b_im,
              s5_c_re, s5_c_im, s5_d, w_glu, b_glu, rwkv_mu, rwkv_w0, rwkv_w2, rwkv_a0, rwkv_a2, rwkv_g2,
              rwkv_k_k, rwkv_k_a, rwkv_r_k, rwkv_gn_w, rwkv_gn_b, peer_w_q, peer_keys1, peer_keys2,
              peer_u, peer_v, final_norm_g):
    nbp = x_prompt.shape[0]
    hp = x_prompt.astype(F32)
    hs = x_sample.astype(F32)
    p_re_l, p_im_l, p_wkv_l, p_sh_l = [], [], [], []
    s_re_l, s_im_l, s_wkv_l, s_sh_l = [], [], [], []
    for l in range(DEPTH):
        prm = {
            "w_ada": w_ada[l], "b_ada": b_ada[l], "norm1_g": norm1_g[l], "norm2_g": norm2_g[l],
            "w_in": w_in[l], "w_out": w_out[l], "s5_a_re": s5_a_re[l], "s5_a_im": s5_a_im[l],
            "s5_log_dt": s5_log_dt[l], "s5_b_re": s5_b_re[l], "s5_b_im": s5_b_im[l],
            "s5_c_re": s5_c_re[l], "s5_c_im": s5_c_im[l], "s5_d": s5_d[l], "w_glu": w_glu[l],
            "b_glu": b_glu[l], "rwkv_mu": rwkv_mu[l], "rwkv_w0": rwkv_w0[l], "rwkv_w2": rwkv_w2[l],
            "rwkv_a0": rwkv_a0[l], "rwkv_a2": rwkv_a2[l], "rwkv_g2": rwkv_g2[l],
            "rwkv_k_k": rwkv_k_k[l], "rwkv_k_a": rwkv_k_a[l], "rwkv_r_k": rwkv_r_k[l],
            "rwkv_gn_w": rwkv_gn_w[l], "rwkv_gn_b": rwkv_gn_b[l], "peer_w_q": peer_w_q[l],
            "peer_keys1": peer_keys1[l], "peer_keys2": peer_keys2[l], "peer_u": peer_u[l],
            "peer_v": peer_v[l],
        }
        z_s5 = jnp.zeros((nbp, S5_GROUPS, S5_STATE), F32)
        z_wkv = jnp.zeros((nbp, RWKV_HEADS, RWKV_HEAD, RWKV_HEAD), F32)
        z_sh = jnp.zeros((nbp, RWKV_COLS), F32)
        hp, pr, pi, pw, psh = hybrid_layer(hp, c_prompt, z_s5, z_s5, z_wkv, z_sh, prm)
        hs, sr, si, sw, ssh = hybrid_layer(hs, c_sample, state_s5_re[l], state_s5_im[l], state_wkv[l],
                                           state_shift[l], prm)
        p_re_l.append(pr); p_im_l.append(pi); p_wkv_l.append(pw); p_sh_l.append(psh)
        s_re_l.append(sr); s_im_l.append(si); s_wkv_l.append(sw); s_sh_l.append(ssh)
    y_prompt = rmsnorm(hp, final_norm_g).astype(x_prompt.dtype)
    y_sample = rmsnorm(hs, final_norm_g).astype(x_sample.dtype)
    s5_re_prompt = jnp.stack(p_re_l)
    s5_im_prompt = jnp.stack(p_im_l)
    wkv_prompt = jnp.stack(p_wkv_l)
    shift_prompt = jnp.stack(p_sh_l)
    s5_re_sample = jnp.stack(s_re_l)
    s5_im_sample = jnp.stack(s_im_l)
    wkv_sample = jnp.stack(s_wkv_l)
    shift_sample = jnp.stack(s_sh_l)
    return (y_prompt, y_sample, s5_re_prompt, s5_im_prompt, wkv_prompt, shift_prompt,
            s5_re_sample, s5_im_sample, wkv_sample, shift_sample)
```

```cpp
#include <hip/hip_runtime.h>
#include <hip/hip_cooperative_groups.h>
#include <stdint.h>
#include <stdio.h>
#include <string.h>
namespace cg = cooperative_groups;

#ifndef MULTI
#define MULTI 0
#endif
#ifndef DUP
#define DUP -1
#endif

typedef unsigned short bfu;
using bf16x8 = __attribute__((ext_vector_type(8))) short;
using f32x16 = __attribute__((ext_vector_type(16))) float;

constexpr int NTOK = 17408, NPT = 16384, NSQ = 136, DM = 1024, INC = 2304, RC = 1792;
constexpr int O_S5RE_P = 17825792, O_S5IM_P = 17842176, O_WKV_P = 17858560, O_SH_P = 18120704;
constexpr int O_S5RE_S = 18135040, O_S5IM_S = 18397184, O_WKV_S = 18659328, O_SH_S = 22853632;
constexpr float NORM_EPS = 1e-6f, GN_EPS = 64e-5f;
constexpr int NT = 256;
constexpr int LDS_BYTES = 75776;
constexpr int LDS_JOB = LDS_BYTES - 16;

struct Params {
  const float *xp, *xs, *s5re0, *s5im0, *wkv0, *shift0, *cp, *cs, *w_ada, *b_ada, *n1g, *n2g, *w_in, *w_out;
  const float *s5are, *s5aim, *s5ldt, *s5bre, *s5bim, *s5cre, *s5cim, *s5d, *w_glu, *b_glu;
  const float *mu, *w0, *w2, *a0, *a2, *g2, *k_k, *k_a, *r_k, *gn_w, *gn_b, *w_q, *keys1, *keys2, *pu, *pv, *fng;
  float* out;
  unsigned char *TU, *TV; float *SU, *SV;
  bfu *WinT, *WoutT, *WqT, *WgluT, *K1, *K2;
  float *mod, *rs1, *lbre, *lbim, *lbLre, *lbLim, *BBre, *BBim;
  bfu* PJ; float* X1; bfu *LD, *AA, *GG; float* Y5; bfu *Q, *H2; unsigned* EI; float* EG; float* BON; float* BONX; bfu *H1, *CAT; bfu *w2T, *a2T, *g2T, *BBh, *CCh; float* E;
  unsigned* bar;
  int never; int pad_;
};

__device__ __forceinline__ bfu f2bf(float f) { unsigned u = __float_as_uint(f); u += 0x7fffu + ((u >> 16) & 1u); return (bfu)(u >> 16); }
__device__ __forceinline__ float bf2f(bfu h) { return __uint_as_float(((unsigned)h) << 16); }
__device__ __forceinline__ unsigned pk2(float a, float b) { return (unsigned)f2bf(a) | ((unsigned)f2bf(b) << 16); }
__device__ __forceinline__ float bflo(unsigned u) { return __uint_as_float(u << 16); }
__device__ __forceinline__ float bfhi(unsigned u) { return __uint_as_float(u & 0xffff0000u); }
__device__ __forceinline__ int sq_of(int tok) { return tok < NPT ? (tok >> 11) : 8 + ((tok - NPT) >> 3); }
__device__ __forceinline__ int t_of(int tok) { return tok < NPT ? (tok & 2047) : ((tok - NPT) & 7); }
__device__ __forceinline__ const float* xrow(const Params& p, int tok) { return tok < NPT ? p.xp + (size_t)tok * DM : p.xs + (size_t)(tok - NPT) * DM; }
__device__ __forceinline__ float sigmoidf_(float x) { return 1.f / (1.f + __expf(-x)); }
__device__ __forceinline__ float gelu_(float x) { return 0.5f * x * (1.f + erff(x * 0.70710678118654752f)); }

#define XB_TMO 128
#define XB_XCNT(j) (256 + 64 * (j))
#define XB_XSUB(j) (1280 + 64 * (j))
#define XB_XGEN(j) (2304 + 64 * (j))
#define XB_TOP 3328
#define XB_TOPGEN 3392
#define XCD_BAR_WORDS 3456
#define XB_SPIN_CAP (1u << 22)
#define LAS __attribute__((address_space(3)))
__device__ __forceinline__ unsigned xb_ld(unsigned* p) { return __hip_atomic_load(p, __ATOMIC_RELAXED, __HIP_MEMORY_SCOPE_AGENT); }
__device__ __forceinline__ unsigned xb_add(unsigned* p, unsigned v) { return __hip_atomic_fetch_add(p, v, __ATOMIC_RELAXED, __HIP_MEMORY_SCOPE_AGENT); }
__device__ __forceinline__ unsigned xb_xcc_id() { return (unsigned)__builtin_amdgcn_s_getreg((3 << 11) | 20) & 0xFu; }
#define XB_SPIN(cond, bar) do { unsigned _sp = 0; while (cond) { __builtin_amdgcn_s_sleep(1); \
    if ((++_sp & 255u) == 0u) { if (xb_ld(&(bar)[XB_TMO])) break; if (_sp > XB_SPIN_CAP) { atomicAdd(&(bar)[XB_TMO], 1u); break; } } } } while (0)
struct XcdBarrier { unsigned* bar; unsigned x; volatile unsigned* st; };
__device__ __forceinline__ XcdBarrier xcd_barrier_post(unsigned* bar, volatile unsigned* st) {
  XcdBarrier b; b.bar = bar; b.x = xb_xcc_id(); b.st = st;
  if (threadIdx.x == 0) (void)xb_add(&bar[XB_XCNT(b.x)], 1u);
  return b;
}
__device__ __forceinline__ void xcd_barrier_complete(unsigned* bar, unsigned x, unsigned& nloc, unsigned& nx) {
  const unsigned G = gridDim.x;
  unsigned sum, cnt, mine, sp = 0u;
  for (;;) {
    sum = 0u; cnt = 0u; mine = 0u;
#pragma unroll
    for (unsigned j = 0; j < 16; ++j) { const unsigned c = xb_ld(&bar[XB_XCNT(j)]); sum += c; cnt += (c > 0u) ? 1u : 0u; mine = (j == x) ? c : mine; }
    if (sum == G) break;
    __builtin_amdgcn_s_sleep(1);
    if ((++sp & 255u) == 0u) { if (xb_ld(&bar[XB_TMO])) break; if (sp > XB_SPIN_CAP) { atomicAdd(&bar[XB_TMO], 1u); break; } }
  }
  nloc = mine > 0u ? mine : 1u; nx = cnt > 0u ? cnt : 1u;
}
__device__ __forceinline__ void xcd_barrier(const XcdBarrier& b) {
  asm volatile("s_waitcnt vmcnt(0)" ::: "memory");
  __syncthreads();
  if (threadIdx.x == 0) {
    unsigned* bar = b.bar;
    __builtin_amdgcn_s_waitcnt(0);
    unsigned nloc = b.st[0], nx = b.st[1];
    if (nloc == 0u) { xcd_barrier_complete(bar, b.x, nloc, nx); b.st[0] = nloc; b.st[1] = nx; }
    const unsigned old = xb_add(&bar[XB_XSUB(b.x)], 1u);
    const unsigned gen = old / nloc;
    if (old + 1u == (gen + 1u) * nloc) {
      __builtin_amdgcn_fence(__ATOMIC_RELEASE, "agent");
      asm volatile("s_waitcnt vmcnt(0)" ::: "memory");
      const unsigned og = xb_add(&bar[XB_TOP], 1u);
      const unsigned tg = og / nx;
      if (og + 1u == (tg + 1u) * nx) xb_add(&bar[XB_TOPGEN], 1u);
      else XB_SPIN(xb_ld(&bar[XB_TOPGEN]) == tg, bar);
      __builtin_amdgcn_fence(__ATOMIC_ACQUIRE, "agent");
      xb_add(&bar[XB_XGEN(b.x)], 1u);
      asm volatile("s_waitcnt vmcnt(0)" ::: "memory");
    } else {
      XB_SPIN(xb_ld(&bar[XB_XGEN(b.x)]) == gen, bar);
      __builtin_amdgcn_fence(__ATOMIC_ACQUIRE, "agent");
      asm volatile("s_waitcnt vmcnt(0)" ::: "memory");
    }
  }
  __syncthreads();
}

struct U4x4 { uint4 a, b, c, d; };
constexpr int GLD = 144;
template <class AL, class EP>
__device__ __forceinline__ void gemm_tile(int m0, int n0, int K, const bfu* __restrict__ Bt, AL al, EP ep, unsigned char* lds) {
  constexpr int BUF = 256 * GLD;
  const int tid = threadIdx.x, lane = tid & 63, wid = tid >> 6;
  const int wr = wid >> 1, wc = wid & 1;
  const int l31 = lane & 31, lh = lane >> 5;
  f32x16 acc[2][2];
#pragma unroll
  for (int i = 0; i < 2; ++i)
#pragma unroll
    for (int j = 0; j < 2; ++j)
#pragma unroll
      for (int r = 0; r < 16; ++r) acc[i][j][r] = 0.f;
  const int srow = tid >> 1, sk = (tid & 1) * 32;
  uint4 av0, av1, av2, av3, bv0, bv1, bv2, bv3;
  auto gl = [&](int k0) {
    al(m0 + srow, k0 + sk, av0, av1, av2, av3);
    const uint4* bp = (const uint4*)(Bt + (size_t)(n0 + srow) * K + k0 + sk);
    bv0 = bp[0]; bv1 = bp[1]; bv2 = bp[2]; bv3 = bp[3];
  };
  auto st = [&](int buf) {
    uint4* da = (uint4*)(lds + buf * BUF + srow * GLD + sk * 2);
    uint4* db = (uint4*)(lds + buf * BUF + 128 * GLD + srow * GLD + sk * 2);
    da[0] = av0; da[1] = av1; da[2] = av2; da[3] = av3;
    db[0] = bv0; db[1] = bv1; db[2] = bv2; db[3] = bv3;
  };
  gl(0);
  __syncthreads();
  st(0);
  if (64 < K) gl(64);
  __syncthreads();
  const int nk = K >> 6;
  for (int kt = 0; kt < nk; ++kt) {
    const unsigned char* ldsA = lds + (kt & 1) * BUF;
    const unsigned char* ldsB = ldsA + 128 * GLD;
    if (kt + 1 < nk) st((kt + 1) & 1);
    if (kt + 2 < nk) gl((kt + 2) * 64);
#pragma unroll
    for (int s = 0; s < 4; ++s) {
      const bf16x8 af0 = *(const bf16x8*)(ldsA + (wr * 64 + l31) * GLD + s * 32 + lh * 16);
      const bf16x8 af1 = *(const bf16x8*)(ldsA + (wr * 64 + 32 + l31) * GLD + s * 32 + lh * 16);
      const bf16x8 bf0 = *(const bf16x8*)(ldsB + (wc * 64 + l31) * GLD + s * 32 + lh * 16);
      const bf16x8 bf1 = *(const bf16x8*)(ldsB + (wc * 64 + 32 + l31) * GLD + s * 32 + lh * 16);
      acc[0][0] = __builtin_amdgcn_mfma_f32_32x32x16_bf16(af0, bf0, acc[0][0], 0, 0, 0);
      acc[0][1] = __builtin_amdgcn_mfma_f32_32x32x16_bf16(af0, bf1, acc[0][1], 0, 0, 0);
      acc[1][0] = __builtin_amdgcn_mfma_f32_32x32x16_bf16(af1, bf0, acc[1][0], 0, 0, 0);
      acc[1][1] = __builtin_amdgcn_mfma_f32_32x32x16_bf16(af1, bf1, acc[1][1], 0, 0, 0);
    }
    __syncthreads();
  }
  {
    float* ct = (float*)lds;
#pragma unroll
    for (int i = 0; i < 2; ++i)
#pragma unroll
      for (int j = 0; j < 2; ++j)
#pragma unroll
        for (int r = 0; r < 16; ++r)
          ct[(wr * 64 + i * 32 + (r & 3) + 8 * (r >> 2) + 4 * lh) * 132 + wc * 64 + j * 32 + l31] = acc[i][j][r];
    __syncthreads();
#pragma unroll 4
    for (int it = 0; it < 16; ++it) {
      const int idx = it * NT + tid, rl = idx >> 5, c4 = (idx & 31) * 4;
      ep(m0 + rl, n0 + c4, *(const float4*)(ct + rl * 132 + c4));
    }
  }
  __syncthreads();
}

__device__ void phase0(const Params& p, unsigned char* lds) {
  const int tid = threadIdx.x, G = gridDim.x, gtid = blockIdx.x * NT + tid, gsz = G * NT;
  {
    const int lane = tid & 63, l31 = lane & 31, gw = gtid >> 6, nw = gsz >> 6;
    for (int rp = gw; rp < 16384; rp += nw) {
      const int r = rp * 2 + (lane >> 5);
      const bool isv = r >= 16384;
      const int row = r & 16383;
      const float4* src = (const float4*)((isv ? p.pv : p.pu) + (size_t)row * 1024 + l31 * 4);
      float x[32];
#pragma unroll
      for (int i = 0; i < 8; ++i) { const float4 v = src[i * 32]; x[i * 4] = v.x; x[i * 4 + 1] = v.y; x[i * 4 + 2] = v.z; x[i * 4 + 3] = v.w; }
      float m = 0.f;
#pragma unroll
      for (int i = 0; i < 32; ++i) m = fmaxf(m, fabsf(x[i]));
#pragma unroll
      for (int o = 16; o > 0; o >>= 1) m = fmaxf(m, __shfl_xor(m, o));
      const float sc = m > 0.f ? 7.5f / m : 1.f;
      unsigned long long w0 = 0ull, w1 = 0ull, w2 = 0ull;
#pragma unroll
      for (int i = 0; i < 32; ++i) {
        const float a_ = fminf(fabsf(x[i]) * sc, 7.5f);
        int code;
        if (a_ < 2.f) code = __float2int_rn(a_ * 8.f);
        else if (a_ < 4.f) code = 8 + __float2int_rn(a_ * 4.f);
        else code = 16 + __float2int_rn(a_ * 2.f);
        code = min(code, 31);
        const unsigned long long c6 = (unsigned long long)((unsigned)code | (x[i] < 0.f ? 32u : 0u));
        const int bit = 6 * i, wi = bit >> 6, sh = bit & 63;
        if (wi == 0) w0 |= c6 << sh; else if (wi == 1) w1 |= c6 << sh; else w2 |= c6 << sh;
        if (sh > 58) { if (wi == 0) w1 |= c6 >> (64 - sh); else if (wi == 1) w2 |= c6 >> (64 - sh); }
      }
      unsigned char* dst = (isv ? p.TV : p.TU) + (size_t)row * 768;
      *(uint4*)(dst + l31 * 16) = make_uint4((unsigned)w0, (unsigned)(w0 >> 32), (unsigned)w1, (unsigned)(w1 >> 32));
      *(uint2*)(dst + 512 + l31 * 8) = make_uint2((unsigned)w2, (unsigned)(w2 >> 32));
      if (l31 == 0) (isv ? p.SV : p.SU)[row] = m > 0.f ? m * (1.f / 7.5f) : 1.f;
    }
  }
  for (int i = gtid; i < 65536; i += gsz) { p.K1[i] = f2bf(p.keys1[i]); p.K2[i] = f2bf(p.keys2[i]); }
  {
    auto tr = [&](const float* __restrict__ src, bfu* __restrict__ dst, const int K, const int N) {
      for (int i = gtid; i < N * (K / 8); i += gsz) {
        const int n = i % N, k8 = i / N;
        float v[8];
#pragma unroll
        for (int j = 0; j < 8; ++j) v[j] = src[(size_t)(k8 * 8 + j) * N + n];
        *(uint4*)(dst + (size_t)n * K + k8 * 8) = make_uint4(pk2(v[0], v[1]), pk2(v[2], v[3]), pk2(v[4], v[5]), pk2(v[6], v[7]));
      }
    };
    tr(p.w_in, p.WinT, 1024, 2304);
    tr(p.w_out, p.WoutT, 1024, 1024);
    tr(p.w_q, p.WqT, 1024, 1024);
    tr(p.w_glu, p.WgluT, 512, 512);
    tr(p.w2, p.w2T, 64, 512);
    tr(p.a2, p.a2T, 64, 512);
    tr(p.g2, p.g2T, 128, 512);
  }
  for (int i = gtid; i < 2048; i += gsz) {
    const int g = i >> 6;
    const float dt = expf(p.s5ldt[g]);
    const float lre = p.s5are[i], lim = p.s5aim[i];
    const float mag = expf(lre * dt), ang = lim * dt;
    float sn, cs; sincosf(ang, &sn, &cs);
    const float lbr = mag * cs, lbi = mag * sn;
    p.lbre[i] = lbr; p.lbim[i] = lbi;
    float pr = lbr, pi = lbi;
#pragma unroll
    for (int s = 0; s < 6; ++s) { const float nr = pr * pr - pi * pi, ni = 2.f * pr * pi; pr = nr; pi = ni; }
    p.lbLre[i] = pr; p.lbLim[i] = pi;
    const float den = lre * lre + lim * lim;
    const float nre = lbr - 1.f, nim = lbi;
    const float cr = (nre * lre + nim * lim) / den, ci = (nim * lre - nre * lim) / den;
#pragma unroll
    for (int h = 0; h < 16; ++h) {
      const float br = p.s5bre[i * 16 + h], bi = p.s5bim[i * 16 + h];
      p.BBh[(g * 128 + (i & 63)) * 16 + h] = f2bf(cr * br - ci * bi);
      p.BBh[(g * 128 + 64 + (i & 63)) * 16 + h] = f2bf(cr * bi + ci * br);
    }
  }
  for (int i = gtid; i < 32 * 16 * 64; i += gsz) {
    const int gh = i >> 6, k = i & 63;
    p.CCh[gh * 128 + k] = f2bf(p.s5cre[i]);
    p.CCh[gh * 128 + 64 + k] = f2bf(-p.s5cim[i]);
  }
  {
    float* sc = (float*)lds;
    for (int it = blockIdx.x; it < 17 * 24 * 4; it += G) {
      const int kp = it & 3, slab = (it >> 2) % 24, sg = (it >> 2) / 24;
      __syncthreads();
      for (int i = tid; i < 8 * 256; i += NT) {
        const int sq = sg * 8 + (i >> 8), k = kp * 256 + (i & 255);
        const float c = sq < 8 ? p.cp[sq * 1024 + k] : p.cs[(sq - 8) * 1024 + k];
        sc[i] = c / (1.f + __expf(-c));
      }
      __syncthreads();
      const int col = slab * 256 + tid;
      float acc[8];
#pragma unroll
      for (int i = 0; i < 8; ++i) acc[i] = 0.f;
      const float* wp = p.w_ada + (size_t)(kp * 256) * 6144 + col;
#pragma unroll 4
      for (int k = 0; k < 256; k += 4) {
        float w[4];
#pragma unroll
        for (int j = 0; j < 4; ++j) w[j] = wp[(size_t)(k + j) * 6144];
#pragma unroll
        for (int i = 0; i < 8; ++i) {
          const float4 s4 = *(const float4*)(sc + i * 256 + k);
          acc[i] += s4.x * w[0] + s4.y * w[1] + s4.z * w[2] + s4.w * w[3];
        }
      }
      const float bb = kp == 0 ? p.b_ada[col] : 0.f;
#pragma unroll
      for (int i = 0; i < 8; ++i) atomicAdd(&p.mod[(size_t)(sg * 8 + i) * 6144 + col], acc[i] + bb);
    }
    __syncthreads();
  }
}

__device__ void phase1(const Params& p, unsigned char* lds) {
  const int ntile = 136 * 18;
  for (int t = blockIdx.x; t < ntile; t += gridDim.x) {
    const int mt = t / 18, nt = t % 18;
    auto al = [&](int row, int k, uint4& o0, uint4& o1, uint4& o2, uint4& o3) {
      const uint4* s_ = (const uint4*)(p.H1 + (size_t)row * 1024 + k);
      o0 = s_[0]; o1 = s_[1]; o2 = s_[2]; o3 = s_[3];
    };
    auto ep = [&](int row, int col, float4 v) {
      *(uint2*)(p.PJ + (size_t)row * INC + col) = make_uint2(pk2(v.x, v.y), pk2(v.z, v.w));
      if (col >= 512) {
        if (row < NPT) { if ((row & 2047) == 2047) *(float4*)(p.out + O_SH_P + (row >> 11) * RC + col - 512) = v; }
        else { const int r = row - NPT; if ((r & 7) == 7) *(float4*)(p.out + O_SH_S + (r >> 3) * RC + col - 512) = v; }
      }
    };
    gemm_tile(mt * 128, nt * 128, 1024, p.WinT, al, ep, lds);
  }
}

struct Cx { float r, i; };
__device__ __forceinline__ Cx cfma(const Cx a, const Cx b, const Cx c) { Cx o; o.r = a.r * b.r - a.i * b.i + c.r; o.i = a.r * b.i + a.i * b.r + c.i; return o; }
using f32x4 = __attribute__((ext_vector_type(4))) float;
constexpr int HIMG = 272;
template <int MT, bool OUT>
__device__ __forceinline__ void s5_chunk(const Params& p, const int tok0, const int nvalid, const int g, Cx (&st)[2], const int Gend,
                                         unsigned char* himg, const int lane) {
  const int c = lane & 31, half = lane >> 5;
  Cx l1[2], l2[2], l3[2], l4[2];
#pragma unroll
  for (int s = 0; s < 2; ++s) {
    const int gp = g * 64 + 32 * s + c;
    l1[s].r = p.lbre[gp]; l1[s].i = p.lbim[gp];
    const Cx z = {0.f, 0.f};
    l2[s] = cfma(l1[s], l1[s], z); l3[s] = cfma(l2[s], l1[s], z); l4[s] = cfma(l2[s], l2[s], z);
  }
  bf16x8 bfr[4];
#pragma unroll
  for (int nt = 0; nt < 4; ++nt) bfr[nt] = *(const bf16x8*)(p.BBh + ((size_t)(g * 128 + 32 * nt + c)) * 16 + 8 * half);
  bf16x8 cfr[4];
  float dsk = 0.f;
  if (OUT) {
#pragma unroll
    for (int ks = 0; ks < 4; ++ks) cfr[ks] = *(const bf16x8*)(p.CCh + ((size_t)(g * 16 + (lane & 15))) * 128 + 32 * ks + 8 * (lane >> 4));
    dsk = p.s5d[g * 16 + (lane & 15)];
  }
  Cx endst[2] = {st[0], st[1]};
#pragma unroll
  for (int mt = 0; mt < MT; ++mt) {
    bf16x8 af;
#pragma unroll
    for (int j = 0; j < 8; ++j) af[j] = 0;
    if (32 * mt + c < nvalid) af = *(const bf16x8*)(p.PJ + (size_t)(tok0 + 32 * mt + c) * INC + g * 16 + 8 * half);
#pragma unroll
    for (int s = 0; s < 2; ++s) {
      f32x16 bre, bim;
#pragma unroll
      for (int r = 0; r < 16; ++r) { bre[r] = 0.f; bim[r] = 0.f; }
      bre = __builtin_amdgcn_mfma_f32_32x32x16_bf16(af, bfr[s], bre, 0, 0, 0);
      bim = __builtin_amdgcn_mfma_f32_32x32x16_bf16(af, bfr[2 + s], bim, 0, 0, 0);
      Cx e[4], pe[4];
#pragma unroll
      for (int q = 0; q < 4; ++q) {
        Cx x; x.r = bre[4 * q]; x.i = bim[4 * q];
#pragma unroll
        for (int i = 1; i < 4; ++i) { Cx b_; b_.r = bre[4 * q + i]; b_.i = bim[4 * q + i]; x = cfma(l1[s], x, b_); bre[4 * q + i] = x.r; bim[4 * q + i] = x.i; }
        e[q] = x;
      }
#pragma unroll
      for (int q = 0; q < 4; ++q) { pe[q].r = __shfl_xor(e[q].r, 32); pe[q].i = __shfl_xor(e[q].i, 32); }
      Cx carry = st[s];
      Cx cin[4];
#pragma unroll
      for (int q = 0; q < 4; ++q) {
        const Cx ee = half ? pe[q] : e[q];
        const Cx eo = half ? e[q] : pe[q];
        const Cx cin_e = carry;
        carry = cfma(l4[s], carry, ee);
        if (8 * mt + 2 * q == Gend) endst[s] = carry;
        const Cx cin_o = carry;
        carry = cfma(l4[s], carry, eo);
        if (8 * mt + 2 * q + 1 == Gend) endst[s] = carry;
        cin[q] = half ? cin_o : cin_e;
      }
      st[s] = carry;
      if (OUT) {
        bfu* hi16 = (bfu*)himg;
#pragma unroll
        for (int q = 0; q < 4; ++q)
#pragma unroll
          for (int i = 0; i < 4; ++i) {
            const Cx lp = i == 0 ? l1[s] : (i == 1 ? l2[s] : (i == 2 ? l3[s] : l4[s]));
            Cx b_; b_.r = bre[4 * q + i]; b_.i = bim[4 * q + i];
            const Cx h = cfma(lp, cin[q], b_);
            const int tl = i + 8 * q + 4 * half;
            hi16[tl * (HIMG / 2) + 32 * s + c] = f2bf(h.r);
            hi16[tl * (HIMG / 2) + 64 + 32 * s + c] = f2bf(h.i);
          }
      }
    }
    if (OUT) {
      __builtin_amdgcn_wave_barrier();
#pragma unroll
      for (int rt = 0; rt < 2; ++rt) {
        f32x4 acc = {0.f, 0.f, 0.f, 0.f};
#pragma unroll
        for (int ks = 0; ks < 4; ++ks) {
          const bf16x8 a_ = *(const bf16x8*)(himg + (16 * rt + (lane & 15)) * HIMG + (32 * ks + 8 * (lane >> 4)) * 2);
          acc = __builtin_amdgcn_mfma_f32_16x16x32_bf16(a_, cfr[ks], acc, 0, 0, 0);
        }
#pragma unroll
        for (int r = 0; r < 4; ++r) {
          const int t = 32 * mt + 16 * rt + 4 * (lane >> 4) + r;
          if (t < nvalid) {
            const float u = bf2f(p.PJ[(size_t)(tok0 + t) * INC + g * 16 + (lane & 15)]);
            p.Y5[(size_t)(tok0 + t) * 512 + g * 16 + (lane & 15)] = gelu_(acc[r] + dsk * u);
          }
        }
      }
      __builtin_amdgcn_wave_barrier();
    }
  }
  st[0] = endst[0]; st[1] = endst[1];
}
__device__ void s5_pass_a(const Params& p) {
  const int lane = threadIdx.x & 63, gw = (blockIdx.x * NT + threadIdx.x) >> 6, nw = (gridDim.x * NT) >> 6;
  for (int job = gw; job < 8 * 32 * 32; job += nw) {
    const int c = job & 31, g = (job >> 5) & 31, b = job >> 10;
    Cx st[2] = {{0.f, 0.f}, {0.f, 0.f}};
    s5_chunk<2, false>(p, b * 2048 + c * 64, 64, g, st, 15, nullptr, lane);
    if (lane < 32) {
      float* e = p.E + (size_t)job * 128;
      e[lane] = st[0].r; e[32 + lane] = st[1].r; e[64 + lane] = st[0].i; e[96 + lane] = st[1].i;
    }
  }
}
__device__ void s5_job_c(const Params& p, int bj, bool prompt, unsigned char* lds) {
  const int lane = threadIdx.x & 63, wid = threadIdx.x >> 6;
  unsigned char* himg = lds + wid * (32 * HIMG);
  const int job = bj * 4 + wid;
  const int cc = lane & 31;
  if (prompt) {
    const int c = job & 31, g = (job >> 5) & 31, b = job >> 10;
    Cx L64[2], st[2];
#pragma unroll
    for (int s = 0; s < 2; ++s) { const int gp = g * 64 + 32 * s + cc; L64[s].r = p.lbLre[gp]; L64[s].i = p.lbLim[gp]; st[s].r = 0.f; st[s].i = 0.f; }
    const float* e = p.E + (size_t)(job - c) * 128;
    for (int j = 0; j < c; ++j) {
      Cx e0, e1;
      e0.r = e[j * 128 + cc]; e1.r = e[j * 128 + 32 + cc]; e0.i = e[j * 128 + 64 + cc]; e1.i = e[j * 128 + 96 + cc];
      st[0] = cfma(L64[0], st[0], e0); st[1] = cfma(L64[1], st[1], e1);
    }
    s5_chunk<2, true>(p, b * 2048 + c * 64, 64, g, st, 15, himg, lane);
    if (c == 31 && lane < 32) {
      float* o = p.out + O_S5RE_P + (b * 32 + g) * 64;
      o[lane] = st[0].r; o[32 + lane] = st[1].r;
      o = p.out + O_S5IM_P + (b * 32 + g) * 64;
      o[lane] = st[0].i; o[32 + lane] = st[1].i;
    }
  } else {
    const int g = job & 31, bs = job >> 5;
    Cx st[2];
    const float* r0 = p.s5re0 + ((size_t)bs * 32 + g) * 64;
    const float* i0 = p.s5im0 + ((size_t)bs * 32 + g) * 64;
    st[0].r = r0[cc]; st[1].r = r0[32 + cc]; st[0].i = i0[cc]; st[1].i = i0[32 + cc];
    s5_chunk<1, true>(p, NPT + bs * 8, 8, g, st, 1, himg, lane);
    if (lane < 32) {
      float* o = p.out + O_S5RE_S + ((size_t)bs * 32 + g) * 64;
      o[lane] = st[0].r; o[32 + lane] = st[1].r;
      o = p.out + O_S5IM_S + ((size_t)bs * 32 + g) * 64;
      o[lane] = st[0].i; o[32 + lane] = st[1].i;
    }
  }
}

__device__ __forceinline__ float tanh_fast(float x) { const float e = __expf(2.f * x); return 1.f - 2.f / (e + 1.f); }
template <int WHICH>
__device__ void lora_tiles(const Params& p, unsigned char* lds) {
  constexpr int base = WHICH == 0 ? 1536 : (WHICH == 1 ? 1600 : 1664);
  for (int t = blockIdx.x; t < 136 * 4; t += gridDim.x) {
    const int mt = t >> 2, nt = t & 3;
    auto al = [&](int row, int k, uint4& o0, uint4& o1, uint4& o2, uint4& o3) {
      const bfu* pc = p.PJ + (size_t)row * INC + 512 + base + k;
      const int tt = t_of(row);
      auto one = [&](int i) -> uint4 {
        const uint4 cu = *(const uint4*)(pc + i * 8);
        const float cur[8] = {bflo(cu.x), bfhi(cu.x), bflo(cu.y), bfhi(cu.y), bflo(cu.z), bfhi(cu.z), bflo(cu.w), bfhi(cu.w)};
        float prv[8];
        if (tt == 0) {
          if (row < NPT) {
#pragma unroll
            for (int j = 0; j < 8; ++j) prv[j] = 0.f;
          } else {
            const float4* s0 = (const float4*)(p.shift0 + (size_t)(sq_of(row) - 8) * RC + base + k + i * 8);
            const float4 a = s0[0], b_ = s0[1];
            prv[0] = a.x; prv[1] = a.y; prv[2] = a.z; prv[3] = a.w; prv[4] = b_.x; prv[5] = b_.y; prv[6] = b_.z; prv[7] = b_.w;
          }
        } else {
          const uint4 pu_ = *(const uint4*)(pc - INC + i * 8);
          prv[0] = bflo(pu_.x); prv[1] = bfhi(pu_.x); prv[2] = bflo(pu_.y); prv[3] = bfhi(pu_.y); prv[4] = bflo(pu_.z); prv[5] = bfhi(pu_.z); prv[6] = bflo(pu_.w); prv[7] = bfhi(pu_.w);
        }
        const float4 m0 = *(const float4*)(p.mu + base + k + i * 8), m1 = *(const float4*)(p.mu + base + k + i * 8 + 4);
        const float mm[8] = {m0.x, m0.y, m0.z, m0.w, m1.x, m1.y, m1.z, m1.w};
        float f[8];
#pragma unroll
        for (int j = 0; j < 8; ++j) {
          const float ps = cur[j] + (prv[j] - cur[j]) * mm[j];
          f[j] = WHICH == 0 ? tanh_fast(ps) : (WHICH == 1 ? ps : sigmoidf_(ps));
        }
        return make_uint4(pk2(f[0], f[1]), pk2(f[2], f[3]), pk2(f[4], f[5]), pk2(f[6], f[7]));
      };
      o0 = one(0); o1 = one(1); o2 = one(2); o3 = one(3);
    };
    auto ep = [&](int row, int col, float4 v4) {
      const size_t o = (size_t)row * 512 + col;
      const float v[4] = {v4.x, v4.y, v4.z, v4.w};
      float f[4];
      if (WHICH == 0) {
        const float4 w0 = *(const float4*)(p.w0 + col);
        const float ww[4] = {w0.x, w0.y, w0.z, w0.w};
#pragma unroll
        for (int j = 0; j < 4; ++j) {
          const float z = -(ww[j] + v[j]);
          const float sp = fmaxf(z, 0.f) + __logf(1.f + __expf(-fabsf(z)));
          f[j] = -__expf(-sp - 0.5f);
        }
        *(uint2*)(p.LD + o) = make_uint2(pk2(f[0], f[1]), pk2(f[2], f[3]));
      } else if (WHICH == 1) {
        const float4 a0 = *(const float4*)(p.a0 + col);
        const float aa[4] = {a0.x, a0.y, a0.z, a0.w};
#pragma unroll
        for (int j = 0; j < 4; ++j) f[j] = sigmoidf_(aa[j] + v[j]);
        *(uint2*)(p.AA + o) = make_uint2(pk2(f[0], f[1]), pk2(f[2], f[3]));
      } else {
        *(uint2*)(p.GG + o) = make_uint2(pk2(v[0], v[1]), pk2(v[2], v[3]));
      }
    };
    gemm_tile(mt * 128, nt * 128, WHICH == 2 ? 128 : 64, WHICH == 0 ? p.w2T : (WHICH == 1 ? p.a2T : p.g2T), al, ep, lds);
  }
}
__device__ void phase2(const Params& p, unsigned char* lds) {
  lora_tiles<0>(p, lds);
  lora_tiles<1>(p, lds);
  lora_tiles<2>(p, lds);
  s5_pass_a(p);
}

template <int CTRL>
__device__ __forceinline__ float dppf(float x) { return __uint_as_float((unsigned)__builtin_amdgcn_update_dpp(0, (int)__float_as_uint(x), CTRL, 0xf, 0xf, true)); }
template <int LPR>
__device__ __forceinline__ float red_lpr(float x) {
  x += dppf<0xB1>(x); x += dppf<0x4E>(x);
  if (LPR == 16) { x += dppf<0x141>(x); x += dppf<0x140>(x); }
  return x;
}
struct RwVec { float4 w, kk, b, k, r; };
template <int LPR, bool PROMPT>
__device__ void rwkv_job(const Params& p, int sq, int h, int rg, unsigned char* lds) {
  constexpr int ROWS = NT / LPR, KPL = 64 / LPR, NV = KPL / 4;
  float* Lr = (float*)lds;
  float* Lw = Lr + 17 * 64;
  float* Lk = Lw + 17 * 64;
  float* Lkk = Lk + 17 * 64;
  float* Lb = Lkk + 17 * 64;
  float* Lv = Lb + 17 * 64;
  float* Lyp0 = Lv + 17 * 64;
  const int tid = threadIdx.x;
  constexpr bool prompt = PROMPT;
  constexpr int T = PROMPT ? 2048 : 8;
  const int tokbase = prompt ? sq * 2048 : NPT + (sq - 8) * 8;
  const int row = tid / LPR, kq = tid % LPR;
  const int grow = rg * ROWS + row;
  float S[KPL];
  if (prompt) {
#pragma unroll
    for (int j = 0; j < KPL; ++j) S[j] = 0.f;
  } else {
    const float* s0 = p.wkv0 + (((size_t)(sq - 8) * 8 + h) * 64 + grow) * 64 + kq * KPL;
#pragma unroll
    for (int j = 0; j < NV; ++j) { const float4 v = ((const float4*)s0)[j]; S[j * 4] = v.x; S[j * 4 + 1] = v.y; S[j * 4 + 2] = v.z; S[j * 4 + 3] = v.w; }
  }
  const int tt = tid >> 4, kg = tid & 15, k4 = kg * 4;
  const int hc = h * 64 + k4;
  float mur[4], muk[4], muv[4], kkc[4], kac[4], rkc[4];
#pragma unroll
  for (int j = 0; j < 4; ++j) {
    mur[j] = p.mu[hc + j]; muk[j] = p.mu[512 + hc + j]; muv[j] = p.mu[1024 + hc + j];
    kkc[j] = p.k_k[hc + j]; kac[j] = p.k_a[hc + j]; rkc[j] = p.r_k[hc + j];
  }
  uint2 Acr, Ack, Acv, Aqr, Aqk, Aqv, Ald, Aaa;
  uint2 Bcr, Bck, Bcv, Bqr, Bqk, Bqv, Bld, Baa;
  auto gload = [&](int c0, uint2& cr, uint2& ck, uint2& cv, uint2& qr, uint2& qk, uint2& qv, uint2& ldv, uint2& aav) {
    const int cc0 = PROMPT ? min(c0, T - 16) : 0;
    const int nst = PROMPT ? 16 : 8;
    const int t = cc0 + (tt < nst ? tt : 0);
    const int tok = tokbase + t;
    const bfu* pc = p.PJ + (size_t)tok * INC + 512 + hc;
    const bfu* pp = pc - (t > 0 ? INC : 0);
    cr = *(const uint2*)(pc); ck = *(const uint2*)(pc + 512); cv = *(const uint2*)(pc + 1024);
    qr = *(const uint2*)(pp); qk = *(const uint2*)(pp + 512); qv = *(const uint2*)(pp + 1024);
    ldv = *(const uint2*)(p.LD + (size_t)tok * 512 + hc);
    aav = *(const uint2*)(p.AA + (size_t)tok * 512 + hc);
  };
  auto store_y = [&](int c0, const float* Lyp) {
    constexpr int nst = PROMPT ? 16 : 8;
    for (int i = tid; i < nst * ROWS; i += NT) {
      const int s = i / ROWS, rr = i % ROWS;
      const float4* yp = (const float4*)(Lyp + (size_t)i * LPR);
      float y = 0.f;
#pragma unroll
      for (int j = 0; j < LPR / 4; ++j) { const float4 v = yp[j]; y += (v.x + v.y) + (v.z + v.w); }
      p.out[(size_t)(tokbase + c0 + s) * 1024 + 512 + h * 64 + rg * ROWS + rr] = y;
    }
  };
  auto process = [&](int c0, int par, uint2& cr, uint2& ck, uint2& cv, uint2& qr, uint2& qk, uint2& qv, uint2& ldv, uint2& aav) {
    float* Lyp = Lyp0 + par * (16 * NT);
    constexpr int nst = PROMPT ? 16 : 8;
    const bool act = PROMPT ? true : (tt < nst);
    const int t = c0 + (act ? tt : 0);
    const int tok = tokbase + t;
    {
      float pr[4], pk_[4], pv_[4];
      if (t == 0) {
        if (prompt) {
#pragma unroll
          for (int j = 0; j < 4; ++j) pr[j] = pk_[j] = pv_[j] = 0.f;
        } else {
          const float* s0 = p.shift0 + (size_t)(sq - 8) * RC + hc;
#pragma unroll
          for (int j = 0; j < 4; ++j) { pr[j] = s0[j]; pk_[j] = s0[512 + j]; pv_[j] = s0[1024 + j]; }
        }
      } else {
        pr[0] = bflo(qr.x); pr[1] = bfhi(qr.x); pr[2] = bflo(qr.y); pr[3] = bfhi(qr.y);
        pk_[0] = bflo(qk.x); pk_[1] = bfhi(qk.x); pk_[2] = bflo(qk.y); pk_[3] = bfhi(qk.y);
        pv_[0] = bflo(qv.x); pv_[1] = bfhi(qv.x); pv_[2] = bflo(qv.y); pv_[3] = bfhi(qv.y);
      }
      const float c_r[4] = {bflo(cr.x), bfhi(cr.x), bflo(cr.y), bfhi(cr.y)};
      const float c_k[4] = {bflo(ck.x), bfhi(ck.x), bflo(ck.y), bfhi(ck.y)};
      const float c_v[4] = {bflo(cv.x), bfhi(cv.x), bflo(cv.y), bfhi(cv.y)};
      const float ld4[4] = {bflo(ldv.x), bfhi(ldv.x), bflo(ldv.y), bfhi(ldv.y)};
      const float aa4[4] = {bflo(aav.x), bfhi(aav.x), bflo(aav.y), bfhi(aav.y)};
      float r4[4], kx4[4], v4[4], w4[4], kk4[4];
      float ssq = 0.f, bon = 0.f;
#pragma unroll
      for (int j = 0; j < 4; ++j) {
        r4[j] = c_r[j] + (pr[j] - c_r[j]) * mur[j];
        const float kx = c_k[j] + (pk_[j] - c_k[j]) * muk[j];
        v4[j] = c_v[j] + (pv_[j] - c_v[j]) * muv[j];
        w4[j] = __expf(ld4[j]);
        kk4[j] = kx * kkc[j];
        ssq += kk4[j] * kk4[j];
        kx4[j] = kx * (1.f + (aa4[j] - 1.f) * kac[j]);
        bon += r4[j] * kx4[j] * rkc[j];
      }
      ssq = red_lpr<16>(ssq); bon = red_lpr<16>(bon);
      const float inv = rsqrtf(fmaxf(ssq, 1e-24f));
      __syncthreads();
      if (act) {
        *(float4*)(Lr + tt * 64 + k4) = make_float4(r4[0], r4[1], r4[2], r4[3]);
        *(float4*)(Lw + tt * 64 + k4) = make_float4(w4[0], w4[1], w4[2], w4[3]);
        *(float4*)(Lk + tt * 64 + k4) = make_float4(kx4[0], kx4[1], kx4[2], kx4[3]);
        *(float4*)(Lkk + tt * 64 + k4) = make_float4(kk4[0] * inv, kk4[1] * inv, kk4[2] * inv, kk4[3] * inv);
        *(float4*)(Lb + tt * 64 + k4) = make_float4(kk4[0] * inv * aa4[0], kk4[1] * inv * aa4[1], kk4[2] * inv * aa4[2], kk4[3] * inv * aa4[3]);
        *(float4*)(Lv + tt * 64 + k4) = make_float4(v4[0], v4[1], v4[2], v4[3]);
        (rg == 0 ? p.BON : p.BONX)[(size_t)tok * 8 + h] = bon;
      }
    }
    __syncthreads();
    if (PROMPT) store_y(max(c0 - 16, 0), Lyp0 + (par ^ 1) * (16 * NT));
    gload(c0 + 32, cr, ck, cv, qr, qk, qv, ldv, aav);
    {
      auto ldvec = [&](int s, int j) -> RwVec {
        RwVec v;
        const int o = s * 64 + kq * KPL + j * 4;
        v.w = *(const float4*)(Lw + o); v.kk = *(const float4*)(Lkk + o); v.b = *(const float4*)(Lb + o);
        v.k = *(const float4*)(Lk + o); v.r = *(const float4*)(Lr + o);
        return v;
      };
      RwVec cur[NV];
      float vcur;
#pragma unroll
      for (int j = 0; j < NV; ++j) cur[j] = ldvec(0, j);
      vcur = Lv[grow];
      for (int s = 0; s < nst; ++s) {
        RwVec nxt[NV];
        float vnx;
#pragma unroll
        for (int j = 0; j < NV; ++j) nxt[j] = ldvec(s + 1, j);
        vnx = Lv[(s + 1) * 64 + grow];
        float sa0 = 0.f, sa1 = 0.f;
#pragma unroll
        for (int j = 0; j < NV; ++j) {
          sa0 += S[j * 4] * cur[j].kk.x; sa1 += S[j * 4 + 1] * cur[j].kk.y;
          sa0 += S[j * 4 + 2] * cur[j].kk.z; sa1 += S[j * 4 + 3] * cur[j].kk.w;
        }
        float tq[KPL];
#pragma unroll
        for (int j = 0; j < NV; ++j) {
          tq[j * 4] = S[j * 4] * cur[j].w.x + vcur * cur[j].k.x;
          tq[j * 4 + 1] = S[j * 4 + 1] * cur[j].w.y + vcur * cur[j].k.y;
          tq[j * 4 + 2] = S[j * 4 + 2] * cur[j].w.z + vcur * cur[j].k.z;
          tq[j * 4 + 3] = S[j * 4 + 3] * cur[j].w.w + vcur * cur[j].k.w;
        }
        float sa = -red_lpr<LPR>(sa0 + sa1);
        float y0 = 0.f, y1 = 0.f;
#pragma unroll
        for (int j = 0; j < NV; ++j) {
          S[j * 4] = tq[j * 4] + sa * cur[j].b.x;
          S[j * 4 + 1] = tq[j * 4 + 1] + sa * cur[j].b.y;
          S[j * 4 + 2] = tq[j * 4 + 2] + sa * cur[j].b.z;
          S[j * 4 + 3] = tq[j * 4 + 3] + sa * cur[j].b.w;
          y0 += S[j * 4] * cur[j].r.x; y1 += S[j * 4 + 1] * cur[j].r.y;
          y0 += S[j * 4 + 2] * cur[j].r.z; y1 += S[j * 4 + 3] * cur[j].r.w;
        }
        Lyp[(s * ROWS + row) * LPR + kq] = y0 + y1;
#pragma unroll
        for (int j = 0; j < NV; ++j) cur[j] = nxt[j];
        vcur = vnx;
      }
    }
  };
  gload(0, Acr, Ack, Acv, Aqr, Aqk, Aqv, Ald, Aaa);
  gload(16, Bcr, Bck, Bcv, Bqr, Bqk, Bqv, Bld, Baa);
  for (int c0 = 0; c0 < T; c0 += 32) {
    process(c0, 0, Acr, Ack, Acv, Aqr, Aqk, Aqv, Ald, Aaa);
    if (PROMPT) process(c0 + 16, 1, Bcr, Bck, Bcv, Bqr, Bqk, Bqv, Bld, Baa);
  }
  __syncthreads();
  {
    const int lastc = ((T - 1) >> 4) << 4;
    store_y(lastc, Lyp0 + ((lastc >> 4) & 1) * (16 * NT));
  }
  {
    float* so = p.out + (prompt ? O_WKV_P + (((size_t)sq * 8 + h) * 64 + grow) * 64 : O_WKV_S + (((size_t)(sq - 8) * 8 + h) * 64 + grow) * 64) + kq * KPL;
#pragma unroll
    for (int j = 0; j < NV; ++j) ((float4*)so)[j] = make_float4(S[j * 4], S[j * 4 + 1], S[j * 4 + 2], S[j * 4 + 3]);
  }
  __syncthreads();
}
__device__ void rwkv_post(const Params& p) {
  const int tid = threadIdx.x;
  const int h = (tid >> 4) & 7, kg = tid & 15, k4 = kg * 4, hc = h * 64 + k4;
  float muv[4], gnw[4], gnb[4];
#pragma unroll
  for (int j = 0; j < 4; ++j) { muv[j] = p.mu[1024 + hc + j]; gnw[j] = p.gn_w[hc + j]; gnb[j] = p.gn_b[hc + j]; }
  for (int it = blockIdx.x; it < NTOK / 2; it += gridDim.x) {
    const int tok = it * 2 + (tid >> 7);
    const int t = t_of(tok);
    const bfu* pc = p.PJ + (size_t)tok * INC + 512 + 1024 + hc;
    const uint2 cv = *(const uint2*)pc;
    float pv_[4];
    if (t == 0) {
      if (tok < NPT) { pv_[0] = pv_[1] = pv_[2] = pv_[3] = 0.f; }
      else { const float* s0 = p.shift0 + (size_t)(sq_of(tok) - 8) * RC + 1024 + hc; pv_[0] = s0[0]; pv_[1] = s0[1]; pv_[2] = s0[2]; pv_[3] = s0[3]; }
    } else {
      const uint2 qv = *(const uint2*)(pc - INC);
      pv_[0] = bflo(qv.x); pv_[1] = bfhi(qv.x); pv_[2] = bflo(qv.y); pv_[3] = bfhi(qv.y);
    }
    const float c_v[4] = {bflo(cv.x), bfhi(cv.x), bflo(cv.y), bfhi(cv.y)};
    float* yp = p.out + (size_t)tok * 1024 + 512 + hc;
    const float4 y4 = *(const float4*)yp;
    const float mean = red_lpr<16>(y4.x + y4.y + y4.z + y4.w) * (1.f / 64.f);
    const float dd[4] = {y4.x - mean, y4.y - mean, y4.z - mean, y4.w - mean};
    const float rstd = rsqrtf(red_lpr<16>(dd[0] * dd[0] + dd[1] * dd[1] + dd[2] * dd[2] + dd[3] * dd[3]) * (1.f / 64.f) + GN_EPS);
    const float bon = p.BON[(size_t)tok * 8 + h];
    const uint2 gv = *(const uint2*)(p.GG + (size_t)tok * 512 + hc);
    const float g4[4] = {bflo(gv.x), bfhi(gv.x), bflo(gv.y), bfhi(gv.y)};
    float o4[4];
#pragma unroll
    for (int j = 0; j < 4; ++j) {
      const float v = c_v[j] + (pv_[j] - c_v[j]) * muv[j];
      o4[j] = (dd[j] * rstd * gnw[j] + gnb[j] + bon * v) * g4[j];
    }
    *(uint2*)(p.CAT + (size_t)tok * 1024 + 512 + hc) = make_uint2(pk2(o4[0], o4[1]), pk2(o4[2], o4[3]));
  }
}

#ifndef P3MODE
#define P3MODE 0
#endif
__device__ void phase3(const Params& p, unsigned char* lds, int cw = 0, int mode = 0) {
  volatile int* jb = (volatile int*)(lds + LDS_JOB);
  for (;;) {
    __syncthreads();
    if (threadIdx.x == 0) *jb = (int)atomicAdd(&p.bar[cw], 1u);
    __syncthreads();
    const int j = *jb;
    if (j >= 4352) break;
    if (j < 256) { if (mode != 1) rwkv_job<16, true>(p, j >> 5, (j >> 2) & 7, j & 3, lds); }
    else if (j < 2304) { if (mode != 2) s5_job_c(p, j - 256, true, lds); }
    else if (j < 3328) { const int q = j - 2304; if (mode != 1) rwkv_job<4, false>(p, 8 + (q >> 3), q & 7, 0, lds); }
    else { if (mode != 2) s5_job_c(p, j - 3328, false, lds); }
  }
}

__device__ void phase4a(const Params& p, unsigned char* lds) {
  rwkv_post(p);
  for (int t = blockIdx.x; t < 136 * 4; t += gridDim.x) {
    const int mt = t >> 2, nt = t & 3;
    auto al = [&](int row, int k, uint4& o0, uint4& o1, uint4& o2, uint4& o3) {
      const float4* s = (const float4*)(p.Y5 + (size_t)row * 512 + k);
      auto one = [&](int i) -> uint4 { const float4 a = s[i * 2], b = s[i * 2 + 1]; return make_uint4(pk2(a.x, a.y), pk2(a.z, a.w), pk2(b.x, b.y), pk2(b.z, b.w)); };
      o0 = one(0); o1 = one(1); o2 = one(2); o3 = one(3);
    };
    auto ep = [&](int row, int col, float4 v) {
      const float4 y = *(const float4*)(p.Y5 + (size_t)row * 512 + col), bg = *(const float4*)(p.b_glu + col);
      *(uint2*)(p.CAT + (size_t)row * 1024 + col) = make_uint2(pk2(y.x * sigmoidf_(v.x + bg.x), y.y * sigmoidf_(v.y + bg.y)), pk2(y.z * sigmoidf_(v.z + bg.z), y.w * sigmoidf_(v.w + bg.w)));
    };
    gemm_tile(mt * 128, nt * 128, 512, p.WgluT, al, ep, lds);
  }
}
__device__ void phase4b(const Params& p, unsigned char* lds) {
  for (int t = blockIdx.x; t < 136 * 8; t += gridDim.x) {
    const int mt = t >> 3, nt = t & 7;
    auto al = [&](int row, int k, uint4& o0, uint4& o1, uint4& o2, uint4& o3) {
      const uint4* s_ = (const uint4*)(p.CAT + (size_t)row * 1024 + k);
      o0 = s_[0]; o1 = s_[1]; o2 = s_[2]; o3 = s_[3];
    };
    auto ep = [&](int row, int col, float4 v) {
      const int sq = sq_of(row);
      const float4 x = *(const float4*)(xrow(p, row) + col), g = *(const float4*)(p.mod + (size_t)sq * 6144 + 2048 + col);
      *(float4*)(p.X1 + (size_t)row * 1024 + col) = make_float4(x.x + g.x * v.x, x.y + g.y * v.y, x.z + g.z * v.z, x.w + g.w * v.w);
    };
    gemm_tile(mt * 128, nt * 128, 1024, p.WoutT, al, ep, lds);
  }
}
template <bool FROMX>
__device__ void norm_rows(const Params& p, const float* __restrict__ gsrc, int sh_off, bfu* __restrict__ dst) {
  const int lane = threadIdx.x & 63, gw = (blockIdx.x * NT + threadIdx.x) >> 6, nw = (gridDim.x * NT) >> 6;
  for (int tok = gw; tok < NTOK; tok += nw) {
    const float* xr = FROMX ? xrow(p, tok) : p.X1 + (size_t)tok * 1024;
    const float* md = p.mod + (size_t)sq_of(tok) * 6144 + sh_off;
    float4 v[4];
    float s = 0.f;
#pragma unroll
    for (int i = 0; i < 4; ++i) { const float4 a = *(const float4*)(xr + lane * 16 + i * 4); v[i] = a; s += a.x * a.x + a.y * a.y + a.z * a.z + a.w * a.w; }
#pragma unroll
    for (int o = 32; o > 0; o >>= 1) s += __shfl_xor(s, o);
    const float rs = rsqrtf(s * (1.f / 1024.f) + NORM_EPS);
    float f[16];
#pragma unroll
    for (int i = 0; i < 4; ++i) {
      const int k = lane * 16 + i * 4;
      const float4 g4 = *(const float4*)(gsrc + k), sh = *(const float4*)(md + k), sc = *(const float4*)(md + 1024 + k);
      const float4 a = v[i];
      f[i * 4 + 0] = a.x * rs * g4.x * (1.f + sc.x) + sh.x;
      f[i * 4 + 1] = a.y * rs * g4.y * (1.f + sc.y) + sh.y;
      f[i * 4 + 2] = a.z * rs * g4.z * (1.f + sc.z) + sh.z;
      f[i * 4 + 3] = a.w * rs * g4.w * (1.f + sc.w) + sh.w;
    }
    uint4* d = (uint4*)(dst + (size_t)tok * 1024 + lane * 16);
    d[0] = make_uint4(pk2(f[0], f[1]), pk2(f[2], f[3]), pk2(f[4], f[5]), pk2(f[6], f[7]));
    d[1] = make_uint4(pk2(f[8], f[9]), pk2(f[10], f[11]), pk2(f[12], f[13]), pk2(f[14], f[15]));
  }
}
__device__ void phase0b(const Params& p) { norm_rows<true>(p, p.n1g, 0, p.H1); }
__device__ void phase5a(const Params& p) { norm_rows<false>(p, p.n2g, 3072, p.H2); }
__device__ void phase5b(const Params& p, unsigned char* lds) {
  for (int t = blockIdx.x; t < 136 * 8; t += gridDim.x) {
    const int mt = t >> 3, nt = t & 7;
    auto al = [&](int row, int k, uint4& o0, uint4& o1, uint4& o2, uint4& o3) {
      const uint4* s = (const uint4*)(p.H2 + (size_t)row * 1024 + k);
      o0 = s[0]; o1 = s[1]; o2 = s[2]; o3 = s[3];
    };
    auto ep = [&](int row, int col, float4 v) { *(uint2*)(p.Q + (size_t)row * 1024 + col) = make_uint2(pk2(v.x, v.y), pk2(v.z, v.w)); };
    gemm_tile(mt * 128, nt * 128, 1024, p.WqT, al, ep, lds);
  }
}

__device__ __forceinline__ void ins16(float (&L)[16], float x) {
#pragma unroll
  for (int j = 0; j < 16; ++j) { const float hi = fmaxf(L[j], x); x = fminf(L[j], x); L[j] = hi; }
}
__device__ __forceinline__ void ce_desc(float& a, float& b) { const float hi = fmaxf(a, b), lo = fminf(a, b); a = hi; b = lo; }
__device__ __forceinline__ void sort16_desc(float (&a)[16]) {
#pragma unroll
  for (int k = 2; k <= 16; k <<= 1)
#pragma unroll
    for (int j = k >> 1; j > 0; j >>= 1)
#pragma unroll
      for (int i = 0; i < 16; ++i) {
        const int l = i ^ j;
        if (l > i) {
          if ((i & k) == 0) ce_desc(a[i], a[l]);
          else ce_desc(a[l], a[i]);
        }
      }
}
__device__ __forceinline__ void merge16_desc(float (&L)[16], const float (&T)[16]) {
#pragma unroll
  for (int i = 0; i < 16; ++i) L[i] = fmaxf(L[i], T[15 - i]);
#pragma unroll
  for (int j = 8; j > 0; j >>= 1)
#pragma unroll
    for (int i = 0; i < 16; ++i) { const int l = i ^ j; if (l > i) ce_desc(L[i], L[l]); }
}
__device__ __forceinline__ void peer_side_top16(const Params& p, const bfu* __restrict__ keys, int tok, int h, int side, int lane, float (&L)[16]) {
  const int l31 = lane & 31, lh = lane >> 5;
  bf16x8 bq[4];
#pragma unroll
  for (int ks = 0; ks < 4; ++ks) bq[ks] = *(const bf16x8*)(p.Q + (size_t)tok * 1024 + h * 128 + side * 64 + ks * 16 + lh * 8);
#pragma unroll
  for (int nt = 0; nt < 4; ++nt) {
    f32x16 acc;
#pragma unroll
    for (int r = 0; r < 16; ++r) acc[r] = 0.f;
#pragma unroll
    for (int ks = 0; ks < 4; ++ks) {
      const bf16x8 ak = *(const bf16x8*)(keys + ((size_t)(h * 128 + nt * 32 + l31)) * 64 + ks * 16 + lh * 8);
      acc = __builtin_amdgcn_mfma_f32_32x32x16_bf16(ak, bq[ks], acc, 0, 0, 0);
    }
    float V[16];
#pragma unroll
    for (int r = 0; r < 16; ++r) {
      const unsigned n = (unsigned)(nt * 32 + (r & 3) + 8 * (r >> 2)) + 4u * (unsigned)lh;
      V[r] = __uint_as_float((__float_as_uint(acc[r]) & ~127u) | n);
    }
    sort16_desc(V);
    if (nt == 0) {
#pragma unroll
      for (int j = 0; j < 16; ++j) L[j] = V[j];
    } else merge16_desc(L, V);
  }
  float P[16];
#pragma unroll
  for (int j = 0; j < 16; ++j) P[j] = __shfl_xor(L[j], 32);
  merge16_desc(L, P);
}
__device__ void phase6(const Params& p, unsigned char* lds) {
  const int tid = threadIdx.x, lane = tid & 63, wid = tid >> 6;
  unsigned char* ib = lds + wid * (64 * 36);
  const int gw = (blockIdx.x * NT + tid) >> 6, nw = (gridDim.x * NT) >> 6;
  for (int job = gw; job < (NTOK / 32) * 8; job += nw) {
    const int tile = job >> 3, h = job & 7;
    const int tok = tile * 32 + (lane & 31);
    float L1[16], L2[16];
    peer_side_top16(p, p.K1, tok, h, 0, lane, L1);
    peer_side_top16(p, p.K2, tok, h, 1, lane, L2);
    {
      unsigned* iw = (unsigned*)(ib + lane * 36);
#pragma unroll
      for (int q = 0; q < 4; ++q) {
        iw[q] = (__float_as_uint(L1[q * 4]) & 127u) | ((__float_as_uint(L1[q * 4 + 1]) & 127u) << 8) | ((__float_as_uint(L1[q * 4 + 2]) & 127u) << 16) | ((__float_as_uint(L1[q * 4 + 3]) & 127u) << 24);
        iw[4 + q] = (__float_as_uint(L2[q * 4]) & 127u) | ((__float_as_uint(L2[q * 4 + 1]) & 127u) << 8) | ((__float_as_uint(L2[q * 4 + 2]) & 127u) << 16) | ((__float_as_uint(L2[q * 4 + 3]) & 127u) << 24);
      }
    }
    float C[16];
    {
      auto cand = [&](int i, int j) -> float {
        const float v = __uint_as_float(__float_as_uint(L1[i]) & ~127u) + __uint_as_float(__float_as_uint(L2[j]) & ~127u);
        return __uint_as_float((__float_as_uint(v) & ~255u) | (unsigned)(i * 16 + j));
      };
      float R[16];
#pragma unroll
      for (int j = 0; j < 16; ++j) { C[j] = cand(0, j); R[j] = j < 8 ? cand(1, j) : -3.0e38f; }
      merge16_desc(C, R);
      R[0] = cand(2, 0); R[1] = cand(2, 1); R[2] = cand(2, 2); R[3] = cand(2, 3); R[4] = cand(2, 4);
      R[5] = cand(3, 0); R[6] = cand(3, 1); R[7] = cand(3, 2); R[8] = cand(3, 3);
      R[9] = cand(4, 0); R[10] = cand(4, 1); R[11] = cand(4, 2);
      R[12] = cand(5, 0); R[13] = cand(5, 1); R[14] = cand(6, 0); R[15] = cand(6, 1);
      sort16_desc(R);
      merge16_desc(C, R);
      R[0] = cand(7, 0); R[1] = cand(7, 1);
#pragma unroll
      for (int i = 8; i < 16; ++i) R[i - 6] = cand(i, 0);
#pragma unroll
      for (int j = 10; j < 16; ++j) R[j] = -3.0e38f;
      sort16_desc(R);
      merge16_desc(C, R);
    }
    __builtin_amdgcn_wave_barrier();
    const float m = __uint_as_float(__float_as_uint(C[0]) & ~255u);
    float e[16], sum = 0.f;
    unsigned idx[16];
#pragma unroll
    for (int j = 0; j < 16; ++j) {
      const unsigned cb = __float_as_uint(C[j]);
      e[j] = __expf(__uint_as_float(cb & ~255u) - m);
      sum += e[j];
      const unsigned i1 = ib[lane * 36 + ((cb >> 4) & 15u)], i2 = ib[lane * 36 + 16 + (cb & 15u)];
      idx[j] = i1 * 128u + i2;
    }
    const float inv = 1.f / sum;
    if (lane < 32) {
      uint4* eo = (uint4*)(p.EI + (size_t)tok * 128 + h * 16);
      float4* go = (float4*)(p.EG + (size_t)tok * 128 + h * 16);
#pragma unroll
      for (int q = 0; q < 4; ++q) {
        eo[q] = make_uint4(idx[q * 4], idx[q * 4 + 1], idx[q * 4 + 2], idx[q * 4 + 3]);
        go[q] = make_float4(e[q * 4] * inv, e[q * 4 + 1] * inv, e[q * 4 + 2] * inv, e[q * 4 + 3] * inv);
      }
    }
    __builtin_amdgcn_wave_barrier();
  }
}

typedef float v32f __attribute__((ext_vector_type(32)));
typedef unsigned v6u __attribute__((ext_vector_type(6)));
typedef __bf16 v2bf __attribute__((ext_vector_type(2)));
typedef __bf16 v32bf __attribute__((ext_vector_type(32)));
__device__ __forceinline__ v32f unpack_fp6(const uint4 a, const uint2 b) {
  v6u w; w[0] = a.x; w[1] = a.y; w[2] = a.z; w[3] = a.w; w[4] = b.x; w[5] = b.y;
  return __builtin_amdgcn_cvt_scalef32_pk32_f32_fp6(w, 1.0f);
}
__device__ void phase7(const Params& p) {
  const int lane = threadIdx.x & 63, l31 = lane & 31, half = lane >> 5;
  const int gw = (blockIdx.x * NT + threadIdx.x) >> 6, nw = (gridDim.x * NT) >> 6;
  for (int tok = gw; tok < NTOK; tok += nw) {
    unsigned hp16[16];
    {
      const uint2* hp = (const uint2*)(p.H2 + (size_t)tok * 1024 + l31 * 4);
#pragma unroll
      for (int i = 0; i < 8; ++i) { const uint2 a = hp[i * 32]; hp16[i * 2] = a.x; hp16[i * 2 + 1] = a.y; }
    }
    const unsigned ei0 = p.EI[(size_t)tok * 128 + lane] & 16383u, ei1 = p.EI[(size_t)tok * 128 + 64 + lane] & 16383u;
    const float eg0 = p.EG[(size_t)tok * 128 + lane] * p.SV[ei0], eg1 = p.EG[(size_t)tok * 128 + 64 + lane] * p.SV[ei1];
    const float su0 = p.SU[ei0], su1 = p.SU[ei1];
    float ff[32];
#pragma unroll
    for (int j = 0; j < 32; ++j) ff[j] = 0.f;
#pragma unroll 1
    for (int grp = 0; grp < 16; ++grp) {
      const unsigned eiv = grp < 8 ? ei0 : ei1;
      const float egv = grp < 8 ? eg0 : eg1;
      const float suv = grp < 8 ? su0 : su1;
      const int lb = (grp & 7) * 8;
      uint4 ua[4], va[4];
      uint2 ub[4], vb[4];
#pragma unroll
      for (int i = 0; i < 4; ++i) {
        const unsigned id = (unsigned)__shfl((int)eiv, lb + 2 * i + half);
        const unsigned char* ur = p.TU + (size_t)id * 768;
        const unsigned char* vr = p.TV + (size_t)id * 768;
        ua[i] = *(const uint4*)(ur + l31 * 16); ub[i] = *(const uint2*)(ur + 512 + l31 * 8);
        va[i] = *(const uint4*)(vr + l31 * 16); vb[i] = *(const uint2*)(vr + 512 + l31 * 8);
      }
      float part[4];
#pragma unroll
      for (int i = 0; i < 4; ++i) {
        v6u w; w[0] = ua[i].x; w[1] = ua[i].y; w[2] = ua[i].z; w[3] = ua[i].w; w[4] = ub[i].x; w[5] = ub[i].y;
        const v32bf u = __builtin_amdgcn_cvt_scalef32_pk32_bf16_fp6(w, 1.0f);
        float s0 = 0.f, s1 = 0.f;
#pragma unroll
        for (int m = 0; m < 16; m += 2) {
          v2bf a0; a0[0] = u[2 * m]; a0[1] = u[2 * m + 1];
          v2bf a1; a1[0] = u[2 * m + 2]; a1[1] = u[2 * m + 3];
          s0 = __builtin_amdgcn_fdot2_f32_bf16(a0, __builtin_bit_cast(v2bf, hp16[m]), s0, false);
          s1 = __builtin_amdgcn_fdot2_f32_bf16(a1, __builtin_bit_cast(v2bf, hp16[m + 1]), s1, false);
        }
        part[i] = s0 + s1;
        __builtin_amdgcn_sched_barrier(0);
      }
      float r2[2], r1;
      {
        const bool h4 = lane & 16;
#pragma unroll
        for (int i = 0; i < 2; ++i) { const float keep = h4 ? part[i + 2] : part[i], send = h4 ? part[i] : part[i + 2]; r2[i] = keep + __shfl_xor(send, 16); }
        const bool h3 = lane & 8;
        { const float keep = h3 ? r2[1] : r2[0], send = h3 ? r2[0] : r2[1]; r1 = keep + __shfl_xor(send, 8); }
        r1 += dppf<0x141>(r1); r1 += dppf<0x4E>(r1); r1 += dppf<0xB1>(r1);
      }
      const int myI = ((lane >> 4) & 1) * 2 + ((lane >> 3) & 1);
      const int slot = lb + 2 * myI + half;
      const float gate = __shfl(egv, slot), su = __shfl(suv, slot);
      const float coef = gate * gelu_(r1 * su);
#pragma unroll
      for (int i = 0; i < 4; ++i) {
        const float c = __shfl(coef, (lane & 32) + ((i >> 1) & 1) * 16 + (i & 1) * 8);
        const v32f v = unpack_fp6(va[i], vb[i]);
#pragma unroll
        for (int j = 0; j < 32; ++j) ff[j] += c * v[j];
        __builtin_amdgcn_sched_barrier(0);
      }
    }
    float fs[16];
#pragma unroll
    for (int j = 0; j < 16; ++j) {
      const float mine = half ? ff[16 + j] : ff[j], other = half ? ff[j] : ff[16 + j];
      fs[j] = mine + __shfl_xor(other, 32);
    }
    const int k0 = half * 512 + l31 * 4;
    const float* x1 = p.X1 + (size_t)tok * 1024 + k0;
    const float* ga = p.mod + (size_t)sq_of(tok) * 6144 + 5120 + k0;
    float xf[16];
    float s = 0.f;
#pragma unroll
    for (int i = 0; i < 4; ++i) {
      const float4 a = *(const float4*)(x1 + i * 128), g4 = *(const float4*)(ga + i * 128);
      xf[i * 4] = a.x + g4.x * fs[i * 4]; xf[i * 4 + 1] = a.y + g4.y * fs[i * 4 + 1]; xf[i * 4 + 2] = a.z + g4.z * fs[i * 4 + 2]; xf[i * 4 + 3] = a.w + g4.w * fs[i * 4 + 3];
      s += xf[i * 4] * xf[i * 4] + xf[i * 4 + 1] * xf[i * 4 + 1] + xf[i * 4 + 2] * xf[i * 4 + 2] + xf[i * 4 + 3] * xf[i * 4 + 3];
    }
#pragma unroll
    for (int o = 32; o > 0; o >>= 1) s += __shfl_xor(s, o);
    const float rs = rsqrtf(s * (1.f / 1024.f) + NORM_EPS);
#pragma unroll
    for (int i = 0; i < 4; ++i) {
      const float4 g4 = *(const float4*)(p.fng + k0 + i * 128);
      *(float4*)(p.out + (size_t)tok * 1024 + k0 + i * 128) = make_float4(xf[i * 4] * rs * g4.x, xf[i * 4 + 1] * rs * g4.y, xf[i * 4 + 2] * rs * g4.z, xf[i * 4 + 3] * rs * g4.w);
    }
  }
}


template <int PH>
__global__ void __launch_bounds__(NT, 2) phase_kernel(Params p) {
  __shared__ __attribute__((aligned(16))) unsigned char lds[LDS_BYTES];
  if (PH == 0) phase0(p, lds);
  if (PH == 1) { phase0b(p); phase1(p, lds); }
  if (PH == 2) phase2(p, lds);
  if (PH == 3) phase3(p, lds);
  if (PH == 4) phase4a(p, lds);
  if (PH == 5) phase4b(p, lds);
  if (PH == 6) phase5a(p);
  if (PH == 7) phase5b(p, lds);
  if (PH == 8) phase6(p, lds);
  if (PH == 9) phase7(p);
}

__global__ void __launch_bounds__(NT, 2) mega_kernel(Params p) {
  __shared__ __attribute__((aligned(16))) unsigned char lds[LDS_BYTES + 16];
  if (p.never) cg::this_grid().sync();
  volatile unsigned* st = (volatile unsigned*)(lds + LDS_BYTES);
  if (threadIdx.x == 0) { st[0] = 0u; st[1] = 0u; st[2] = 0u; st[3] = 0u; }
  __syncthreads();
  XcdBarrier b = xcd_barrier_post(p.bar, st);
  phase0(p, lds);  xcd_barrier(b);
  if (DUP == 0) { phase0(p, lds); xcd_barrier(b); }
  phase0b(p);      xcd_barrier(b);
  phase1(p, lds);  xcd_barrier(b);
  if (DUP == 1) { phase1(p, lds); xcd_barrier(b); }
  phase2(p, lds);  xcd_barrier(b);
  if (DUP == 2) { phase2(p, lds); xcd_barrier(b); }
  phase3(p, lds);  xcd_barrier(b);
  if (DUP == 3) { phase3(p, lds, 64, P3MODE); xcd_barrier(b); }
  phase4a(p, lds); xcd_barrier(b);
  if (DUP == 4) { phase4a(p, lds); xcd_barrier(b); }
  phase4b(p, lds); xcd_barrier(b);
  if (DUP == 5) { phase4b(p, lds); xcd_barrier(b); }
  phase5a(p);      xcd_barrier(b);
  if (DUP == 6) { phase5a(p); xcd_barrier(b); }
  phase5b(p, lds); xcd_barrier(b);
  if (DUP == 7) { phase5b(p, lds); xcd_barrier(b); }
  phase6(p, lds);  xcd_barrier(b);
  if (DUP == 8) { phase6(p, lds); xcd_barrier(b); }
  phase7(p);
  if (DUP == 9) { xcd_barrier(b); phase7(p); }
}

extern "C" void kernel_launch(void* const* d_in, const int* in_sizes, int n_in, void* d_out, int out_size, void* d_ws, size_t ws_size,
                              hipStream_t stream) {
  Params p;
  memset(&p, 0, sizeof(p));
  const float** f = (const float**)&p.xp;
  for (int i = 0; i < 41; ++i) f[i] = (const float*)d_in[i];
  p.out = (float*)d_out;
  unsigned char* w = (unsigned char*)d_ws;
  size_t off = 0;
  auto take = [&](size_t bytes) { unsigned char* r = w + off; off += (bytes + 255) & ~(size_t)255; return r; };
  p.bar = (unsigned*)take(XCD_BAR_WORDS * 4);
  p.TU = take((size_t)16384 * 768);
  p.TV = take((size_t)16384 * 768);
  p.SU = (float*)take(16384 * 4);
  p.SV = (float*)take(16384 * 4);
  p.WinT = (bfu*)take((size_t)2304 * 1024 * 2);
  p.WoutT = (bfu*)take((size_t)1024 * 1024 * 2);
  p.WqT = (bfu*)take((size_t)1024 * 1024 * 2);
  p.WgluT = (bfu*)take((size_t)512 * 512 * 2);
  p.K1 = (bfu*)take(65536 * 2);
  p.K2 = (bfu*)take(65536 * 2);
  p.mod = (float*)take((size_t)NSQ * 6144 * 4);
  p.rs1 = (float*)take(NTOK * 4);
  p.lbre = (float*)take(2048 * 4); p.lbim = (float*)take(2048 * 4);
  p.lbLre = (float*)take(2048 * 4); p.lbLim = (float*)take(2048 * 4);
  p.BBre = (float*)take(32768 * 4); p.BBim = (float*)take(32768 * 4);
  p.BON = (float*)take((size_t)NTOK * 8 * 4);
  p.BONX = (float*)take((size_t)NTOK * 8 * 4);
  p.w2T = (bfu*)take(512 * 64 * 2); p.a2T = (bfu*)take(512 * 64 * 2); p.g2T = (bfu*)take(512 * 128 * 2);
  p.BBh = (bfu*)take(32 * 128 * 16 * 2); p.CCh = (bfu*)take(32 * 16 * 128 * 2);
  p.E = (float*)take((size_t)8 * 32 * 32 * 128 * 4);
  unsigned char* regC = take((size_t)NTOK * INC * 2);
  p.PJ = (bfu*)regC; p.X1 = (float*)regC;
  unsigned char* regDE = take((size_t)NTOK * 1024 * 2);
  p.LD = (bfu*)regDE; p.AA = (bfu*)(regDE + (size_t)NTOK * 512 * 2); p.Q = (bfu*)regDE;
  unsigned char* regF = take((size_t)NTOK * 128 * 8);
  p.GG = (bfu*)regF; p.EI = (unsigned*)regF; p.EG = (float*)(regF + (size_t)NTOK * 128 * 4);
  unsigned char* regY = take((size_t)NTOK * 512 * 4);
  p.Y5 = (float*)regY; p.H2 = (bfu*)regY; p.H1 = (bfu*)regY; p.CAT = (bfu*)regDE;
  if (off > ws_size) { fprintf(stderr, "workspace too small: need %zu have %zu\n", off, ws_size); return; }
  p.never = 0;

  (void)hipMemsetAsync(p.bar, 0, XCD_BAR_WORDS * 4, stream);
  (void)hipMemsetAsync(p.mod, 0, (size_t)NSQ * 6144 * 4, stream);
#if MULTI
  const int G = 512;
  phase_kernel<0><<<G, NT, 0, stream>>>(p);
  phase_kernel<1><<<G, NT, 0, stream>>>(p);
  phase_kernel<2><<<G, NT, 0, stream>>>(p);
  phase_kernel<3><<<G, NT, 0, stream>>>(p);
  phase_kernel<4><<<G, NT, 0, stream>>>(p);
  phase_kernel<5><<<G, NT, 0, stream>>>(p);
  phase_kernel<6><<<G, NT, 0, stream>>>(p);
  phase_kernel<7><<<G, NT, 0, stream>>>(p);
  phase_kernel<8><<<G, NT, 0, stream>>>(p);
  phase_kernel<9><<<G, NT, 0, stream>>>(p);
#else
  static int grid_blocks = 0;
  if (!grid_blocks) {
    int dev = 0, cus = 0, per_cu = 0;
    hipGetDevice(&dev);
    hipDeviceGetAttribute(&cus, hipDeviceAttributeMultiprocessorCount, dev);
    hipOccupancyMaxActiveBlocksPerMultiprocessor(&per_cu, mega_kernel, NT, 0);
    if (per_cu > 2) per_cu = 2;
    if (per_cu < 1) per_cu = 1;
    grid_blocks = cus * per_cu;
  }
  void* args[] = {&p};
  hipError_t e = hipLaunchCooperativeKernel((void*)mega_kernel, dim3(grid_blocks), dim3(NT), args, 0, stream);
  if (e != hipSuccess) fprintf(stderr, "cooperative launch failed: %s (grid %d)\n", hipGetErrorString(e), grid_blocks);
#endif
}
```

```cpp
#include <hip/hip_runtime.h>
#include <hip/hip_cooperative_groups.h>
#include <stdint.h>
#include <stdio.h>
#include <string.h>
namespace cg = cooperative_groups;

#ifndef MULTI
#define MULTI 0
#endif
#ifndef DUP
#define DUP -1
#endif

typedef unsigned short bfu;
using bf16x8 = __attribute__((ext_vector_type(8))) short;
using f32x16 = __attribute__((ext_vector_type(16))) float;

constexpr int NTOK = 17408, NPT = 16384, NSQ = 136, DM = 1024, INC = 2304, RC = 1792;
constexpr int O_S5RE_P = 17825792, O_S5IM_P = 17842176, O_WKV_P = 17858560, O_SH_P = 18120704;
constexpr int O_S5RE_S = 18135040, O_S5IM_S = 18397184, O_WKV_S = 18659328, O_SH_S = 22853632;
constexpr float NORM_EPS = 1e-6f, GN_EPS = 64e-5f;
constexpr int NT = 256;
constexpr int LDS_BYTES = 75776;
constexpr int LDS_JOB = LDS_BYTES - 16;

struct Params {
  const float *xp, *xs, *s5re0, *s5im0, *wkv0, *shift0, *cp, *cs, *w_ada, *b_ada, *n1g, *n2g, *w_in, *w_out;
  const float *s5are, *s5aim, *s5ldt, *s5bre, *s5bim, *s5cre, *s5cim, *s5d, *w_glu, *b_glu;
  const float *mu, *w0, *w2, *a0, *a2, *g2, *k_k, *k_a, *r_k, *gn_w, *gn_b, *w_q, *keys1, *keys2, *pu, *pv, *fng;
  float* out;
  unsigned char *TU, *TV; float *SU, *SV;
  bfu *WinT, *WoutT, *WqT, *WgluT, *K1, *K2;
  float *mod, *rs1, *lbre, *lbim, *lbLre, *lbLim, *BBre, *BBim;
  bfu* PJ; float* X1; bfu *LD, *AA, *GG; float* Y5; bfu *Q, *H2; unsigned* EI; float* EG; float* BON; float* BONX; bfu *H1, *CAT; bfu *w2T, *a2T, *g2T, *BBh, *CCh; float* E;
  unsigned* bar;
  int never; int pad_;
};

__device__ __forceinline__ bfu f2bf(float f) { unsigned u = __float_as_uint(f); u += 0x7fffu + ((u >> 16) & 1u); return (bfu)(u >> 16); }
__device__ __forceinline__ float bf2f(bfu h) { return __uint_as_float(((unsigned)h) << 16); }
__device__ __forceinline__ unsigned pk2(float a, float b) { return (unsigned)f2bf(a) | ((unsigned)f2bf(b) << 16); }
__device__ __forceinline__ float bflo(unsigned u) { return __uint_as_float(u << 16); }
__device__ __forceinline__ float bfhi(unsigned u) { return __uint_as_float(u & 0xffff0000u); }
__device__ __forceinline__ int sq_of(int tok) { return tok < NPT ? (tok >> 11) : 8 + ((tok - NPT) >> 3); }
__device__ __forceinline__ int t_of(int tok) { return tok < NPT ? (tok & 2047) : ((tok - NPT) & 7); }
__device__ __forceinline__ const float* xrow(const Params& p, int tok) { return tok < NPT ? p.xp + (size_t)tok * DM : p.xs + (size_t)(tok - NPT) * DM; }
__device__ __forceinline__ float sigmoidf_(float x) { return 1.f / (1.f + __expf(-x)); }
__device__ __forceinline__ float gelu_(float x) { return 0.5f * x * (1.f + erff(x * 0.70710678118654752f)); }

#define XB_TMO 128
#define XB_XCNT(j) (256 + 64 * (j))
#define XB_XSUB(j) (1280 + 64 * (j))
#define XB_XGEN(j) (2304 + 64 * (j))
#define XB_TOP 3328
#define XB_TOPGEN 3392
#define XCD_BAR_WORDS 3456
#define XB_SPIN_CAP (1u << 22)
#define LAS __attribute__((address_space(3)))
__device__ __forceinline__ unsigned xb_ld(unsigned* p) { return __hip_atomic_load(p, __ATOMIC_RELAXED, __HIP_MEMORY_SCOPE_AGENT); }
__device__ __forceinline__ unsigned xb_add(unsigned* p, unsigned v) { return __hip_atomic_fetch_add(p, v, __ATOMIC_RELAXED, __HIP_MEMORY_SCOPE_AGENT); }
__device__ __forceinline__ unsigned xb_xcc_id() { return (unsigned)__builtin_amdgcn_s_getreg((3 << 11) | 20) & 0xFu; }
#define XB_SPIN(cond, bar) do { unsigned _sp = 0; while (cond) { __builtin_amdgcn_s_sleep(1); \
    if ((++_sp & 255u) == 0u) { if (xb_ld(&(bar)[XB_TMO])) break; if (_sp > XB_SPIN_CAP) { atomicAdd(&(bar)[XB_TMO], 1u); break; } } } } while (0)
struct XcdBarrier { unsigned* bar; unsigned x; volatile unsigned* st; };
__device__ __forceinline__ XcdBarrier xcd_barrier_post(unsigned* bar, volatile unsigned* st) {
  XcdBarrier b; b.bar = bar; b.x = xb_xcc_id(); b.st = st;
  if (threadIdx.x == 0) (void)xb_add(&bar[XB_XCNT(b.x)], 1u);
  return b;
}
__device__ __forceinline__ void xcd_barrier_complete(unsigned* bar, unsigned x, unsigned& nloc, unsigned& nx) {
  const unsigned G = gridDim.x;
  unsigned sum, cnt, mine, sp = 0u;
  for (;;) {
    sum = 0u; cnt = 0u; mine = 0u;
#pragma unroll
    for (unsigned j = 0; j < 16; ++j) { const unsigned c = xb_ld(&bar[XB_XCNT(j)]); sum += c; cnt += (c > 0u) ? 1u : 0u; mine = (j == x) ? c : mine; }
    if (sum == G) break;
    __builtin_amdgcn_s_sleep(1);
    if ((++sp & 255u) == 0u) { if (xb_ld(&bar[XB_TMO])) break; if (sp > XB_SPIN_CAP) { atomicAdd(&bar[XB_TMO], 1u); break; } }
  }
  nloc = mine > 0u ? mine : 1u; nx = cnt > 0u ? cnt : 1u;
}
__device__ __forceinline__ void xcd_barrier(const XcdBarrier& b) {
  asm volatile("s_waitcnt vmcnt(0)" ::: "memory");
  __syncthreads();
  if (threadIdx.x == 0) {
    unsigned* bar = b.bar;
    __builtin_amdgcn_s_waitcnt(0);
    unsigned nloc = b.st[0], nx = b.st[1];
    if (nloc == 0u) { xcd_barrier_complete(bar, b.x, nloc, nx); b.st[0] = nloc; b.st[1] = nx; }
    const unsigned old = xb_add(&bar[XB_XSUB(b.x)], 1u);
    const unsigned gen = old / nloc;
    if (old + 1u == (gen + 1u) * nloc) {
      __builtin_amdgcn_fence(__ATOMIC_RELEASE, "agent");
      asm volatile("s_waitcnt vmcnt(0)" ::: "memory");
      const unsigned og = xb_add(&bar[XB_TOP], 1u);
      const unsigned tg = og / nx;
      if (og + 1u == (tg + 1u) * nx) xb_add(&bar[XB_TOPGEN], 1u);
      else XB_SPIN(xb_ld(&bar[XB_TOPGEN]) == tg, bar);
      __builtin_amdgcn_fence(__ATOMIC_ACQUIRE, "agent");
      xb_add(&bar[XB_XGEN(b.x)], 1u);
      asm volatile("s_waitcnt vmcnt(0)" ::: "memory");
    } else {
      XB_SPIN(xb_ld(&bar[XB_XGEN(b.x)]) == gen, bar);
      __builtin_amdgcn_fence(__ATOMIC_ACQUIRE, "agent");
      asm volatile("s_waitcnt vmcnt(0)" ::: "memory");
    }
  }
  __syncthreads();
}

struct U4x4 { uint4 a, b, c, d; };
constexpr int GLD = 144;
template <class AL, class EP>
__device__ __forceinline__ void gemm_tile(int m0, int n0, int K, const bfu* __restrict__ Bt, AL al, EP ep, unsigned char* lds) {
  constexpr int BUF = 256 * GLD;
  const int tid = threadIdx.x, lane = tid & 63, wid = tid >> 6;
  const int wr = wid >> 1, wc = wid & 1;
  const int l31 = lane & 31, lh = lane >> 5;
  f32x16 acc[2][2];
#pragma unroll
  for (int i = 0; i < 2; ++i)
#pragma unroll
    for (int j = 0; j < 2; ++j)
#pragma unroll
      for (int r = 0; r < 16; ++r) acc[i][j][r] = 0.f;
  const int srow = tid >> 1, sk = (tid & 1) * 32;
  uint4 av0, av1, av2, av3, bv0, bv1, bv2, bv3;
  auto gl = [&](int k0) {
    al(m0 + srow, k0 + sk, av0, av1, av2, av3);
    const uint4* bp = (const uint4*)(Bt + (size_t)(n0 + srow) * K + k0 + sk);
    bv0 = bp[0]; bv1 = bp[1]; bv2 = bp[2]; bv3 = bp[3];
  };
  auto st = [&](int buf) {
    uint4* da = (uint4*)(lds + buf * BUF + srow * GLD + sk * 2);
    uint4* db = (uint4*)(lds + buf * BUF + 128 * GLD + srow * GLD + sk * 2);
    da[0] = av0; da[1] = av1; da[2] = av2; da[3] = av3;
    db[0] = bv0; db[1] = bv1; db[2] = bv2; db[3] = bv3;
  };
  gl(0);
  __syncthreads();
  st(0);
  if (64 < K) gl(64);
  __syncthreads();
  const int nk = K >> 6;
  for (int kt = 0; kt < nk; ++kt) {
    const unsigned char* ldsA = lds + (kt & 1) * BUF;
    const unsigned char* ldsB = ldsA + 128 * GLD;
    if (kt + 1 < nk) st((kt + 1) & 1);
    if (kt + 2 < nk) gl((kt + 2) * 64);
#pragma unroll
    for (int s = 0; s < 4; ++s) {
      const bf16x8 af0 = *(const bf16x8*)(ldsA + (wr * 64 + l31) * GLD + s * 32 + lh * 16);
      const bf16x8 af1 = *(const bf16x8*)(ldsA + (wr * 64 + 32 + l31) * GLD + s * 32 + lh * 16);
      const bf16x8 bf0 = *(const bf16x8*)(ldsB + (wc * 64 + l31) * GLD + s * 32 + lh * 16);
      const bf16x8 bf1 = *(const bf16x8*)(ldsB + (wc * 64 + 32 + l31) * GLD + s * 32 + lh * 16);
      acc[0][0] = __builtin_amdgcn_mfma_f32_32x32x16_bf16(af0, bf0, acc[0][0], 0, 0, 0);
      acc[0][1] = __builtin_amdgcn_mfma_f32_32x32x16_bf16(af0, bf1, acc[0][1], 0, 0, 0);
      acc[1][0] = __builtin_amdgcn_mfma_f32_32x32x16_bf16(af1, bf0, acc[1][0], 0, 0, 0);
      acc[1][1] = __builtin_amdgcn_mfma_f32_32x32x16_bf16(af1, bf1, acc[1][1], 0, 0, 0);
    }
    __syncthreads();
  }
  {
    float* ct = (float*)lds;
#pragma unroll
    for (int i = 0; i < 2; ++i)
#pragma unroll
      for (int j = 0; j < 2; ++j)
#pragma unroll
        for (int r = 0; r < 16; ++r)
          ct[(wr * 64 + i * 32 + (r & 3) + 8 * (r >> 2) + 4 * lh) * 132 + wc * 64 + j * 32 + l31] = acc[i][j][r];
    __syncthreads();
#pragma unroll 4
    for (int it = 0; it < 16; ++it) {
      const int idx = it * NT + tid, rl = idx >> 5, c4 = (idx & 31) * 4;
      ep(m0 + rl, n0 + c4, *(const float4*)(ct + rl * 132 + c4));
    }
  }
  __syncthreads();
}

__device__ void phase0(const Params& p, unsigned char* lds) {
  const int tid = threadIdx.x, G = gridDim.x, gtid = blockIdx.x * NT + tid, gsz = G * NT;
  {
    const int lane = tid & 63, l31 = lane & 31, gw = gtid >> 6, nw = gsz >> 6;
    for (int rp = gw; rp < 16384; rp += nw) {
      const int r = rp * 2 + (lane >> 5);
      const bool isv = r >= 16384;
      const int row = r & 16383;
      const float4* src = (const float4*)((isv ? p.pv : p.pu) + (size_t)row * 1024 + l31 * 4);
      float x[32];
#pragma unroll
      for (int i = 0; i < 8; ++i) { const float4 v = src[i * 32]; x[i * 4] = v.x; x[i * 4 + 1] = v.y; x[i * 4 + 2] = v.z; x[i * 4 + 3] = v.w; }
      float m = 0.f;
#pragma unroll
      for (int i = 0; i < 32; ++i) m = fmaxf(m, fabsf(x[i]));
#pragma unroll
      for (int o = 16; o > 0; o >>= 1) m = fmaxf(m, __shfl_xor(m, o));
      if (!isv) {
        const float sc4 = m > 0.f ? 6.f / m : 1.f;
        unsigned wq[4] = {0u, 0u, 0u, 0u};
#pragma unroll
        for (int i = 0; i < 32; ++i) {
          const float a_ = fabsf(x[i]) * sc4;
          const unsigned code = (unsigned)(a_ >= 0.25f) + (unsigned)(a_ >= 0.75f) + (unsigned)(a_ >= 1.25f) + (unsigned)(a_ >= 1.75f) +
                                (unsigned)(a_ >= 2.5f) + (unsigned)(a_ >= 3.5f) + (unsigned)(a_ >= 5.f);
          wq[i >> 3] |= (code | (x[i] < 0.f ? 8u : 0u)) << (4 * (i & 7));
        }
        *(uint4*)(p.TU + (size_t)row * 512 + l31 * 16) = make_uint4(wq[0], wq[1], wq[2], wq[3]);
        if (l31 == 0) p.SU[row] = m > 0.f ? m * (1.f / 6.f) : 1.f;
        continue;
      }
      const float sc = m > 0.f ? 7.5f / m : 1.f;
      unsigned long long w0 = 0ull, w1 = 0ull, w2 = 0ull;
#pragma unroll
      for (int i = 0; i < 32; ++i) {
        const float a_ = fminf(fabsf(x[i]) * sc, 7.5f);
        int code;
        if (a_ < 2.f) code = __float2int_rn(a_ * 8.f);
        else if (a_ < 4.f) code = 8 + __float2int_rn(a_ * 4.f);
        else code = 16 + __float2int_rn(a_ * 2.f);
        code = min(code, 31);
        const unsigned long long c6 = (unsigned long long)((unsigned)code | (x[i] < 0.f ? 32u : 0u));
        const int bit = 6 * i, wi = bit >> 6, sh = bit & 63;
        if (wi == 0) w0 |= c6 << sh; else if (wi == 1) w1 |= c6 << sh; else w2 |= c6 << sh;
        if (sh > 58) { if (wi == 0) w1 |= c6 >> (64 - sh); else if (wi == 1) w2 |= c6 >> (64 - sh); }
      }
      unsigned char* dst = p.TV + (size_t)row * 768;
      *(uint4*)(dst + l31 * 16) = make_uint4((unsigned)w0, (unsigned)(w0 >> 32), (unsigned)w1, (unsigned)(w1 >> 32));
      *(uint2*)(dst + 512 + l31 * 8) = make_uint2((unsigned)w2, (unsigned)(w2 >> 32));
      if (l31 == 0) p.SV[row] = m > 0.f ? m * (1.f / 7.5f) : 1.f;
    }
  }
  for (int i = gtid; i < 65536; i += gsz) { p.K1[i] = f2bf(p.keys1[i]); p.K2[i] = f2bf(p.keys2[i]); }
  {
    auto tr = [&](const float* __restrict__ src, bfu* __restrict__ dst, const int K, const int N) {
      for (int i = gtid; i < N * (K / 8); i += gsz) {
        const int n = i % N, k8 = i / N;
        float v[8];
#pragma unroll
        for (int j = 0; j < 8; ++j) v[j] = src[(size_t)(k8 * 8 + j) * N + n];
        *(uint4*)(dst + (size_t)n * K + k8 * 8) = make_uint4(pk2(v[0], v[1]), pk2(v[2], v[3]), pk2(v[4], v[5]), pk2(v[6], v[7]));
      }
    };
    tr(p.w_in, p.WinT, 1024, 2304);
    tr(p.w_out, p.WoutT, 1024, 1024);
    tr(p.w_q, p.WqT, 1024, 1024);
    tr(p.w_glu, p.WgluT, 512, 512);
    tr(p.w2, p.w2T, 64, 512);
    tr(p.a2, p.a2T, 64, 512);
    tr(p.g2, p.g2T, 128, 512);
  }
  for (int i = gtid; i < 2048; i += gsz) {
    const int g = i >> 6;
    const float dt = expf(p.s5ldt[g]);
    const float lre = p.s5are[i], lim = p.s5aim[i];
    const float mag = expf(lre * dt), ang = lim * dt;
    float sn, cs; sincosf(ang, &sn, &cs);
    const float lbr = mag * cs, lbi = mag * sn;
    p.lbre[i] = lbr; p.lbim[i] = lbi;
    float pr = lbr, pi = lbi;
#pragma unroll
    for (int s = 0; s < 6; ++s) { const float nr = pr * pr - pi * pi, ni = 2.f * pr * pi; pr = nr; pi = ni; }
    p.lbLre[i] = pr; p.lbLim[i] = pi;
    const float den = lre * lre + lim * lim;
    const float nre = lbr - 1.f, nim = lbi;
    const float cr = (nre * lre + nim * lim) / den, ci = (nim * lre - nre * lim) / den;
#pragma unroll
    for (int h = 0; h < 16; ++h) {
      const float br = p.s5bre[i * 16 + h], bi = p.s5bim[i * 16 + h];
      p.BBh[(g * 128 + (i & 63)) * 16 + h] = f2bf(cr * br - ci * bi);
      p.BBh[(g * 128 + 64 + (i & 63)) * 16 + h] = f2bf(cr * bi + ci * br);
    }
  }
  for (int i = gtid; i < 32 * 16 * 64; i += gsz) {
    const int gh = i >> 6, k = i & 63;
    p.CCh[gh * 128 + k] = f2bf(p.s5cre[i]);
    p.CCh[gh * 128 + 64 + k] = f2bf(-p.s5cim[i]);
  }
  {
    float* sc = (float*)lds;
    for (int it = blockIdx.x; it < 17 * 24 * 4; it += G) {
      const int kp = it & 3, slab = (it >> 2) % 24, sg = (it >> 2) / 24;
      __syncthreads();
      for (int i = tid; i < 8 * 256; i += NT) {
        const int sq = sg * 8 + (i >> 8), k = kp * 256 + (i & 255);
        const float c = sq < 8 ? p.cp[sq * 1024 + k] : p.cs[(sq - 8) * 1024 + k];
        sc[i] = c / (1.f + __expf(-c));
      }
      __syncthreads();
      const int col = slab * 256 + tid;
      float acc[8];
#pragma unroll
      for (int i = 0; i < 8; ++i) acc[i] = 0.f;
      const float* wp = p.w_ada + (size_t)(kp * 256) * 6144 + col;
#pragma unroll 4
      for (int k = 0; k < 256; k += 4) {
        float w[4];
#pragma unroll
        for (int j = 0; j < 4; ++j) w[j] = wp[(size_t)(k + j) * 6144];
#pragma unroll
        for (int i = 0; i < 8; ++i) {
          const float4 s4 = *(const float4*)(sc + i * 256 + k);
          acc[i] += s4.x * w[0] + s4.y * w[1] + s4.z * w[2] + s4.w * w[3];
        }
      }
      const float bb = kp == 0 ? p.b_ada[col] : 0.f;
#pragma unroll
      for (int i = 0; i < 8; ++i) atomicAdd(&p.mod[(size_t)(sg * 8 + i) * 6144 + col], acc[i] + bb);
    }
    __syncthreads();
  }
}

__device__ void phase1(const Params& p, unsigned char* lds) {
  const int ntile = 136 * 18;
  for (int t = blockIdx.x; t < ntile; t += gridDim.x) {
    const int mt = t / 18, nt = t % 18;
    auto al = [&](int row, int k, uint4& o0, uint4& o1, uint4& o2, uint4& o3) {
      const uint4* s_ = (const uint4*)(p.H1 + (size_t)row * 1024 + k);
      o0 = s_[0]; o1 = s_[1]; o2 = s_[2]; o3 = s_[3];
    };
    auto ep = [&](int row, int col, float4 v) {
      *(uint2*)(p.PJ + (size_t)row * INC + col) = make_uint2(pk2(v.x, v.y), pk2(v.z, v.w));
      if (col >= 512) {
        if (row < NPT) { if ((row & 2047) == 2047) *(float4*)(p.out + O_SH_P + (row >> 11) * RC + col - 512) = v; }
        else { const int r = row - NPT; if ((r & 7) == 7) *(float4*)(p.out + O_SH_S + (r >> 3) * RC + col - 512) = v; }
      }
    };
    gemm_tile(mt * 128, nt * 128, 1024, p.WinT, al, ep, lds);
  }
}

struct Cx { float r, i; };
__device__ __forceinline__ Cx cfma(const Cx a, const Cx b, const Cx c) { Cx o; o.r = a.r * b.r - a.i * b.i + c.r; o.i = a.r * b.i + a.i * b.r + c.i; return o; }
using f32x4 = __attribute__((ext_vector_type(4))) float;
constexpr int HIMG = 272;
template <int MT, bool OUT>
__device__ __forceinline__ void s5_chunk(const Params& p, const int tok0, const int nvalid, const int g, Cx (&st)[2], const int Gend,
                                         unsigned char* himg, const int lane) {
  const int c = lane & 31, half = lane >> 5;
  Cx l1[2], l2[2], l3[2], l4[2];
#pragma unroll
  for (int s = 0; s < 2; ++s) {
    const int gp = g * 64 + 32 * s + c;
    l1[s].r = p.lbre[gp]; l1[s].i = p.lbim[gp];
    const Cx z = {0.f, 0.f};
    l2[s] = cfma(l1[s], l1[s], z); l3[s] = cfma(l2[s], l1[s], z); l4[s] = cfma(l2[s], l2[s], z);
  }
  bf16x8 bfr[4];
#pragma unroll
  for (int nt = 0; nt < 4; ++nt) bfr[nt] = *(const bf16x8*)(p.BBh + ((size_t)(g * 128 + 32 * nt + c)) * 16 + 8 * half);
  bf16x8 cfr[4];
  float dsk = 0.f;
  if (OUT) {
#pragma unroll
    for (int ks = 0; ks < 4; ++ks) cfr[ks] = *(const bf16x8*)(p.CCh + ((size_t)(g * 16 + (lane & 15))) * 128 + 32 * ks + 8 * (lane >> 4));
    dsk = p.s5d[g * 16 + (lane & 15)];
  }
  Cx endst[2] = {st[0], st[1]};
#pragma unroll
  for (int mt = 0; mt < MT; ++mt) {
    bf16x8 af;
#pragma unroll
    for (int j = 0; j < 8; ++j) af[j] = 0;
    if (32 * mt + c < nvalid) af = *(const bf16x8*)(p.PJ + (size_t)(tok0 + 32 * mt + c) * INC + g * 16 + 8 * half);
#pragma unroll
    for (int s = 0; s < 2; ++s) {
      f32x16 bre, bim;
#pragma unroll
      for (int r = 0; r < 16; ++r) { bre[r] = 0.f; bim[r] = 0.f; }
      bre = __builtin_amdgcn_mfma_f32_32x32x16_bf16(af, bfr[s], bre, 0, 0, 0);
      bim = __builtin_amdgcn_mfma_f32_32x32x16_bf16(af, bfr[2 + s], bim, 0, 0, 0);
      Cx e[4], pe[4];
#pragma unroll
      for (int q = 0; q < 4; ++q) {
        Cx x; x.r = bre[4 * q]; x.i = bim[4 * q];
#pragma unroll
        for (int i = 1; i < 4; ++i) { Cx b_; b_.r = bre[4 * q + i]; b_.i = bim[4 * q + i]; x = cfma(l1[s], x, b_); bre[4 * q + i] = x.r; bim[4 * q + i] = x.i; }
        e[q] = x;
      }
#pragma unroll
      for (int q = 0; q < 4; ++q) { pe[q].r = __shfl_xor(e[q].r, 32); pe[q].i = __shfl_xor(e[q].i, 32); }
      Cx carry = st[s];
      Cx cin[4];
#pragma unroll
      for (int q = 0; q < 4; ++q) {
        const Cx ee = half ? pe[q] : e[q];
        const Cx eo = half ? e[q] : pe[q];
        const Cx cin_e = carry;
        carry = cfma(l4[s], carry, ee);
        if (8 * mt + 2 * q == Gend) endst[s] = carry;
        const Cx cin_o = carry;
        carry = cfma(l4[s], carry, eo);
        if (8 * mt + 2 * q + 1 == Gend) endst[s] = carry;
        cin[q] = half ? cin_o : cin_e;
      }
      st[s] = carry;
      if (OUT) {
        bfu* hi16 = (bfu*)himg;
#pragma unroll
        for (int q = 0; q < 4; ++q)
#pragma unroll
          for (int i = 0; i < 4; ++i) {
            const Cx lp = i == 0 ? l1[s] : (i == 1 ? l2[s] : (i == 2 ? l3[s] : l4[s]));
            Cx b_; b_.r = bre[4 * q + i]; b_.i = bim[4 * q + i];
            const Cx h = cfma(lp, cin[q], b_);
            const int tl = i + 8 * q + 4 * half;
            hi16[tl * (HIMG / 2) + 32 * s + c] = f2bf(h.r);
            hi16[tl * (HIMG / 2) + 64 + 32 * s + c] = f2bf(h.i);
          }
      }
    }
    if (OUT) {
      __builtin_amdgcn_wave_barrier();
#pragma unroll
      for (int rt = 0; rt < 2; ++rt) {
        f32x4 acc = {0.f, 0.f, 0.f, 0.f};
#pragma unroll
        for (int ks = 0; ks < 4; ++ks) {
          const bf16x8 a_ = *(const bf16x8*)(himg + (16 * rt + (lane & 15)) * HIMG + (32 * ks + 8 * (lane >> 4)) * 2);
          acc = __builtin_amdgcn_mfma_f32_16x16x32_bf16(a_, cfr[ks], acc, 0, 0, 0);
        }
#pragma unroll
        for (int r = 0; r < 4; ++r) {
          const int t = 32 * mt + 16 * rt + 4 * (lane >> 4) + r;
          if (t < nvalid) {
            const float u = bf2f(p.PJ[(size_t)(tok0 + t) * INC + g * 16 + (lane & 15)]);
            p.Y5[(size_t)(tok0 + t) * 512 + g * 16 + (lane & 15)] = gelu_(acc[r] + dsk * u);
          }
        }
      }
      __builtin_amdgcn_wave_barrier();
    }
  }
  st[0] = endst[0]; st[1] = endst[1];
}
__device__ void s5_pass_a(const Params& p) {
  const int lane = threadIdx.x & 63, gw = (blockIdx.x * NT + threadIdx.x) >> 6, nw = (gridDim.x * NT) >> 6;
  for (int job = gw; job < 8 * 32 * 32; job += nw) {
    const int c = job & 31, g = (job >> 5) & 31, b = job >> 10;
    Cx st[2] = {{0.f, 0.f}, {0.f, 0.f}};
    s5_chunk<2, false>(p, b * 2048 + c * 64, 64, g, st, 15, nullptr, lane);
    if (lane < 32) {
      float* e = p.E + (size_t)job * 128;
      e[lane] = st[0].r; e[32 + lane] = st[1].r; e[64 + lane] = st[0].i; e[96 + lane] = st[1].i;
    }
  }
}
__device__ void s5_job_c(const Params& p, int bj, bool prompt, unsigned char* lds) {
  const int lane = threadIdx.x & 63, wid = threadIdx.x >> 6;
  unsigned char* himg = lds + wid * (32 * HIMG);
  const int job = bj * 4 + wid;
  const int cc = lane & 31;
  if (prompt) {
    const int c = job & 31, g = (job >> 5) & 31, b = job >> 10;
    Cx L64[2], st[2];
#pragma unroll
    for (int s = 0; s < 2; ++s) { const int gp = g * 64 + 32 * s + cc; L64[s].r = p.lbLre[gp]; L64[s].i = p.lbLim[gp]; st[s].r = 0.f; st[s].i = 0.f; }
    const float* e = p.E + (size_t)(job - c) * 128;
    for (int j = 0; j < c; ++j) {
      Cx e0, e1;
      e0.r = e[j * 128 + cc]; e1.r = e[j * 128 + 32 + cc]; e0.i = e[j * 128 + 64 + cc]; e1.i = e[j * 128 + 96 + cc];
      st[0] = cfma(L64[0], st[0], e0); st[1] = cfma(L64[1], st[1], e1);
    }
    s5_chunk<2, true>(p, b * 2048 + c * 64, 64, g, st, 15, himg, lane);
    if (c == 31 && lane < 32) {
      float* o = p.out + O_S5RE_P + (b * 32 + g) * 64;
      o[lane] = st[0].r; o[32 + lane] = st[1].r;
      o = p.out + O_S5IM_P + (b * 32 + g) * 64;
      o[lane] = st[0].i; o[32 + lane] = st[1].i;
    }
  } else {
    const int g = job & 31, bs = job >> 5;
    Cx st[2];
    const float* r0 = p.s5re0 + ((size_t)bs * 32 + g) * 64;
    const float* i0 = p.s5im0 + ((size_t)bs * 32 + g) * 64;
    st[0].r = r0[cc]; st[1].r = r0[32 + cc]; st[0].i = i0[cc]; st[1].i = i0[32 + cc];
    s5_chunk<1, true>(p, NPT + bs * 8, 8, g, st, 1, himg, lane);
    if (lane < 32) {
      float* o = p.out + O_S5RE_S + ((size_t)bs * 32 + g) * 64;
      o[lane] = st[0].r; o[32 + lane] = st[1].r;
      o = p.out + O_S5IM_S + ((size_t)bs * 32 + g) * 64;
      o[lane] = st[0].i; o[32 + lane] = st[1].i;
    }
  }
}

__device__ __forceinline__ float tanh_fast(float x) { const float e = __expf(2.f * x); return 1.f - 2.f / (e + 1.f); }
template <int WHICH>
__device__ void lora_tiles(const Params& p, unsigned char* lds) {
  constexpr int base = WHICH == 0 ? 1536 : (WHICH == 1 ? 1600 : 1664);
  for (int t = blockIdx.x; t < 136 * 4; t += gridDim.x) {
    const int mt = t >> 2, nt = t & 3;
    auto al = [&](int row, int k, uint4& o0, uint4& o1, uint4& o2, uint4& o3) {
      const bfu* pc = p.PJ + (size_t)row * INC + 512 + base + k;
      const int tt = t_of(row);
      auto one = [&](int i) -> uint4 {
        const uint4 cu = *(const uint4*)(pc + i * 8);
        const float cur[8] = {bflo(cu.x), bfhi(cu.x), bflo(cu.y), bfhi(cu.y), bflo(cu.z), bfhi(cu.z), bflo(cu.w), bfhi(cu.w)};
        float prv[8];
        if (tt == 0) {
          if (row < NPT) {
#pragma unroll
            for (int j = 0; j < 8; ++j) prv[j] = 0.f;
          } else {
            const float4* s0 = (const float4*)(p.shift0 + (size_t)(sq_of(row) - 8) * RC + base + k + i * 8);
            const float4 a = s0[0], b_ = s0[1];
            prv[0] = a.x; prv[1] = a.y; prv[2] = a.z; prv[3] = a.w; prv[4] = b_.x; prv[5] = b_.y; prv[6] = b_.z; prv[7] = b_.w;
          }
        } else {
          const uint4 pu_ = *(const uint4*)(pc - INC + i * 8);
          prv[0] = bflo(pu_.x); prv[1] = bfhi(pu_.x); prv[2] = bflo(pu_.y); prv[3] = bfhi(pu_.y); prv[4] = bflo(pu_.z); prv[5] = bfhi(pu_.z); prv[6] = bflo(pu_.w); prv[7] = bfhi(pu_.w);
        }
        const float4 m0 = *(const float4*)(p.mu + base + k + i * 8), m1 = *(const float4*)(p.mu + base + k + i * 8 + 4);
        const float mm[8] = {m0.x, m0.y, m0.z, m0.w, m1.x, m1.y, m1.z, m1.w};
        float f[8];
#pragma unroll
        for (int j = 0; j < 8; ++j) {
          const float ps = cur[j] + (prv[j] - cur[j]) * mm[j];
          f[j] = WHICH == 0 ? tanh_fast(ps) : (WHICH == 1 ? ps : sigmoidf_(ps));
        }
        return make_uint4(pk2(f[0], f[1]), pk2(f[2], f[3]), pk2(f[4], f[5]), pk2(f[6], f[7]));
      };
      o0 = one(0); o1 = one(1); o2 = one(2); o3 = one(3);
    };
    auto ep = [&](int row, int col, float4 v4) {
      const size_t o = (size_t)row * 512 + col;
      const float v[4] = {v4.x, v4.y, v4.z, v4.w};
      float f[4];
      if (WHICH == 0) {
        const float4 w0 = *(const float4*)(p.w0 + col);
        const float ww[4] = {w0.x, w0.y, w0.z, w0.w};
#pragma unroll
        for (int j = 0; j < 4; ++j) {
          const float z = -(ww[j] + v[j]);
          const float sp = fmaxf(z, 0.f) + __logf(1.f + __expf(-fabsf(z)));
          f[j] = -__expf(-sp - 0.5f);
        }
        *(uint2*)(p.LD + o) = make_uint2(pk2(f[0], f[1]), pk2(f[2], f[3]));
      } else if (WHICH == 1) {
        const float4 a0 = *(const float4*)(p.a0 + col);
        const float aa[4] = {a0.x, a0.y, a0.z, a0.w};
#pragma unroll
        for (int j = 0; j < 4; ++j) f[j] = sigmoidf_(aa[j] + v[j]);
        *(uint2*)(p.AA + o) = make_uint2(pk2(f[0], f[1]), pk2(f[2], f[3]));
      } else {
        *(uint2*)(p.GG + o) = make_uint2(pk2(v[0], v[1]), pk2(v[2], v[3]));
      }
    };
    gemm_tile(mt * 128, nt * 128, WHICH == 2 ? 128 : 64, WHICH == 0 ? p.w2T : (WHICH == 1 ? p.a2T : p.g2T), al, ep, lds);
  }
}
__device__ void phase2(const Params& p, unsigned char* lds) {
  lora_tiles<0>(p, lds);
  lora_tiles<1>(p, lds);
  lora_tiles<2>(p, lds);
  s5_pass_a(p);
}

template <int CTRL>
__device__ __forceinline__ float dppf(float x) { return __uint_as_float((unsigned)__builtin_amdgcn_update_dpp(0, (int)__float_as_uint(x), CTRL, 0xf, 0xf, true)); }
template <int LPR>
__device__ __forceinline__ float red_lpr(float x) {
  x += dppf<0xB1>(x); x += dppf<0x4E>(x);
  if (LPR == 16) { x += dppf<0x141>(x); x += dppf<0x140>(x); }
  return x;
}
struct RwVec { float4 w, kk, b, k, r; };
template <int LPR, bool PROMPT>
__device__ void rwkv_job(const Params& p, int sq, int h, int rg, unsigned char* lds) {
  constexpr int ROWS = NT / LPR, KPL = 64 / LPR, NV = KPL / 4;
  float* Lr = (float*)lds;
  float* Lw = Lr + 17 * 64;
  float* Lk = Lw + 17 * 64;
  float* Lkk = Lk + 17 * 64;
  float* Lb = Lkk + 17 * 64;
  float* Lv = Lb + 17 * 64;
  float* Lyp0 = Lv + 17 * 64;
  const int tid = threadIdx.x;
  constexpr bool prompt = PROMPT;
  constexpr int T = PROMPT ? 2048 : 8;
  const int tokbase = prompt ? sq * 2048 : NPT + (sq - 8) * 8;
  const int row = tid / LPR, kq = tid % LPR;
  const int grow = rg * ROWS + row;
  float S[KPL];
  if (prompt) {
#pragma unroll
    for (int j = 0; j < KPL; ++j) S[j] = 0.f;
  } else {
    const float* s0 = p.wkv0 + (((size_t)(sq - 8) * 8 + h) * 64 + grow) * 64 + kq * KPL;
#pragma unroll
    for (int j = 0; j < NV; ++j) { const float4 v = ((const float4*)s0)[j]; S[j * 4] = v.x; S[j * 4 + 1] = v.y; S[j * 4 + 2] = v.z; S[j * 4 + 3] = v.w; }
  }
  const int tt = tid >> 4, kg = tid & 15, k4 = kg * 4;
  const int hc = h * 64 + k4;
  float mur[4], muk[4], muv[4], kkc[4], kac[4], rkc[4];
#pragma unroll
  for (int j = 0; j < 4; ++j) {
    mur[j] = p.mu[hc + j]; muk[j] = p.mu[512 + hc + j]; muv[j] = p.mu[1024 + hc + j];
    kkc[j] = p.k_k[hc + j]; kac[j] = p.k_a[hc + j]; rkc[j] = p.r_k[hc + j];
  }
  uint2 Acr, Ack, Acv, Aqr, Aqk, Aqv, Ald, Aaa;
  uint2 Bcr, Bck, Bcv, Bqr, Bqk, Bqv, Bld, Baa;
  auto gload = [&](int c0, uint2& cr, uint2& ck, uint2& cv, uint2& qr, uint2& qk, uint2& qv, uint2& ldv, uint2& aav) {
    const int cc0 = PROMPT ? min(c0, T - 16) : 0;
    const int nst = PROMPT ? 16 : 8;
    const int t = cc0 + (tt < nst ? tt : 0);
    const int tok = tokbase + t;
    const bfu* pc = p.PJ + (size_t)tok * INC + 512 + hc;
    const bfu* pp = pc - (t > 0 ? INC : 0);
    cr = *(const uint2*)(pc); ck = *(const uint2*)(pc + 512); cv = *(const uint2*)(pc + 1024);
    qr = *(const uint2*)(pp); qk = *(const uint2*)(pp + 512); qv = *(const uint2*)(pp + 1024);
    ldv = *(const uint2*)(p.LD + (size_t)tok * 512 + hc);
    aav = *(const uint2*)(p.AA + (size_t)tok * 512 + hc);
  };
  auto store_y = [&](int c0, const float* Lyp) {
    constexpr int nst = PROMPT ? 16 : 8;
    for (int i = tid; i < nst * ROWS; i += NT) {
      const int s = i / ROWS, rr = i % ROWS;
      const float4* yp = (const float4*)(Lyp + (size_t)i * LPR);
      float y = 0.f;
#pragma unroll
      for (int j = 0; j < LPR / 4; ++j) { const float4 v = yp[j]; y += (v.x + v.y) + (v.z + v.w); }
      p.out[(size_t)(tokbase + c0 + s) * 1024 + 512 + h * 64 + rg * ROWS + rr] = y;
    }
  };
  auto process = [&](int c0, int par, uint2& cr, uint2& ck, uint2& cv, uint2& qr, uint2& qk, uint2& qv, uint2& ldv, uint2& aav) {
    float* Lyp = Lyp0 + par * (16 * NT);
    constexpr int nst = PROMPT ? 16 : 8;
    const bool act = PROMPT ? true : (tt < nst);
    const int t = c0 + (act ? tt : 0);
    const int tok = tokbase + t;
    {
      float pr[4], pk_[4], pv_[4];
      if (t == 0) {
        if (prompt) {
#pragma unroll
          for (int j = 0; j < 4; ++j) pr[j] = pk_[j] = pv_[j] = 0.f;
        } else {
          const float* s0 = p.shift0 + (size_t)(sq - 8) * RC + hc;
#pragma unroll
          for (int j = 0; j < 4; ++j) { pr[j] = s0[j]; pk_[j] = s0[512 + j]; pv_[j] = s0[1024 + j]; }
        }
      } else {
        pr[0] = bflo(qr.x); pr[1] = bfhi(qr.x); pr[2] = bflo(qr.y); pr[3] = bfhi(qr.y);
        pk_[0] = bflo(qk.x); pk_[1] = bfhi(qk.x); pk_[2] = bflo(qk.y); pk_[3] = bfhi(qk.y);
        pv_[0] = bflo(qv.x); pv_[1] = bfhi(qv.x); pv_[2] = bflo(qv.y); pv_[3] = bfhi(qv.y);
      }
      const float c_r[4] = {bflo(cr.x), bfhi(cr.x), bflo(cr.y), bfhi(cr.y)};
      const float c_k[4] = {bflo(ck.x), bfhi(ck.x), bflo(ck.y), bfhi(ck.y)};
      const float c_v[4] = {bflo(cv.x), bfhi(cv.x), bflo(cv.y), bfhi(cv.y)};
      const float ld4[4] = {bflo(ldv.x), bfhi(ldv.x), bflo(ldv.y), bfhi(ldv.y)};
      const float aa4[4] = {bflo(aav.x), bfhi(aav.x), bflo(aav.y), bfhi(aav.y)};
      float r4[4], kx4[4], v4[4], w4[4], kk4[4];
      float ssq = 0.f, bon = 0.f;
#pragma unroll
      for (int j = 0; j < 4; ++j) {
        r4[j] = c_r[j] + (pr[j] - c_r[j]) * mur[j];
        const float kx = c_k[j] + (pk_[j] - c_k[j]) * muk[j];
        v4[j] = c_v[j] + (pv_[j] - c_v[j]) * muv[j];
        w4[j] = __expf(ld4[j]);
        kk4[j] = kx * kkc[j];
        ssq += kk4[j] * kk4[j];
        kx4[j] = kx * (1.f + (aa4[j] - 1.f) * kac[j]);
        bon += r4[j] * kx4[j] * rkc[j];
      }
      ssq = red_lpr<16>(ssq); bon = red_lpr<16>(bon);
      const float inv = rsqrtf(fmaxf(ssq, 1e-24f));
      __syncthreads();
      if (act) {
        *(float4*)(Lr + tt * 64 + k4) = make_float4(r4[0], r4[1], r4[2], r4[3]);
        *(float4*)(Lw + tt * 64 + k4) = make_float4(w4[0], w4[1], w4[2], w4[3]);
        *(float4*)(Lk + tt * 64 + k4) = make_float4(kx4[0], kx4[1], kx4[2], kx4[3]);
        *(float4*)(Lkk + tt * 64 + k4) = make_float4(kk4[0] * inv, kk4[1] * inv, kk4[2] * inv, kk4[3] * inv);
        *(float4*)(Lb + tt * 64 + k4) = make_float4(kk4[0] * inv * aa4[0], kk4[1] * inv * aa4[1], kk4[2] * inv * aa4[2], kk4[3] * inv * aa4[3]);
        *(float4*)(Lv + tt * 64 + k4) = make_float4(v4[0], v4[1], v4[2], v4[3]);
        (rg == 0 ? p.BON : p.BONX)[(size_t)tok * 8 + h] = bon;
      }
    }
    __syncthreads();
    if (PROMPT) store_y(max(c0 - 16, 0), Lyp0 + (par ^ 1) * (16 * NT));
    gload(c0 + 32, cr, ck, cv, qr, qk, qv, ldv, aav);
    {
      auto ldvec = [&](int s, int j) -> RwVec {
        RwVec v;
        const int o = s * 64 + kq * KPL + j * 4;
        v.w = *(const float4*)(Lw + o); v.kk = *(const float4*)(Lkk + o); v.b = *(const float4*)(Lb + o);
        v.k = *(const float4*)(Lk + o); v.r = *(const float4*)(Lr + o);
        return v;
      };
      RwVec cur[NV];
      float vcur;
#pragma unroll
      for (int j = 0; j < NV; ++j) cur[j] = ldvec(0, j);
      vcur = Lv[grow];
      for (int s = 0; s < nst; ++s) {
        RwVec nxt[NV];
        float vnx;
#pragma unroll
        for (int j = 0; j < NV; ++j) nxt[j] = ldvec(s + 1, j);
        vnx = Lv[(s + 1) * 64 + grow];
        float sa0 = 0.f, sa1 = 0.f;
#pragma unroll
        for (int j = 0; j < NV; ++j) {
          sa0 += S[j * 4] * cur[j].kk.x; sa1 += S[j * 4 + 1] * cur[j].kk.y;
          sa0 += S[j * 4 + 2] * cur[j].kk.z; sa1 += S[j * 4 + 3] * cur[j].kk.w;
        }
        float tq[KPL];
#pragma unroll
        for (int j = 0; j < NV; ++j) {
          tq[j * 4] = S[j * 4] * cur[j].w.x + vcur * cur[j].k.x;
          tq[j * 4 + 1] = S[j * 4 + 1] * cur[j].w.y + vcur * cur[j].k.y;
          tq[j * 4 + 2] = S[j * 4 + 2] * cur[j].w.z + vcur * cur[j].k.z;
          tq[j * 4 + 3] = S[j * 4 + 3] * cur[j].w.w + vcur * cur[j].k.w;
        }
        float sa = -red_lpr<LPR>(sa0 + sa1);
        float y0 = 0.f, y1 = 0.f;
#pragma unroll
        for (int j = 0; j < NV; ++j) {
          S[j * 4] = tq[j * 4] + sa * cur[j].b.x;
          S[j * 4 + 1] = tq[j * 4 + 1] + sa * cur[j].b.y;
          S[j * 4 + 2] = tq[j * 4 + 2] + sa * cur[j].b.z;
          S[j * 4 + 3] = tq[j * 4 + 3] + sa * cur[j].b.w;
          y0 += S[j * 4] * cur[j].r.x; y1 += S[j * 4 + 1] * cur[j].r.y;
          y0 += S[j * 4 + 2] * cur[j].r.z; y1 += S[j * 4 + 3] * cur[j].r.w;
        }
        Lyp[(s * ROWS + row) * LPR + kq] = y0 + y1;
#pragma unroll
        for (int j = 0; j < NV; ++j) cur[j] = nxt[j];
        vcur = vnx;
      }
    }
  };
  gload(0, Acr, Ack, Acv, Aqr, Aqk, Aqv, Ald, Aaa);
  gload(16, Bcr, Bck, Bcv, Bqr, Bqk, Bqv, Bld, Baa);
  for (int c0 = 0; c0 < T; c0 += 32) {
    process(c0, 0, Acr, Ack, Acv, Aqr, Aqk, Aqv, Ald, Aaa);
    if (PROMPT) process(c0 + 16, 1, Bcr, Bck, Bcv, Bqr, Bqk, Bqv, Bld, Baa);
  }
  __syncthreads();
  {
    const int lastc = ((T - 1) >> 4) << 4;
    store_y(lastc, Lyp0 + ((lastc >> 4) & 1) * (16 * NT));
  }
  {
    float* so = p.out + (prompt ? O_WKV_P + (((size_t)sq * 8 + h) * 64 + grow) * 64 : O_WKV_S + (((size_t)(sq - 8) * 8 + h) * 64 + grow) * 64) + kq * KPL;
#pragma unroll
    for (int j = 0; j < NV; ++j) ((float4*)so)[j] = make_float4(S[j * 4], S[j * 4 + 1], S[j * 4 + 2], S[j * 4 + 3]);
  }
  __syncthreads();
}
__device__ void rwkv_post(const Params& p) {
  const int tid = threadIdx.x;
  const int h = (tid >> 4) & 7, kg = tid & 15, k4 = kg * 4, hc = h * 64 + k4;
  float muv[4], gnw[4], gnb[4];
#pragma unroll
  for (int j = 0; j < 4; ++j) { muv[j] = p.mu[1024 + hc + j]; gnw[j] = p.gn_w[hc + j]; gnb[j] = p.gn_b[hc + j]; }
  for (int it = blockIdx.x; it < NTOK / 2; it += gridDim.x) {
    const int tok = it * 2 + (tid >> 7);
    const int t = t_of(tok);
    const bfu* pc = p.PJ + (size_t)tok * INC + 512 + 1024 + hc;
    const uint2 cv = *(const uint2*)pc;
    float pv_[4];
    if (t == 0) {
      if (tok < NPT) { pv_[0] = pv_[1] = pv_[2] = pv_[3] = 0.f; }
      else { const float* s0 = p.shift0 + (size_t)(sq_of(tok) - 8) * RC + 1024 + hc; pv_[0] = s0[0]; pv_[1] = s0[1]; pv_[2] = s0[2]; pv_[3] = s0[3]; }
    } else {
      const uint2 qv = *(const uint2*)(pc - INC);
      pv_[0] = bflo(qv.x); pv_[1] = bfhi(qv.x); pv_[2] = bflo(qv.y); pv_[3] = bfhi(qv.y);
    }
    const float c_v[4] = {bflo(cv.x), bfhi(cv.x), bflo(cv.y), bfhi(cv.y)};
    float* yp = p.out + (size_t)tok * 1024 + 512 + hc;
    const float4 y4 = *(const float4*)yp;
    const float mean = red_lpr<16>(y4.x + y4.y + y4.z + y4.w) * (1.f / 64.f);
    const float dd[4] = {y4.x - mean, y4.y - mean, y4.z - mean, y4.w - mean};
    const float rstd = rsqrtf(red_lpr<16>(dd[0] * dd[0] + dd[1] * dd[1] + dd[2] * dd[2] + dd[3] * dd[3]) * (1.f / 64.f) + GN_EPS);
    const float bon = p.BON[(size_t)tok * 8 + h];
    const uint2 gv = *(const uint2*)(p.GG + (size_t)tok * 512 + hc);
    const float g4[4] = {bflo(gv.x), bfhi(gv.x), bflo(gv.y), bfhi(gv.y)};
    float o4[4];
#pragma unroll
    for (int j = 0; j < 4; ++j) {
      const float v = c_v[j] + (pv_[j] - c_v[j]) * muv[j];
      o4[j] = (dd[j] * rstd * gnw[j] + gnb[j] + bon * v) * g4[j];
    }
    *(uint2*)(p.CAT + (size_t)tok * 1024 + 512 + hc) = make_uint2(pk2(o4[0], o4[1]), pk2(o4[2], o4[3]));
  }
}

#ifndef P3MODE
#define P3MODE 0
#endif
__device__ void phase3(const Params& p, unsigned char* lds, int cw = 0, int mode = 0) {
  volatile int* jb = (volatile int*)(lds + LDS_JOB);
  for (;;) {
    __syncthreads();
    if (threadIdx.x == 0) *jb = (int)atomicAdd(&p.bar[cw], 1u);
    __syncthreads();
    const int j = *jb;
    if (j >= 4352) break;
    if (j < 256) { if (mode != 1) rwkv_job<16, true>(p, j >> 5, (j >> 2) & 7, j & 3, lds); }
    else if (j < 2304) { if (mode != 2) s5_job_c(p, j - 256, true, lds); }
    else if (j < 3328) { const int q = j - 2304; if (mode != 1) rwkv_job<4, false>(p, 8 + (q >> 3), q & 7, 0, lds); }
    else { if (mode != 2) s5_job_c(p, j - 3328, false, lds); }
  }
}

__device__ void phase4a(const Params& p, unsigned char* lds) {
  rwkv_post(p);
  for (int t = blockIdx.x; t < 136 * 4; t += gridDim.x) {
    const int mt = t >> 2, nt = t & 3;
    auto al = [&](int row, int k, uint4& o0, uint4& o1, uint4& o2, uint4& o3) {
      const float4* s = (const float4*)(p.Y5 + (size_t)row * 512 + k);
      auto one = [&](int i) -> uint4 { const float4 a = s[i * 2], b = s[i * 2 + 1]; return make_uint4(pk2(a.x, a.y), pk2(a.z, a.w), pk2(b.x, b.y), pk2(b.z, b.w)); };
      o0 = one(0); o1 = one(1); o2 = one(2); o3 = one(3);
    };
    auto ep = [&](int row, int col, float4 v) {
      const float4 y = *(const float4*)(p.Y5 + (size_t)row * 512 + col), bg = *(const float4*)(p.b_glu + col);
      *(uint2*)(p.CAT + (size_t)row * 1024 + col) = make_uint2(pk2(y.x * sigmoidf_(v.x + bg.x), y.y * sigmoidf_(v.y + bg.y)), pk2(y.z * sigmoidf_(v.z + bg.z), y.w * sigmoidf_(v.w + bg.w)));
    };
    gemm_tile(mt * 128, nt * 128, 512, p.WgluT, al, ep, lds);
  }
}
__device__ void phase4b(const Params& p, unsigned char* lds) {
  for (int t = blockIdx.x; t < 136 * 8; t += gridDim.x) {
    const int mt = t >> 3, nt = t & 7;
    auto al = [&](int row, int k, uint4& o0, uint4& o1, uint4& o2, uint4& o3) {
      const uint4* s_ = (const uint4*)(p.CAT + (size_t)row * 1024 + k);
      o0 = s_[0]; o1 = s_[1]; o2 = s_[2]; o3 = s_[3];
    };
    auto ep = [&](int row, int col, float4 v) {
      const int sq = sq_of(row);
      const float4 x = *(const float4*)(xrow(p, row) + col), g = *(const float4*)(p.mod + (size_t)sq * 6144 + 2048 + col);
      *(float4*)(p.X1 + (size_t)row * 1024 + col) = make_float4(x.x + g.x * v.x, x.y + g.y * v.y, x.z + g.z * v.z, x.w + g.w * v.w);
    };
    gemm_tile(mt * 128, nt * 128, 1024, p.WoutT, al, ep, lds);
  }
}
template <bool FROMX>
__device__ void norm_rows(const Params& p, const float* __restrict__ gsrc, int sh_off, bfu* __restrict__ dst) {
  const int lane = threadIdx.x & 63, gw = (blockIdx.x * NT + threadIdx.x) >> 6, nw = (gridDim.x * NT) >> 6;
  for (int tok = gw; tok < NTOK; tok += nw) {
    const float* xr = FROMX ? xrow(p, tok) : p.X1 + (size_t)tok * 1024;
    const float* md = p.mod + (size_t)sq_of(tok) * 6144 + sh_off;
    float4 v[4];
    float s = 0.f;
#pragma unroll
    for (int i = 0; i < 4; ++i) { const float4 a = *(const float4*)(xr + lane * 16 + i * 4); v[i] = a; s += a.x * a.x + a.y * a.y + a.z * a.z + a.w * a.w; }
#pragma unroll
    for (int o = 32; o > 0; o >>= 1) s += __shfl_xor(s, o);
    const float rs = rsqrtf(s * (1.f / 1024.f) + NORM_EPS);
    float f[16];
#pragma unroll
    for (int i = 0; i < 4; ++i) {
      const int k = lane * 16 + i * 4;
      const float4 g4 = *(const float4*)(gsrc + k), sh = *(const float4*)(md + k), sc = *(const float4*)(md + 1024 + k);
      const float4 a = v[i];
      f[i * 4 + 0] = a.x * rs * g4.x * (1.f + sc.x) + sh.x;
      f[i * 4 + 1] = a.y * rs * g4.y * (1.f + sc.y) + sh.y;
      f[i * 4 + 2] = a.z * rs * g4.z * (1.f + sc.z) + sh.z;
      f[i * 4 + 3] = a.w * rs * g4.w * (1.f + sc.w) + sh.w;
    }
    uint4* d = (uint4*)(dst + (size_t)tok * 1024 + lane * 16);
    d[0] = make_uint4(pk2(f[0], f[1]), pk2(f[2], f[3]), pk2(f[4], f[5]), pk2(f[6], f[7]));
    d[1] = make_uint4(pk2(f[8], f[9]), pk2(f[10], f[11]), pk2(f[12], f[13]), pk2(f[14], f[15]));
  }
}
__device__ void phase0b(const Params& p) { norm_rows<true>(p, p.n1g, 0, p.H1); }
__device__ void phase5a(const Params& p) { norm_rows<false>(p, p.n2g, 3072, p.H2); }
__device__ void phase5b(const Params& p, unsigned char* lds) {
  for (int t = blockIdx.x; t < 136 * 8; t += gridDim.x) {
    const int mt = t >> 3, nt = t & 7;
    auto al = [&](int row, int k, uint4& o0, uint4& o1, uint4& o2, uint4& o3) {
      const uint4* s = (const uint4*)(p.H2 + (size_t)row * 1024 + k);
      o0 = s[0]; o1 = s[1]; o2 = s[2]; o3 = s[3];
    };
    auto ep = [&](int row, int col, float4 v) { *(uint2*)(p.Q + (size_t)row * 1024 + col) = make_uint2(pk2(v.x, v.y), pk2(v.z, v.w)); };
    gemm_tile(mt * 128, nt * 128, 1024, p.WqT, al, ep, lds);
  }
}

__device__ __forceinline__ void ins16(float (&L)[16], float x) {
#pragma unroll
  for (int j = 0; j < 16; ++j) { const float hi = fmaxf(L[j], x); x = fminf(L[j], x); L[j] = hi; }
}
__device__ __forceinline__ void ce_desc(float& a, float& b) { const float hi = fmaxf(a, b), lo = fminf(a, b); a = hi; b = lo; }
__device__ __forceinline__ void sort16_desc(float (&a)[16]) {
#pragma unroll
  for (int k = 2; k <= 16; k <<= 1)
#pragma unroll
    for (int j = k >> 1; j > 0; j >>= 1)
#pragma unroll
      for (int i = 0; i < 16; ++i) {
        const int l = i ^ j;
        if (l > i) {
          if ((i & k) == 0) ce_desc(a[i], a[l]);
          else ce_desc(a[l], a[i]);
        }
      }
}
__device__ __forceinline__ void merge16_desc(float (&L)[16], const float (&T)[16]) {
#pragma unroll
  for (int i = 0; i < 16; ++i) L[i] = fmaxf(L[i], T[15 - i]);
#pragma unroll
  for (int j = 8; j > 0; j >>= 1)
#pragma unroll
    for (int i = 0; i < 16; ++i) { const int l = i ^ j; if (l > i) ce_desc(L[i], L[l]); }
}
__device__ __forceinline__ void peer_side_top16(const Params& p, const bfu* __restrict__ keys, int tok, int h, int side, int lane, float (&L)[16]) {
  const int l31 = lane & 31, lh = lane >> 5;
  bf16x8 bq[4];
#pragma unroll
  for (int ks = 0; ks < 4; ++ks) bq[ks] = *(const bf16x8*)(p.Q + (size_t)tok * 1024 + h * 128 + side * 64 + ks * 16 + lh * 8);
#pragma unroll
  for (int nt = 0; nt < 4; ++nt) {
    f32x16 acc;
#pragma unroll
    for (int r = 0; r < 16; ++r) acc[r] = 0.f;
#pragma unroll
    for (int ks = 0; ks < 4; ++ks) {
      const bf16x8 ak = *(const bf16x8*)(keys + ((size_t)(h * 128 + nt * 32 + l31)) * 64 + ks * 16 + lh * 8);
      acc = __builtin_amdgcn_mfma_f32_32x32x16_bf16(ak, bq[ks], acc, 0, 0, 0);
    }
    float V[16];
#pragma unroll
    for (int r = 0; r < 16; ++r) {
      const unsigned n = (unsigned)(nt * 32 + (r & 3) + 8 * (r >> 2)) + 4u * (unsigned)lh;
      V[r] = __uint_as_float((__float_as_uint(acc[r]) & ~127u) | n);
    }
    sort16_desc(V);
    if (nt == 0) {
#pragma unroll
      for (int j = 0; j < 16; ++j) L[j] = V[j];
    } else merge16_desc(L, V);
  }
  float P[16];
#pragma unroll
  for (int j = 0; j < 16; ++j) P[j] = __shfl_xor(L[j], 32);
  merge16_desc(L, P);
}
__device__ void phase6(const Params& p, unsigned char* lds) {
  const int tid = threadIdx.x, lane = tid & 63, wid = tid >> 6;
  unsigned char* ib = lds + wid * (64 * 36);
  const int gw = (blockIdx.x * NT + tid) >> 6, nw = (gridDim.x * NT) >> 6;
  for (int job = gw; job < (NTOK / 32) * 8; job += nw) {
    const int tile = job >> 3, h = job & 7;
    const int tok = tile * 32 + (lane & 31);
    float L1[16], L2[16];
    peer_side_top16(p, p.K1, tok, h, 0, lane, L1);
    peer_side_top16(p, p.K2, tok, h, 1, lane, L2);
    {
      unsigned* iw = (unsigned*)(ib + lane * 36);
#pragma unroll
      for (int q = 0; q < 4; ++q) {
        iw[q] = (__float_as_uint(L1[q * 4]) & 127u) | ((__float_as_uint(L1[q * 4 + 1]) & 127u) << 8) | ((__float_as_uint(L1[q * 4 + 2]) & 127u) << 16) | ((__float_as_uint(L1[q * 4 + 3]) & 127u) << 24);
        iw[4 + q] = (__float_as_uint(L2[q * 4]) & 127u) | ((__float_as_uint(L2[q * 4 + 1]) & 127u) << 8) | ((__float_as_uint(L2[q * 4 + 2]) & 127u) << 16) | ((__float_as_uint(L2[q * 4 + 3]) & 127u) << 24);
      }
    }
    float C[16];
    {
      auto cand = [&](int i, int j) -> float {
        const float v = __uint_as_float(__float_as_uint(L1[i]) & ~127u) + __uint_as_float(__float_as_uint(L2[j]) & ~127u);
        return __uint_as_float((__float_as_uint(v) & ~255u) | (unsigned)(i * 16 + j));
      };
      float R[16];
#pragma unroll
      for (int j = 0; j < 16; ++j) { C[j] = cand(0, j); R[j] = j < 8 ? cand(1, j) : -3.0e38f; }
      merge16_desc(C, R);
      R[0] = cand(2, 0); R[1] = cand(2, 1); R[2] = cand(2, 2); R[3] = cand(2, 3); R[4] = cand(2, 4);
      R[5] = cand(3, 0); R[6] = cand(3, 1); R[7] = cand(3, 2); R[8] = cand(3, 3);
      R[9] = cand(4, 0); R[10] = cand(4, 1); R[11] = cand(4, 2);
      R[12] = cand(5, 0); R[13] = cand(5, 1); R[14] = cand(6, 0); R[15] = cand(6, 1);
      sort16_desc(R);
      merge16_desc(C, R);
      R[0] = cand(7, 0); R[1] = cand(7, 1);
#pragma unroll
      for (int i = 8; i < 16; ++i) R[i - 6] = cand(i, 0);
#pragma unroll
      for (int j = 10; j < 16; ++j) R[j] = -3.0e38f;
      sort16_desc(R);
      merge16_desc(C, R);
    }
    __builtin_amdgcn_wave_barrier();
    const float m = __uint_as_float(__float_as_uint(C[0]) & ~255u);
    float e[16], sum = 0.f;
    unsigned idx[16];
#pragma unroll
    for (int j = 0; j < 16; ++j) {
      const unsigned cb = __float_as_uint(C[j]);
      e[j] = __expf(__uint_as_float(cb & ~255u) - m);
      sum += e[j];
      const unsigned i1 = ib[lane * 36 + ((cb >> 4) & 15u)], i2 = ib[lane * 36 + 16 + (cb & 15u)];
      idx[j] = i1 * 128u + i2;
    }
    const float inv = 1.f / sum;
    if (lane < 32) {
      uint4* eo = (uint4*)(p.EI + (size_t)tok * 128 + h * 16);
      float4* go = (float4*)(p.EG + (size_t)tok * 128 + h * 16);
#pragma unroll
      for (int q = 0; q < 4; ++q) {
        eo[q] = make_uint4(idx[q * 4], idx[q * 4 + 1], idx[q * 4 + 2], idx[q * 4 + 3]);
        go[q] = make_float4(e[q * 4] * inv, e[q * 4 + 1] * inv, e[q * 4 + 2] * inv, e[q * 4 + 3] * inv);
      }
    }
    __builtin_amdgcn_wave_barrier();
  }
}

typedef float v32f __attribute__((ext_vector_type(32)));
typedef unsigned v6u __attribute__((ext_vector_type(6)));
typedef __bf16 v2bf __attribute__((ext_vector_type(2)));
typedef __bf16 v32bf __attribute__((ext_vector_type(32)));
__device__ __forceinline__ v32f unpack_fp6(const uint4 a, const uint2 b) {
  v6u w; w[0] = a.x; w[1] = a.y; w[2] = a.z; w[3] = a.w; w[4] = b.x; w[5] = b.y;
  return __builtin_amdgcn_cvt_scalef32_pk32_f32_fp6(w, 1.0f);
}
__device__ void phase7(const Params& p) {
  const int lane = threadIdx.x & 63, l31 = lane & 31, half = lane >> 5;
  const int gw = (blockIdx.x * NT + threadIdx.x) >> 6, nw = (gridDim.x * NT) >> 6;
  for (int tok = gw; tok < NTOK; tok += nw) {
    unsigned hp16[16];
    {
      const uint2* hp = (const uint2*)(p.H2 + (size_t)tok * 1024 + l31 * 4);
#pragma unroll
      for (int i = 0; i < 8; ++i) { const uint2 a = hp[i * 32]; hp16[i * 2] = a.x; hp16[i * 2 + 1] = a.y; }
    }
    const unsigned ei0 = p.EI[(size_t)tok * 128 + lane] & 16383u, ei1 = p.EI[(size_t)tok * 128 + 64 + lane] & 16383u;
    const float eg0 = p.EG[(size_t)tok * 128 + lane] * p.SV[ei0], eg1 = p.EG[(size_t)tok * 128 + 64 + lane] * p.SV[ei1];
    const float su0 = p.SU[ei0], su1 = p.SU[ei1];
    float ff[32];
#pragma unroll
    for (int j = 0; j < 32; ++j) ff[j] = 0.f;
#pragma unroll 1
    for (int grp = 0; grp < 16; ++grp) {
      const unsigned eiv = grp < 8 ? ei0 : ei1;
      const float egv = grp < 8 ? eg0 : eg1;
      const float suv = grp < 8 ? su0 : su1;
      const int lb = (grp & 7) * 8;
      uint4 ua[4], va[4];
      uint2 vb[4];
#pragma unroll
      for (int i = 0; i < 4; ++i) {
        const unsigned id = (unsigned)__shfl((int)eiv, lb + 2 * i + half);
        const unsigned char* ur = p.TU + (size_t)id * 512;
        const unsigned char* vr = p.TV + (size_t)id * 768;
        ua[i] = *(const uint4*)(ur + l31 * 16);
        va[i] = *(const uint4*)(vr + l31 * 16); vb[i] = *(const uint2*)(vr + 512 + l31 * 8);
      }
      float part[4];
#pragma unroll
      for (int i = 0; i < 4; ++i) {
        const unsigned wq[4] = {ua[i].x, ua[i].y, ua[i].z, ua[i].w};
        float s0 = 0.f, s1 = 0.f;
#pragma unroll
        for (int d = 0; d < 4; ++d) {
          s0 = __builtin_amdgcn_fdot2_f32_bf16(__builtin_amdgcn_cvt_scalef32_pk_bf16_fp4(wq[d], 1.0f, 0), __builtin_bit_cast(v2bf, hp16[d * 4 + 0]), s0, false);
          s1 = __builtin_amdgcn_fdot2_f32_bf16(__builtin_amdgcn_cvt_scalef32_pk_bf16_fp4(wq[d], 1.0f, 1), __builtin_bit_cast(v2bf, hp16[d * 4 + 1]), s1, false);
          s0 = __builtin_amdgcn_fdot2_f32_bf16(__builtin_amdgcn_cvt_scalef32_pk_bf16_fp4(wq[d], 1.0f, 2), __builtin_bit_cast(v2bf, hp16[d * 4 + 2]), s0, false);
          s1 = __builtin_amdgcn_fdot2_f32_bf16(__builtin_amdgcn_cvt_scalef32_pk_bf16_fp4(wq[d], 1.0f, 3), __builtin_bit_cast(v2bf, hp16[d * 4 + 3]), s1, false);
        }
        part[i] = s0 + s1;
        __builtin_amdgcn_sched_barrier(0);
      }
      float r2[2], r1;
      {
        const bool h4 = lane & 16;
#pragma unroll
        for (int i = 0; i < 2; ++i) { const float keep = h4 ? part[i + 2] : part[i], send = h4 ? part[i] : part[i + 2]; r2[i] = keep + __shfl_xor(send, 16); }
        const bool h3 = lane & 8;
        { const float keep = h3 ? r2[1] : r2[0], send = h3 ? r2[0] : r2[1]; r1 = keep + __shfl_xor(send, 8); }
        r1 += dppf<0x141>(r1); r1 += dppf<0x4E>(r1); r1 += dppf<0xB1>(r1);
      }
      const int myI = ((lane >> 4) & 1) * 2 + ((lane >> 3) & 1);
      const int slot = lb + 2 * myI + half;
      const float gate = __shfl(egv, slot), su = __shfl(suv, slot);
      const float coef = gate * gelu_(r1 * su);
#pragma unroll
      for (int i = 0; i < 4; ++i) {
        const float c = __shfl(coef, (lane & 32) + ((i >> 1) & 1) * 16 + (i & 1) * 8);
        const v32f v = unpack_fp6(va[i], vb[i]);
#pragma unroll
        for (int j = 0; j < 32; ++j) ff[j] += c * v[j];
        __builtin_amdgcn_sched_barrier(0);
      }
    }
    float fs[16];
#pragma unroll
    for (int j = 0; j < 16; ++j) {
      const float mine = half ? ff[16 + j] : ff[j], other = half ? ff[j] : ff[16 + j];
      fs[j] = mine + __shfl_xor(other, 32);
    }
    const int k0 = half * 512 + l31 * 4;
    const float* x1 = p.X1 + (size_t)tok * 1024 + k0;
    const float* ga = p.mod + (size_t)sq_of(tok) * 6144 + 5120 + k0;
    float xf[16];
    float s = 0.f;
#pragma unroll
    for (int i = 0; i < 4; ++i) {
      const float4 a = *(const float4*)(x1 + i * 128), g4 = *(const float4*)(ga + i * 128);
      xf[i * 4] = a.x + g4.x * fs[i * 4]; xf[i * 4 + 1] = a.y + g4.y * fs[i * 4 + 1]; xf[i * 4 + 2] = a.z + g4.z * fs[i * 4 + 2]; xf[i * 4 + 3] = a.w + g4.w * fs[i * 4 + 3];
      s += xf[i * 4] * xf[i * 4] + xf[i * 4 + 1] * xf[i * 4 + 1] + xf[i * 4 + 2] * xf[i * 4 + 2] + xf[i * 4 + 3] * xf[i * 4 + 3];
    }
#pragma unroll
    for (int o = 32; o > 0; o >>= 1) s += __shfl_xor(s, o);
    const float rs = rsqrtf(s * (1.f / 1024.f) + NORM_EPS);
#pragma unroll
    for (int i = 0; i < 4; ++i) {
      const float4 g4 = *(const float4*)(p.fng + k0 + i * 128);
      *(float4*)(p.out + (size_t)tok * 1024 + k0 + i * 128) = make_float4(xf[i * 4] * rs * g4.x, xf[i * 4 + 1] * rs * g4.y, xf[i * 4 + 2] * rs * g4.z, xf[i * 4 + 3] * rs * g4.w);
    }
  }
}


template <int PH>
__global__ void __launch_bounds__(NT, 2) phase_kernel(Params p) {
  __shared__ __attribute__((aligned(16))) unsigned char lds[LDS_BYTES];
  if (PH == 0) phase0(p, lds);
  if (PH == 1) { phase0b(p); phase1(p, lds); }
  if (PH == 2) phase2(p, lds);
  if (PH == 3) phase3(p, lds);
  if (PH == 4) phase4a(p, lds);
  if (PH == 5) phase4b(p, lds);
  if (PH == 6) phase5a(p);
  if (PH == 7) phase5b(p, lds);
  if (PH == 8) phase6(p, lds);
  if (PH == 9) phase7(p);
}

__global__ void __launch_bounds__(NT, 2) mega_kernel(Params p) {
  __shared__ __attribute__((aligned(16))) unsigned char lds[LDS_BYTES + 16];
  if (p.never) cg::this_grid().sync();
  volatile unsigned* st = (volatile unsigned*)(lds + LDS_BYTES);
  if (threadIdx.x == 0) { st[0] = 0u; st[1] = 0u; st[2] = 0u; st[3] = 0u; }
  __syncthreads();
  XcdBarrier b = xcd_barrier_post(p.bar, st);
  phase0(p, lds);  xcd_barrier(b);
  if (DUP == 0) { phase0(p, lds); xcd_barrier(b); }
  phase0b(p);      xcd_barrier(b);
  phase1(p, lds);  xcd_barrier(b);
  if (DUP == 1) { phase1(p, lds); xcd_barrier(b); }
  phase2(p, lds);  xcd_barrier(b);
  if (DUP == 2) { phase2(p, lds); xcd_barrier(b); }
  phase3(p, lds);  xcd_barrier(b);
  if (DUP == 3) { phase3(p, lds, 64, P3MODE); xcd_barrier(b); }
  phase4a(p, lds); xcd_barrier(b);
  if (DUP == 4) { phase4a(p, lds); xcd_barrier(b); }
  phase4b(p, lds); xcd_barrier(b);
  if (DUP == 5) { phase4b(p, lds); xcd_barrier(b); }
  phase5a(p);      xcd_barrier(b);
  if (DUP == 6) { phase5a(p); xcd_barrier(b); }
  phase5b(p, lds); xcd_barrier(b);
  if (DUP == 7) { phase5b(p, lds); xcd_barrier(b); }
  phase6(p, lds);  xcd_barrier(b);
  if (DUP == 8) { phase6(p, lds); xcd_barrier(b); }
  phase7(p);
  if (DUP == 9) { xcd_barrier(b); phase7(p); }
}

extern "C" void kernel_launch(void* const* d_in, const int* in_sizes, int n_in, void* d_out, int out_size, void* d_ws, size_t ws_size,
                              hipStream_t stream) {
  Params p;
  memset(&p, 0, sizeof(p));
  const float** f = (const float**)&p.xp;
  for (int i = 0; i < 41; ++i) f[i] = (const float*)d_in[i];
  p.out = (float*)d_out;
  unsigned char* w = (unsigned char*)d_ws;
  size_t off = 0;
  auto take = [&](size_t bytes) { unsigned char* r = w + off; off += (bytes + 255) & ~(size_t)255; return r; };
  p.bar = (unsigned*)take(XCD_BAR_WORDS * 4);
  p.TU = take((size_t)16384 * 512);
  p.TV = take((size_t)16384 * 768);
  p.SU = (float*)take(16384 * 4);
  p.SV = (float*)take(16384 * 4);
  p.WinT = (bfu*)take((size_t)2304 * 1024 * 2);
  p.WoutT = (bfu*)take((size_t)1024 * 1024 * 2);
  p.WqT = (bfu*)take((size_t)1024 * 1024 * 2);
  p.WgluT = (bfu*)take((size_t)512 * 512 * 2);
  p.K1 = (bfu*)take(65536 * 2);
  p.K2 = (bfu*)take(65536 * 2);
  p.mod = (float*)take((size_t)NSQ * 6144 * 4);
  p.rs1 = (float*)take(NTOK * 4);
  p.lbre = (float*)take(2048 * 4); p.lbim = (float*)take(2048 * 4);
  p.lbLre = (float*)take(2048 * 4); p.lbLim = (float*)take(2048 * 4);
  p.BBre = (float*)take(32768 * 4); p.BBim = (float*)take(32768 * 4);
  p.BON = (float*)take((size_t)NTOK * 8 * 4);
  p.BONX = (float*)take((size_t)NTOK * 8 * 4);
  p.w2T = (bfu*)take(512 * 64 * 2); p.a2T = (bfu*)take(512 * 64 * 2); p.g2T = (bfu*)take(512 * 128 * 2);
  p.BBh = (bfu*)take(32 * 128 * 16 * 2); p.CCh = (bfu*)take(32 * 16 * 128 * 2);
  p.E = (float*)take((size_t)8 * 32 * 32 * 128 * 4);
  unsigned char* regC = take((size_t)NTOK * INC * 2);
  p.PJ = (bfu*)regC; p.X1 = (float*)regC;
  unsigned char* regDE = take((size_t)NTOK * 1024 * 2);
  p.LD = (bfu*)regDE; p.AA = (bfu*)(regDE + (size_t)NTOK * 512 * 2); p.Q = (bfu*)regDE;
  unsigned char* regF = take((size_t)NTOK * 128 * 8);
  p.GG = (bfu*)regF; p.EI = (unsigned*)regF; p.EG = (float*)(regF + (size_t)NTOK * 128 * 4);
  unsigned char* regY = take((size_t)NTOK * 512 * 4);
  p.Y5 = (float*)regY; p.H2 = (bfu*)regY; p.H1 = (bfu*)regY; p.CAT = (bfu*)regDE;
  if (off > ws_size) { fprintf(stderr, "workspace too small: need %zu have %zu\n", off, ws_size); return; }
  p.never = 0;

  (void)hipMemsetAsync(p.bar, 0, XCD_BAR_WORDS * 4, stream);
  (void)hipMemsetAsync(p.mod, 0, (size_t)NSQ * 6144 * 4, stream);
#if MULTI
  const int G = 512;
  phase_kernel<0><<<G, NT, 0, stream>>>(p);
  phase_kernel<1><<<G, NT, 0, stream>>>(p);
  phase_kernel<2><<<G, NT, 0, stream>>>(p);
  phase_kernel<3><<<G, NT, 0, stream>>>(p);
  phase_kernel<4><<<G, NT, 0, stream>>>(p);
  phase_kernel<5><<<G, NT, 0, stream>>>(p);
  phase_kernel<6><<<G, NT, 0, stream>>>(p);
  phase_kernel<7><<<G, NT, 0, stream>>>(p);
  phase_kernel<8><<<G, NT, 0, stream>>>(p);
  phase_kernel<9><<<G, NT, 0, stream>>>(p);
#else
  static int grid_blocks = 0;
  if (!grid_blocks) {
    int dev = 0, cus = 0, per_cu = 0;
    hipGetDevice(&dev);
    hipDeviceGetAttribute(&cus, hipDeviceAttributeMultiprocessorCount, dev);
    hipOccupancyMaxActiveBlocksPerMultiprocessor(&per_cu, mega_kernel, NT, 0);
    if (per_cu > 2) per_cu = 2;
    if (per_cu < 1) per_cu = 1;
    grid_blocks = cus * per_cu;
  }
  void* args[] = {&p};
  hipError_t e = hipLaunchCooperativeKernel((void*)mega_kernel, dim3(grid_blocks), dim3(NT), args, 0, stream);
  if (e != hipSuccess) fprintf(stderr, "cooperative launch failed: %s (grid %d)\n", hipGetErrorString(e), grid_blocks);
#endif
}
```

```cpp
#include <hip/hip_runtime.h>
#include <hip/hip_cooperative_groups.h>
#include <stdint.h>
#include <stdio.h>
#include <string.h>
namespace cg = cooperative_groups;

#ifndef MULTI
#define MULTI 0
#endif
#ifndef DUP
#define DUP -1
#endif

typedef unsigned short bfu;
using bf16x8 = __attribute__((ext_vector_type(8))) short;
using f32x16 = __attribute__((ext_vector_type(16))) float;

constexpr int NTOK = 17408, NPT = 16384, NSQ = 136, DM = 1024, INC = 2304, RC = 1792;
constexpr int O_S5RE_P = 17825792, O_S5IM_P = 17842176, O_WKV_P = 17858560, O_SH_P = 18120704;
constexpr int O_S5RE_S = 18135040, O_S5IM_S = 18397184, O_WKV_S = 18659328, O_SH_S = 22853632;
constexpr float NORM_EPS = 1e-6f, GN_EPS = 64e-5f;
constexpr int NT = 256;
constexpr int LDS_BYTES = 75776;
constexpr int LDS_JOB = LDS_BYTES - 16;

struct Params {
  const float *xp, *xs, *s5re0, *s5im0, *wkv0, *shift0, *cp, *cs, *w_ada, *b_ada, *n1g, *n2g, *w_in, *w_out;
  const float *s5are, *s5aim, *s5ldt, *s5bre, *s5bim, *s5cre, *s5cim, *s5d, *w_glu, *b_glu;
  const float *mu, *w0, *w2, *a0, *a2, *g2, *k_k, *k_a, *r_k, *gn_w, *gn_b, *w_q, *keys1, *keys2, *pu, *pv, *fng;
  float* out;
  unsigned char *TU, *TV; float *SU, *SV;
  bfu *WinT, *WoutT, *WqT, *WgluT, *K1, *K2;
  float *mod, *rs1, *lbre, *lbim, *lbLre, *lbLim, *BBre, *BBim;
  bfu* PJ; float* X1; bfu *LD, *AA, *GG; float* Y5; bfu *Q, *H2; unsigned* EI; float* EG; float* BON; float* BONX; bfu *H1, *CAT; bfu *w2T, *a2T, *g2T, *BBh, *CCh; float* E;
  unsigned* bar;
  int never; int pad_;
};

__device__ __forceinline__ bfu f2bf(float f) { unsigned u = __float_as_uint(f); u += 0x7fffu + ((u >> 16) & 1u); return (bfu)(u >> 16); }
__device__ __forceinline__ float bf2f(bfu h) { return __uint_as_float(((unsigned)h) << 16); }
__device__ __forceinline__ unsigned pk2(float a, float b) { return (unsigned)f2bf(a) | ((unsigned)f2bf(b) << 16); }
__device__ __forceinline__ float bflo(unsigned u) { return __uint_as_float(u << 16); }
__device__ __forceinline__ float bfhi(unsigned u) { return __uint_as_float(u & 0xffff0000u); }
__device__ __forceinline__ int sq_of(int tok) { return tok < NPT ? (tok >> 11) : 8 + ((tok - NPT) >> 3); }
__device__ __forceinline__ int t_of(int tok) { return tok < NPT ? (tok & 2047) : ((tok - NPT) & 7); }
__device__ __forceinline__ const float* xrow(const Params& p, int tok) { return tok < NPT ? p.xp + (size_t)tok * DM : p.xs + (size_t)(tok - NPT) * DM; }
__device__ __forceinline__ float sigmoidf_(float x) { return 1.f / (1.f + __expf(-x)); }
__device__ __forceinline__ float gelu_(float x) { return 0.5f * x * (1.f + erff(x * 0.70710678118654752f)); }

#define XB_TMO 128
#define XB_XCNT(j) (256 + 64 * (j))
#define XB_XSUB(j) (1280 + 64 * (j))
#define XB_XGEN(j) (2304 + 64 * (j))
#define XB_TOP 3328
#define XB_TOPGEN 3392
#define XCD_BAR_WORDS 3456
#define XB_SPIN_CAP (1u << 22)
#define LAS __attribute__((address_space(3)))
__device__ __forceinline__ unsigned xb_ld(unsigned* p) { return __hip_atomic_load(p, __ATOMIC_RELAXED, __HIP_MEMORY_SCOPE_AGENT); }
__device__ __forceinline__ unsigned xb_add(unsigned* p, unsigned v) { return __hip_atomic_fetch_add(p, v, __ATOMIC_RELAXED, __HIP_MEMORY_SCOPE_AGENT); }
__device__ __forceinline__ unsigned xb_xcc_id() { return (unsigned)__builtin_amdgcn_s_getreg((3 << 11) | 20) & 0xFu; }
#define XB_SPIN(cond, bar) do { unsigned _sp = 0; while (cond) { __builtin_amdgcn_s_sleep(1); \
    if ((++_sp & 255u) == 0u) { if (xb_ld(&(bar)[XB_TMO])) break; if (_sp > XB_SPIN_CAP) { atomicAdd(&(bar)[XB_TMO], 1u); break; } } } } while (0)
struct XcdBarrier { unsigned* bar; unsigned x; volatile unsigned* st; };
__device__ __forceinline__ XcdBarrier xcd_barrier_post(unsigned* bar, volatile unsigned* st) {
  XcdBarrier b; b.bar = bar; b.x = xb_xcc_id(); b.st = st;
  if (threadIdx.x == 0) (void)xb_add(&bar[XB_XCNT(b.x)], 1u);
  return b;
}
__device__ __forceinline__ void xcd_barrier_complete(unsigned* bar, unsigned x, unsigned& nloc, unsigned& nx) {
  const unsigned G = gridDim.x;
  unsigned sum, cnt, mine, sp = 0u;
  for (;;) {
    sum = 0u; cnt = 0u; mine = 0u;
#pragma unroll
    for (unsigned j = 0; j < 16; ++j) { const unsigned c = xb_ld(&bar[XB_XCNT(j)]); sum += c; cnt += (c > 0u) ? 1u : 0u; mine = (j == x) ? c : mine; }
    if (sum == G) break;
    __builtin_amdgcn_s_sleep(1);
    if ((++sp & 255u) == 0u) { if (xb_ld(&bar[XB_TMO])) break; if (sp > XB_SPIN_CAP) { atomicAdd(&bar[XB_TMO], 1u); break; } }
  }
  nloc = mine > 0u ? mine : 1u; nx = cnt > 0u ? cnt : 1u;
}
__device__ __forceinline__ void xcd_barrier(const XcdBarrier& b) {
  asm volatile("s_waitcnt vmcnt(0)" ::: "memory");
  __syncthreads();
  if (threadIdx.x == 0) {
    unsigned* bar = b.bar;
    __builtin_amdgcn_s_waitcnt(0);
    unsigned nloc = b.st[0], nx = b.st[1];
    if (nloc == 0u) { xcd_barrier_complete(bar, b.x, nloc, nx); b.st[0] = nloc; b.st[1] = nx; }
    const unsigned old = xb_add(&bar[XB_XSUB(b.x)], 1u);
    const unsigned gen = old / nloc;
    if (old + 1u == (gen + 1u) * nloc) {
      __builtin_amdgcn_fence(__ATOMIC_RELEASE, "agent");
      asm volatile("s_waitcnt vmcnt(0)" ::: "memory");
      const unsigned og = xb_add(&bar[XB_TOP], 1u);
      const unsigned tg = og / nx;
      if (og + 1u == (tg + 1u) * nx) xb_add(&bar[XB_TOPGEN], 1u);
      else XB_SPIN(xb_ld(&bar[XB_TOPGEN]) == tg, bar);
      __builtin_amdgcn_fence(__ATOMIC_ACQUIRE, "agent");
      xb_add(&bar[XB_XGEN(b.x)], 1u);
      asm volatile("s_waitcnt vmcnt(0)" ::: "memory");
    } else {
      XB_SPIN(xb_ld(&bar[XB_XGEN(b.x)]) == gen, bar);
      __builtin_amdgcn_fence(__ATOMIC_ACQUIRE, "agent");
      asm volatile("s_waitcnt vmcnt(0)" ::: "memory");
    }
  }
  __syncthreads();
}

struct U4x4 { uint4 a, b, c, d; };
constexpr int GLD = 144;
template <class AL, class EP>
__device__ __forceinline__ void gemm_tile(int m0, int n0, int K, const bfu* __restrict__ Bt, AL al, EP ep, unsigned char* lds) {
  constexpr int BUF = 256 * GLD;
  const int tid = threadIdx.x, lane = tid & 63, wid = tid >> 6;
  const int wr = wid >> 1, wc = wid & 1;
  const int l31 = lane & 31, lh = lane >> 5;
  f32x16 acc[2][2];
#pragma unroll
  for (int i = 0; i < 2; ++i)
#pragma unroll
    for (int j = 0; j < 2; ++j)
#pragma unroll
      for (int r = 0; r < 16; ++r) acc[i][j][r] = 0.f;
  const int srow = tid >> 1, sk = (tid & 1) * 32;
  uint4 av0, av1, av2, av3, bv0, bv1, bv2, bv3;
  auto gl = [&](int k0) {
    al(m0 + srow, k0 + sk, av0, av1, av2, av3);
    const uint4* bp = (const uint4*)(Bt + (size_t)(n0 + srow) * K + k0 + sk);
    bv0 = bp[0]; bv1 = bp[1]; bv2 = bp[2]; bv3 = bp[3];
  };
  auto st = [&](int buf) {
    uint4* da = (uint4*)(lds + buf * BUF + srow * GLD + sk * 2);
    uint4* db = (uint4*)(lds + buf * BUF + 128 * GLD + srow * GLD + sk * 2);
    da[0] = av0; da[1] = av1; da[2] = av2; da[3] = av3;
    db[0] = bv0; db[1] = bv1; db[2] = bv2; db[3] = bv3;
  };
  gl(0);
  __syncthreads();
  st(0);
  if (64 < K) gl(64);
  __syncthreads();
  const int nk = K >> 6;
  for (int kt = 0; kt < nk; ++kt) {
    const unsigned char* ldsA = lds + (kt & 1) * BUF;
    const unsigned char* ldsB = ldsA + 128 * GLD;
    if (kt + 1 < nk) st((kt + 1) & 1);
    if (kt + 2 < nk) gl((kt + 2) * 64);
#pragma unroll
    for (int s = 0; s < 4; ++s) {
      const bf16x8 af0 = *(const bf16x8*)(ldsA + (wr * 64 + l31) * GLD + s * 32 + lh * 16);
      const bf16x8 af1 = *(const bf16x8*)(ldsA + (wr * 64 + 32 + l31) * GLD + s * 32 + lh * 16);
      const bf16x8 bf0 = *(const bf16x8*)(ldsB + (wc * 64 + l31) * GLD + s * 32 + lh * 16);
      const bf16x8 bf1 = *(const bf16x8*)(ldsB + (wc * 64 + 32 + l31) * GLD + s * 32 + lh * 16);
      acc[0][0] = __builtin_amdgcn_mfma_f32_32x32x16_bf16(af0, bf0, acc[0][0], 0, 0, 0);
      acc[0][1] = __builtin_amdgcn_mfma_f32_32x32x16_bf16(af0, bf1, acc[0][1], 0, 0, 0);
      acc[1][0] = __builtin_amdgcn_mfma_f32_32x32x16_bf16(af1, bf0, acc[1][0], 0, 0, 0);
      acc[1][1] = __builtin_amdgcn_mfma_f32_32x32x16_bf16(af1, bf1, acc[1][1], 0, 0, 0);
    }
    __syncthreads();
  }
  {
    float* ct = (float*)lds;
#pragma unroll
    for (int i = 0; i < 2; ++i)
#pragma unroll
      for (int j = 0; j < 2; ++j)
#pragma unroll
        for (int r = 0; r < 16; ++r)
          ct[(wr * 64 + i * 32 + (r & 3) + 8 * (r >> 2) + 4 * lh) * 132 + wc * 64 + j * 32 + l31] = acc[i][j][r];
    __syncthreads();
#pragma unroll 4
    for (int it = 0; it < 16; ++it) {
      const int idx = it * NT + tid, rl = idx >> 5, c4 = (idx & 31) * 4;
      ep(m0 + rl, n0 + c4, *(const float4*)(ct + rl * 132 + c4));
    }
  }
  __syncthreads();
}

__device__ void phase0(const Params& p, unsigned char* lds) {
  const int tid = threadIdx.x, G = gridDim.x, gtid = blockIdx.x * NT + tid, gsz = G * NT;
  {
    const int lane = tid & 63, l31 = lane & 31, gw = gtid >> 6, nw = gsz >> 6;
    for (int rp = gw; rp < 16384; rp += nw) {
      const int r = rp * 2 + (lane >> 5);
      const bool isv = r >= 16384;
      const int row = r & 16383;
      const float4* src = (const float4*)((isv ? p.pv : p.pu) + (size_t)row * 1024 + l31 * 4);
      float x[32];
#pragma unroll
      for (int i = 0; i < 8; ++i) { const float4 v = src[i * 32]; x[i * 4] = v.x; x[i * 4 + 1] = v.y; x[i * 4 + 2] = v.z; x[i * 4 + 3] = v.w; }
      float m = 0.f;
#pragma unroll
      for (int i = 0; i < 32; ++i) m = fmaxf(m, fabsf(x[i]));
#pragma unroll
      for (int o = 16; o > 0; o >>= 1) m = fmaxf(m, __shfl_xor(m, o));
      {
        const float sc4 = m > 0.f ? 6.f / m : 1.f;
        unsigned wq[4] = {0u, 0u, 0u, 0u};
#pragma unroll
        for (int i = 0; i < 32; ++i) {
          const float a_ = fabsf(x[i]) * sc4;
          const unsigned code = (unsigned)(a_ >= 0.25f) + (unsigned)(a_ >= 0.75f) + (unsigned)(a_ >= 1.25f) + (unsigned)(a_ >= 1.75f) +
                                (unsigned)(a_ >= 2.5f) + (unsigned)(a_ >= 3.5f) + (unsigned)(a_ >= 5.f);
          wq[i >> 3] |= (code | (x[i] < 0.f ? 8u : 0u)) << (4 * (i & 7));
        }
        *(uint4*)((isv ? p.TV : p.TU) + (size_t)row * 512 + l31 * 16) = make_uint4(wq[0], wq[1], wq[2], wq[3]);
        if (l31 == 0) (isv ? p.SV : p.SU)[row] = m > 0.f ? m * (1.f / 6.f) : 1.f;
        continue;
      }
      const float sc = m > 0.f ? 7.5f / m : 1.f;
      unsigned long long w0 = 0ull, w1 = 0ull, w2 = 0ull;
#pragma unroll
      for (int i = 0; i < 32; ++i) {
        const float a_ = fminf(fabsf(x[i]) * sc, 7.5f);
        int code;
        if (a_ < 2.f) code = __float2int_rn(a_ * 8.f);
        else if (a_ < 4.f) code = 8 + __float2int_rn(a_ * 4.f);
        else code = 16 + __float2int_rn(a_ * 2.f);
        code = min(code, 31);
        const unsigned long long c6 = (unsigned long long)((unsigned)code | (x[i] < 0.f ? 32u : 0u));
        const int bit = 6 * i, wi = bit >> 6, sh = bit & 63;
        if (wi == 0) w0 |= c6 << sh; else if (wi == 1) w1 |= c6 << sh; else w2 |= c6 << sh;
        if (sh > 58) { if (wi == 0) w1 |= c6 >> (64 - sh); else if (wi == 1) w2 |= c6 >> (64 - sh); }
      }
      unsigned char* dst = p.TV + (size_t)row * 768;
      *(uint4*)(dst + l31 * 16) = make_uint4((unsigned)w0, (unsigned)(w0 >> 32), (unsigned)w1, (unsigned)(w1 >> 32));
      *(uint2*)(dst + 512 + l31 * 8) = make_uint2((unsigned)w2, (unsigned)(w2 >> 32));
      if (l31 == 0) p.SV[row] = m > 0.f ? m * (1.f / 7.5f) : 1.f;
    }
  }
  for (int i = gtid; i < 65536; i += gsz) { p.K1[i] = f2bf(p.keys1[i]); p.K2[i] = f2bf(p.keys2[i]); }
  {
    auto tr = [&](const float* __restrict__ src, bfu* __restrict__ dst, const int K, const int N) {
      for (int i = gtid; i < N * (K / 8); i += gsz) {
        const int n = i % N, k8 = i / N;
        float v[8];
#pragma unroll
        for (int j = 0; j < 8; ++j) v[j] = src[(size_t)(k8 * 8 + j) * N + n];
        *(uint4*)(dst + (size_t)n * K + k8 * 8) = make_uint4(pk2(v[0], v[1]), pk2(v[2], v[3]), pk2(v[4], v[5]), pk2(v[6], v[7]));
      }
    };
    tr(p.w_in, p.WinT, 1024, 2304);
    tr(p.w_out, p.WoutT, 1024, 1024);
    tr(p.w_q, p.WqT, 1024, 1024);
    tr(p.w_glu, p.WgluT, 512, 512);
    tr(p.w2, p.w2T, 64, 512);
    tr(p.a2, p.a2T, 64, 512);
    tr(p.g2, p.g2T, 128, 512);
  }
  for (int i = gtid; i < 2048; i += gsz) {
    const int g = i >> 6;
    const float dt = expf(p.s5ldt[g]);
    const float lre = p.s5are[i], lim = p.s5aim[i];
    const float mag = expf(lre * dt), ang = lim * dt;
    float sn, cs; sincosf(ang, &sn, &cs);
    const float lbr = mag * cs, lbi = mag * sn;
    p.lbre[i] = lbr; p.lbim[i] = lbi;
    float pr = lbr, pi = lbi;
#pragma unroll
    for (int s = 0; s < 6; ++s) { const float nr = pr * pr - pi * pi, ni = 2.f * pr * pi; pr = nr; pi = ni; }
    p.lbLre[i] = pr; p.lbLim[i] = pi;
    const float den = lre * lre + lim * lim;
    const float nre = lbr - 1.f, nim = lbi;
    const float cr = (nre * lre + nim * lim) / den, ci = (nim * lre - nre * lim) / den;
#pragma unroll
    for (int h = 0; h < 16; ++h) {
      const float br = p.s5bre[i * 16 + h], bi = p.s5bim[i * 16 + h];
      p.BBh[(g * 128 + (i & 63)) * 16 + h] = f2bf(cr * br - ci * bi);
      p.BBh[(g * 128 + 64 + (i & 63)) * 16 + h] = f2bf(cr * bi + ci * br);
    }
  }
  for (int i = gtid; i < 32 * 16 * 64; i += gsz) {
    const int gh = i >> 6, k = i & 63;
    p.CCh[gh * 128 + k] = f2bf(p.s5cre[i]);
    p.CCh[gh * 128 + 64 + k] = f2bf(-p.s5cim[i]);
  }
  {
    float* sc = (float*)lds;
    for (int it = blockIdx.x; it < 17 * 24 * 4; it += G) {
      const int kp = it & 3, slab = (it >> 2) % 24, sg = (it >> 2) / 24;
      __syncthreads();
      for (int i = tid; i < 8 * 256; i += NT) {
        const int sq = sg * 8 + (i >> 8), k = kp * 256 + (i & 255);
        const float c = sq < 8 ? p.cp[sq * 1024 + k] : p.cs[(sq - 8) * 1024 + k];
        sc[i] = c / (1.f + __expf(-c));
      }
      __syncthreads();
      const int col = slab * 256 + tid;
      float acc[8];
#pragma unroll
      for (int i = 0; i < 8; ++i) acc[i] = 0.f;
      const float* wp = p.w_ada + (size_t)(kp * 256) * 6144 + col;
#pragma unroll 4
      for (int k = 0; k < 256; k += 4) {
        float w[4];
#pragma unroll
        for (int j = 0; j < 4; ++j) w[j] = wp[(size_t)(k + j) * 6144];
#pragma unroll
        for (int i = 0; i < 8; ++i) {
          const float4 s4 = *(const float4*)(sc + i * 256 + k);
          acc[i] += s4.x * w[0] + s4.y * w[1] + s4.z * w[2] + s4.w * w[3];
        }
      }
      const float bb = kp == 0 ? p.b_ada[col] : 0.f;
#pragma unroll
      for (int i = 0; i < 8; ++i) atomicAdd(&p.mod[(size_t)(sg * 8 + i) * 6144 + col], acc[i] + bb);
    }
    __syncthreads();
  }
}

__device__ void phase1(const Params& p, unsigned char* lds) {
  const int ntile = 136 * 18;
  for (int t = blockIdx.x; t < ntile; t += gridDim.x) {
    const int mt = t / 18, nt = t % 18;
    auto al = [&](int row, int k, uint4& o0, uint4& o1, uint4& o2, uint4& o3) {
      const uint4* s_ = (const uint4*)(p.H1 + (size_t)row * 1024 + k);
      o0 = s_[0]; o1 = s_[1]; o2 = s_[2]; o3 = s_[3];
    };
    auto ep = [&](int row, int col, float4 v) {
      *(uint2*)(p.PJ + (size_t)row * INC + col) = make_uint2(pk2(v.x, v.y), pk2(v.z, v.w));
      if (col >= 512) {
        if (row < NPT) { if ((row & 2047) == 2047) *(float4*)(p.out + O_SH_P + (row >> 11) * RC + col - 512) = v; }
        else { const int r = row - NPT; if ((r & 7) == 7) *(float4*)(p.out + O_SH_S + (r >> 3) * RC + col - 512) = v; }
      }
    };
    gemm_tile(mt * 128, nt * 128, 1024, p.WinT, al, ep, lds);
  }
}

struct Cx { float r, i; };
__device__ __forceinline__ Cx cfma(const Cx a, const Cx b, const Cx c) { Cx o; o.r = a.r * b.r - a.i * b.i + c.r; o.i = a.r * b.i + a.i * b.r + c.i; return o; }
using f32x4 = __attribute__((ext_vector_type(4))) float;
constexpr int HIMG = 272;
template <int MT, bool OUT>
__device__ __forceinline__ void s5_chunk(const Params& p, const int tok0, const int nvalid, const int g, Cx (&st)[2], const int Gend,
                                         unsigned char* himg, const int lane) {
  const int c = lane & 31, half = lane >> 5;
  Cx l1[2], l2[2], l3[2], l4[2];
#pragma unroll
  for (int s = 0; s < 2; ++s) {
    const int gp = g * 64 + 32 * s + c;
    l1[s].r = p.lbre[gp]; l1[s].i = p.lbim[gp];
    const Cx z = {0.f, 0.f};
    l2[s] = cfma(l1[s], l1[s], z); l3[s] = cfma(l2[s], l1[s], z); l4[s] = cfma(l2[s], l2[s], z);
  }
  bf16x8 bfr[4];
#pragma unroll
  for (int nt = 0; nt < 4; ++nt) bfr[nt] = *(const bf16x8*)(p.BBh + ((size_t)(g * 128 + 32 * nt + c)) * 16 + 8 * half);
  bf16x8 cfr[4];
  float dsk = 0.f;
  if (OUT) {
#pragma unroll
    for (int ks = 0; ks < 4; ++ks) cfr[ks] = *(const bf16x8*)(p.CCh + ((size_t)(g * 16 + (lane & 15))) * 128 + 32 * ks + 8 * (lane >> 4));
    dsk = p.s5d[g * 16 + (lane & 15)];
  }
  Cx endst[2] = {st[0], st[1]};
#pragma unroll
  for (int mt = 0; mt < MT; ++mt) {
    bf16x8 af;
#pragma unroll
    for (int j = 0; j < 8; ++j) af[j] = 0;
    if (32 * mt + c < nvalid) af = *(const bf16x8*)(p.PJ + (size_t)(tok0 + 32 * mt + c) * INC + g * 16 + 8 * half);
#pragma unroll
    for (int s = 0; s < 2; ++s) {
      f32x16 bre, bim;
#pragma unroll
      for (int r = 0; r < 16; ++r) { bre[r] = 0.f; bim[r] = 0.f; }
      bre = __builtin_amdgcn_mfma_f32_32x32x16_bf16(af, bfr[s], bre, 0, 0, 0);
      bim = __builtin_amdgcn_mfma_f32_32x32x16_bf16(af, bfr[2 + s], bim, 0, 0, 0);
      Cx e[4], pe[4];
#pragma unroll
      for (int q = 0; q < 4; ++q) {
        Cx x; x.r = bre[4 * q]; x.i = bim[4 * q];
#pragma unroll
        for (int i = 1; i < 4; ++i) { Cx b_; b_.r = bre[4 * q + i]; b_.i = bim[4 * q + i]; x = cfma(l1[s], x, b_); bre[4 * q + i] = x.r; bim[4 * q + i] = x.i; }
        e[q] = x;
      }
#pragma unroll
      for (int q = 0; q < 4; ++q) { pe[q].r = __shfl_xor(e[q].r, 32); pe[q].i = __shfl_xor(e[q].i, 32); }
      Cx carry = st[s];
      Cx cin[4];
#pragma unroll
      for (int q = 0; q < 4; ++q) {
        const Cx ee = half ? pe[q] : e[q];
        const Cx eo = half ? e[q] : pe[q];
        const Cx cin_e = carry;
        carry = cfma(l4[s], carry, ee);
        if (8 * mt + 2 * q == Gend) endst[s] = carry;
        const Cx cin_o = carry;
        carry = cfma(l4[s], carry, eo);
        if (8 * mt + 2 * q + 1 == Gend) endst[s] = carry;
        cin[q] = half ? cin_o : cin_e;
      }
      st[s] = carry;
      if (OUT) {
        bfu* hi16 = (bfu*)himg;
#pragma unroll
        for (int q = 0; q < 4; ++q)
#pragma unroll
          for (int i = 0; i < 4; ++i) {
            const Cx lp = i == 0 ? l1[s] : (i == 1 ? l2[s] : (i == 2 ? l3[s] : l4[s]));
            Cx b_; b_.r = bre[4 * q + i]; b_.i = bim[4 * q + i];
            const Cx h = cfma(lp, cin[q], b_);
            const int tl = i + 8 * q + 4 * half;
            hi16[tl * (HIMG / 2) + 32 * s + c] = f2bf(h.r);
            hi16[tl * (HIMG / 2) + 64 + 32 * s + c] = f2bf(h.i);
          }
      }
    }
    if (OUT) {
      __builtin_amdgcn_wave_barrier();
#pragma unroll
      for (int rt = 0; rt < 2; ++rt) {
        f32x4 acc = {0.f, 0.f, 0.f, 0.f};
#pragma unroll
        for (int ks = 0; ks < 4; ++ks) {
          const bf16x8 a_ = *(const bf16x8*)(himg + (16 * rt + (lane & 15)) * HIMG + (32 * ks + 8 * (lane >> 4)) * 2);
          acc = __builtin_amdgcn_mfma_f32_16x16x32_bf16(a_, cfr[ks], acc, 0, 0, 0);
        }
#pragma unroll
        for (int r = 0; r < 4; ++r) {
          const int t = 32 * mt + 16 * rt + 4 * (lane >> 4) + r;
          if (t < nvalid) {
            const float u = bf2f(p.PJ[(size_t)(tok0 + t) * INC + g * 16 + (lane & 15)]);
            p.Y5[(size_t)(tok0 + t) * 512 + g * 16 + (lane & 15)] = gelu_(acc[r] + dsk * u);
          }
        }
      }
      __builtin_amdgcn_wave_barrier();
    }
  }
  st[0] = endst[0]; st[1] = endst[1];
}
__device__ void s5_pass_a(const Params& p) {
  const int lane = threadIdx.x & 63, gw = (blockIdx.x * NT + threadIdx.x) >> 6, nw = (gridDim.x * NT) >> 6;
  for (int job = gw; job < 8 * 32 * 32; job += nw) {
    const int c = job & 31, g = (job >> 5) & 31, b = job >> 10;
    Cx st[2] = {{0.f, 0.f}, {0.f, 0.f}};
    s5_chunk<2, false>(p, b * 2048 + c * 64, 64, g, st, 15, nullptr, lane);
    if (lane < 32) {
      float* e = p.E + (size_t)job * 128;
      e[lane] = st[0].r; e[32 + lane] = st[1].r; e[64 + lane] = st[0].i; e[96 + lane] = st[1].i;
    }
  }
}
__device__ void s5_job_c(const Params& p, int bj, bool prompt, unsigned char* lds) {
  const int lane = threadIdx.x & 63, wid = threadIdx.x >> 6;
  unsigned char* himg = lds + wid * (32 * HIMG);
  const int job = bj * 4 + wid;
  const int cc = lane & 31;
  if (prompt) {
    const int c = job & 31, g = (job >> 5) & 31, b = job >> 10;
    Cx L64[2], st[2];
#pragma unroll
    for (int s = 0; s < 2; ++s) { const int gp = g * 64 + 32 * s + cc; L64[s].r = p.lbLre[gp]; L64[s].i = p.lbLim[gp]; st[s].r = 0.f; st[s].i = 0.f; }
    const float* e = p.E + (size_t)(job - c) * 128;
    for (int j = 0; j < c; ++j) {
      Cx e0, e1;
      e0.r = e[j * 128 + cc]; e1.r = e[j * 128 + 32 + cc]; e0.i = e[j * 128 + 64 + cc]; e1.i = e[j * 128 + 96 + cc];
      st[0] = cfma(L64[0], st[0], e0); st[1] = cfma(L64[1], st[1], e1);
    }
    s5_chunk<2, true>(p, b * 2048 + c * 64, 64, g, st, 15, himg, lane);
    if (c == 31 && lane < 32) {
      float* o = p.out + O_S5RE_P + (b * 32 + g) * 64;
      o[lane] = st[0].r; o[32 + lane] = st[1].r;
      o = p.out + O_S5IM_P + (b * 32 + g) * 64;
      o[lane] = st[0].i; o[32 + lane] = st[1].i;
    }
  } else {
    const int g = job & 31, bs = job >> 5;
    Cx st[2];
    const float* r0 = p.s5re0 + ((size_t)bs * 32 + g) * 64;
    const float* i0 = p.s5im0 + ((size_t)bs * 32 + g) * 64;
    st[0].r = r0[cc]; st[1].r = r0[32 + cc]; st[0].i = i0[cc]; st[1].i = i0[32 + cc];
    s5_chunk<1, true>(p, NPT + bs * 8, 8, g, st, 1, himg, lane);
    if (lane < 32) {
      float* o = p.out + O_S5RE_S + ((size_t)bs * 32 + g) * 64;
      o[lane] = st[0].r; o[32 + lane] = st[1].r;
      o = p.out + O_S5IM_S + ((size_t)bs * 32 + g) * 64;
      o[lane] = st[0].i; o[32 + lane] = st[1].i;
    }
  }
}

__device__ __forceinline__ float tanh_fast(float x) { const float e = __expf(2.f * x); return 1.f - 2.f / (e + 1.f); }
template <int WHICH>
__device__ void lora_tiles(const Params& p, unsigned char* lds) {
  constexpr int base = WHICH == 0 ? 1536 : (WHICH == 1 ? 1600 : 1664);
  for (int t = blockIdx.x; t < 136 * 4; t += gridDim.x) {
    const int mt = t >> 2, nt = t & 3;
    auto al = [&](int row, int k, uint4& o0, uint4& o1, uint4& o2, uint4& o3) {
      const bfu* pc = p.PJ + (size_t)row * INC + 512 + base + k;
      const int tt = t_of(row);
      auto one = [&](int i) -> uint4 {
        const uint4 cu = *(const uint4*)(pc + i * 8);
        const float cur[8] = {bflo(cu.x), bfhi(cu.x), bflo(cu.y), bfhi(cu.y), bflo(cu.z), bfhi(cu.z), bflo(cu.w), bfhi(cu.w)};
        float prv[8];
        if (tt == 0) {
          if (row < NPT) {
#pragma unroll
            for (int j = 0; j < 8; ++j) prv[j] = 0.f;
          } else {
            const float4* s0 = (const float4*)(p.shift0 + (size_t)(sq_of(row) - 8) * RC + base + k + i * 8);
            const float4 a = s0[0], b_ = s0[1];
            prv[0] = a.x; prv[1] = a.y; prv[2] = a.z; prv[3] = a.w; prv[4] = b_.x; prv[5] = b_.y; prv[6] = b_.z; prv[7] = b_.w;
          }
        } else {
          const uint4 pu_ = *(const uint4*)(pc - INC + i * 8);
          prv[0] = bflo(pu_.x); prv[1] = bfhi(pu_.x); prv[2] = bflo(pu_.y); prv[3] = bfhi(pu_.y); prv[4] = bflo(pu_.z); prv[5] = bfhi(pu_.z); prv[6] = bflo(pu_.w); prv[7] = bfhi(pu_.w);
        }
        const float4 m0 = *(const float4*)(p.mu + base + k + i * 8), m1 = *(const float4*)(p.mu + base + k + i * 8 + 4);
        const float mm[8] = {m0.x, m0.y, m0.z, m0.w, m1.x, m1.y, m1.z, m1.w};
        float f[8];
#pragma unroll
        for (int j = 0; j < 8; ++j) {
          const float ps = cur[j] + (prv[j] - cur[j]) * mm[j];
          f[j] = WHICH == 0 ? tanh_fast(ps) : (WHICH == 1 ? ps : sigmoidf_(ps));
        }
        return make_uint4(pk2(f[0], f[1]), pk2(f[2], f[3]), pk2(f[4], f[5]), pk2(f[6], f[7]));
      };
      o0 = one(0); o1 = one(1); o2 = one(2); o3 = one(3);
    };
    auto ep = [&](int row, int col, float4 v4) {
      const size_t o = (size_t)row * 512 + col;
      const float v[4] = {v4.x, v4.y, v4.z, v4.w};
      float f[4];
      if (WHICH == 0) {
        const float4 w0 = *(const float4*)(p.w0 + col);
        const float ww[4] = {w0.x, w0.y, w0.z, w0.w};
#pragma unroll
        for (int j = 0; j < 4; ++j) {
          const float z = -(ww[j] + v[j]);
          const float sp = fmaxf(z, 0.f) + __logf(1.f + __expf(-fabsf(z)));
          f[j] = -__expf(-sp - 0.5f);
        }
        *(uint2*)(p.LD + o) = make_uint2(pk2(f[0], f[1]), pk2(f[2], f[3]));
      } else if (WHICH == 1) {
        const float4 a0 = *(const float4*)(p.a0 + col);
        const float aa[4] = {a0.x, a0.y, a0.z, a0.w};
#pragma unroll
        for (int j = 0; j < 4; ++j) f[j] = sigmoidf_(aa[j] + v[j]);
        *(uint2*)(p.AA + o) = make_uint2(pk2(f[0], f[1]), pk2(f[2], f[3]));
      } else {
        *(uint2*)(p.GG + o) = make_uint2(pk2(v[0], v[1]), pk2(v[2], v[3]));
      }
    };
    gemm_tile(mt * 128, nt * 128, WHICH == 2 ? 128 : 64, WHICH == 0 ? p.w2T : (WHICH == 1 ? p.a2T : p.g2T), al, ep, lds);
  }
}
__device__ void phase2(const Params& p, unsigned char* lds) {
  lora_tiles<0>(p, lds);
  lora_tiles<1>(p, lds);
  lora_tiles<2>(p, lds);
  s5_pass_a(p);
}

template <int CTRL>
__device__ __forceinline__ float dppf(float x) { return __uint_as_float((unsigned)__builtin_amdgcn_update_dpp(0, (int)__float_as_uint(x), CTRL, 0xf, 0xf, true)); }
template <int LPR>
__device__ __forceinline__ float red_lpr(float x) {
  x += dppf<0xB1>(x); x += dppf<0x4E>(x);
  if (LPR == 16) { x += dppf<0x141>(x); x += dppf<0x140>(x); }
  return x;
}
struct RwVec { float4 w, kk, b, k, r; };
template <int LPR, bool PROMPT>
__device__ void rwkv_job(const Params& p, int sq, int h, int rg, unsigned char* lds) {
  constexpr int ROWS = NT / LPR, KPL = 64 / LPR, NV = KPL / 4;
  float* Lr = (float*)lds;
  float* Lw = Lr + 17 * 64;
  float* Lk = Lw + 17 * 64;
  float* Lkk = Lk + 17 * 64;
  float* Lb = Lkk + 17 * 64;
  float* Lv = Lb + 17 * 64;
  float* Lyp0 = Lv + 17 * 64;
  const int tid = threadIdx.x;
  constexpr bool prompt = PROMPT;
  constexpr int T = PROMPT ? 2048 : 8;
  const int tokbase = prompt ? sq * 2048 : NPT + (sq - 8) * 8;
  const int row = tid / LPR, kq = tid % LPR;
  const int grow = rg * ROWS + row;
  float S[KPL];
  if (prompt) {
#pragma unroll
    for (int j = 0; j < KPL; ++j) S[j] = 0.f;
  } else {
    const float* s0 = p.wkv0 + (((size_t)(sq - 8) * 8 + h) * 64 + grow) * 64 + kq * KPL;
#pragma unroll
    for (int j = 0; j < NV; ++j) { const float4 v = ((const float4*)s0)[j]; S[j * 4] = v.x; S[j * 4 + 1] = v.y; S[j * 4 + 2] = v.z; S[j * 4 + 3] = v.w; }
  }
  const int tt = tid >> 4, kg = tid & 15, k4 = kg * 4;
  const int hc = h * 64 + k4;
  float mur[4], muk[4], muv[4], kkc[4], kac[4], rkc[4];
#pragma unroll
  for (int j = 0; j < 4; ++j) {
    mur[j] = p.mu[hc + j]; muk[j] = p.mu[512 + hc + j]; muv[j] = p.mu[1024 + hc + j];
    kkc[j] = p.k_k[hc + j]; kac[j] = p.k_a[hc + j]; rkc[j] = p.r_k[hc + j];
  }
  uint2 Acr, Ack, Acv, Aqr, Aqk, Aqv, Ald, Aaa;
  uint2 Bcr, Bck, Bcv, Bqr, Bqk, Bqv, Bld, Baa;
  auto gload = [&](int c0, uint2& cr, uint2& ck, uint2& cv, uint2& qr, uint2& qk, uint2& qv, uint2& ldv, uint2& aav) {
    const int cc0 = PROMPT ? min(c0, T - 16) : 0;
    const int nst = PROMPT ? 16 : 8;
    const int t = cc0 + (tt < nst ? tt : 0);
    const int tok = tokbase + t;
    const bfu* pc = p.PJ + (size_t)tok * INC + 512 + hc;
    const bfu* pp = pc - (t > 0 ? INC : 0);
    cr = *(const uint2*)(pc); ck = *(const uint2*)(pc + 512); cv = *(const uint2*)(pc + 1024);
    qr = *(const uint2*)(pp); qk = *(const uint2*)(pp + 512); qv = *(const uint2*)(pp + 1024);
    ldv = *(const uint2*)(p.LD + (size_t)tok * 512 + hc);
    aav = *(const uint2*)(p.AA + (size_t)tok * 512 + hc);
  };
  auto store_y = [&](int c0, const float* Lyp) {
    constexpr int nst = PROMPT ? 16 : 8;
    for (int i = tid; i < nst * ROWS; i += NT) {
      const int s = i / ROWS, rr = i % ROWS;
      const float4* yp = (const float4*)(Lyp + (size_t)i * LPR);
      float y = 0.f;
#pragma unroll
      for (int j = 0; j < LPR / 4; ++j) { const float4 v = yp[j]; y += (v.x + v.y) + (v.z + v.w); }
      p.out[(size_t)(tokbase + c0 + s) * 1024 + 512 + h * 64 + rg * ROWS + rr] = y;
    }
  };
  auto process = [&](int c0, int par, uint2& cr, uint2& ck, uint2& cv, uint2& qr, uint2& qk, uint2& qv, uint2& ldv, uint2& aav) {
    float* Lyp = Lyp0 + par * (16 * NT);
    constexpr int nst = PROMPT ? 16 : 8;
    const bool act = PROMPT ? true : (tt < nst);
    const int t = c0 + (act ? tt : 0);
    const int tok = tokbase + t;
    {
      float pr[4], pk_[4], pv_[4];
      if (t == 0) {
        if (prompt) {
#pragma unroll
          for (int j = 0; j < 4; ++j) pr[j] = pk_[j] = pv_[j] = 0.f;
        } else {
          const float* s0 = p.shift0 + (size_t)(sq - 8) * RC + hc;
#pragma unroll
          for (int j = 0; j < 4; ++j) { pr[j] = s0[j]; pk_[j] = s0[512 + j]; pv_[j] = s0[1024 + j]; }
        }
      } else {
        pr[0] = bflo(qr.x); pr[1] = bfhi(qr.x); pr[2] = bflo(qr.y); pr[3] = bfhi(qr.y);
        pk_[0] = bflo(qk.x); pk_[1] = bfhi(qk.x); pk_[2] = bflo(qk.y); pk_[3] = bfhi(qk.y);
        pv_[0] = bflo(qv.x); pv_[1] = bfhi(qv.x); pv_[2] = bflo(qv.y); pv_[3] = bfhi(qv.y);
      }
      const float c_r[4] = {bflo(cr.x), bfhi(cr.x), bflo(cr.y), bfhi(cr.y)};
      const float c_k[4] = {bflo(ck.x), bfhi(ck.x), bflo(ck.y), bfhi(ck.y)};
      const float c_v[4] = {bflo(cv.x), bfhi(cv.x), bflo(cv.y), bfhi(cv.y)};
      const float ld4[4] = {bflo(ldv.x), bfhi(ldv.x), bflo(ldv.y), bfhi(ldv.y)};
      const float aa4[4] = {bflo(aav.x), bfhi(aav.x), bflo(aav.y), bfhi(aav.y)};
      float r4[4], kx4[4], v4[4], w4[4], kk4[4];
      float ssq = 0.f, bon = 0.f;
#pragma unroll
      for (int j = 0; j < 4; ++j) {
        r4[j] = c_r[j] + (pr[j] - c_r[j]) * mur[j];
        const float kx = c_k[j] + (pk_[j] - c_k[j]) * muk[j];
        v4[j] = c_v[j] + (pv_[j] - c_v[j]) * muv[j];
        w4[j] = __expf(ld4[j]);
        kk4[j] = kx * kkc[j];
        ssq += kk4[j] * kk4[j];
        kx4[j] = kx * (1.f + (aa4[j] - 1.f) * kac[j]);
        bon += r4[j] * kx4[j] * rkc[j];
      }
      ssq = red_lpr<16>(ssq); bon = red_lpr<16>(bon);
      const float inv = rsqrtf(fmaxf(ssq, 1e-24f));
      __syncthreads();
      if (act) {
        *(float4*)(Lr + tt * 64 + k4) = make_float4(r4[0], r4[1], r4[2], r4[3]);
        *(float4*)(Lw + tt * 64 + k4) = make_float4(w4[0], w4[1], w4[2], w4[3]);
        *(float4*)(Lk + tt * 64 + k4) = make_float4(kx4[0], kx4[1], kx4[2], kx4[3]);
        *(float4*)(Lkk + tt * 64 + k4) = make_float4(kk4[0] * inv, kk4[1] * inv, kk4[2] * inv, kk4[3] * inv);
        *(float4*)(Lb + tt * 64 + k4) = make_float4(kk4[0] * inv * aa4[0], kk4[1] * inv * aa4[1], kk4[2] * inv * aa4[2], kk4[3] * inv * aa4[3]);
        *(float4*)(Lv + tt * 64 + k4) = make_float4(v4[0], v4[1], v4[2], v4[3]);
        (rg == 0 ? p.BON : p.BONX)[(size_t)tok * 8 + h] = bon;
      }
    }
    __syncthreads();
    if (PROMPT) store_y(max(c0 - 16, 0), Lyp0 + (par ^ 1) * (16 * NT));
    gload(c0 + 32, cr, ck, cv, qr, qk, qv, ldv, aav);
    {
      auto ldvec = [&](int s, int j) -> RwVec {
        RwVec v;
        const int o = s * 64 + kq * KPL + j * 4;
        v.w = *(const float4*)(Lw + o); v.kk = *(const float4*)(Lkk + o); v.b = *(const float4*)(Lb + o);
        v.k = *(const float4*)(Lk + o); v.r = *(const float4*)(Lr + o);
        return v;
      };
      RwVec cur[NV];
      float vcur;
#pragma unroll
      for (int j = 0; j < NV; ++j) cur[j] = ldvec(0, j);
      vcur = Lv[grow];
      for (int s = 0; s < nst; ++s) {
        RwVec nxt[NV];
        float vnx;
#pragma unroll
        for (int j = 0; j < NV; ++j) nxt[j] = ldvec(s + 1, j);
        vnx = Lv[(s + 1) * 64 + grow];
        float sa0 = 0.f, sa1 = 0.f;
#pragma unroll
        for (int j = 0; j < NV; ++j) {
          sa0 += S[j * 4] * cur[j].kk.x; sa1 += S[j * 4 + 1] * cur[j].kk.y;
          sa0 += S[j * 4 + 2] * cur[j].kk.z; sa1 += S[j * 4 + 3] * cur[j].kk.w;
        }
        float tq[KPL];
#pragma unroll
        for (int j = 0; j < NV; ++j) {
          tq[j * 4] = S[j * 4] * cur[j].w.x + vcur * cur[j].k.x;
          tq[j * 4 + 1] = S[j * 4 + 1] * cur[j].w.y + vcur * cur[j].k.y;
          tq[j * 4 + 2] = S[j * 4 + 2] * cur[j].w.z + vcur * cur[j].k.z;
          tq[j * 4 + 3] = S[j * 4 + 3] * cur[j].w.w + vcur * cur[j].k.w;
        }
        float sa = -red_lpr<LPR>(sa0 + sa1);
        float y0 = 0.f, y1 = 0.f;
#pragma unroll
        for (int j = 0; j < NV; ++j) {
          S[j * 4] = tq[j * 4] + sa * cur[j].b.x;
          S[j * 4 + 1] = tq[j * 4 + 1] + sa * cur[j].b.y;
          S[j * 4 + 2] = tq[j * 4 + 2] + sa * cur[j].b.z;
          S[j * 4 + 3] = tq[j * 4 + 3] + sa * cur[j].b.w;
          y0 += S[j * 4] * cur[j].r.x; y1 += S[j * 4 + 1] * cur[j].r.y;
          y0 += S[j * 4 + 2] * cur[j].r.z; y1 += S[j * 4 + 3] * cur[j].r.w;
        }
        Lyp[(s * ROWS + row) * LPR + kq] = y0 + y1;
#pragma unroll
        for (int j = 0; j < NV; ++j) cur[j] = nxt[j];
        vcur = vnx;
      }
    }
  };
  gload(0, Acr, Ack, Acv, Aqr, Aqk, Aqv, Ald, Aaa);
  gload(16, Bcr, Bck, Bcv, Bqr, Bqk, Bqv, Bld, Baa);
  for (int c0 = 0; c0 < T; c0 += 32) {
    process(c0, 0, Acr, Ack, Acv, Aqr, Aqk, Aqv, Ald, Aaa);
    if (PROMPT) process(c0 + 16, 1, Bcr, Bck, Bcv, Bqr, Bqk, Bqv, Bld, Baa);
  }
  __syncthreads();
  {
    const int lastc = ((T - 1) >> 4) << 4;
    store_y(lastc, Lyp0 + ((lastc >> 4) & 1) * (16 * NT));
  }
  {
    float* so = p.out + (prompt ? O_WKV_P + (((size_t)sq * 8 + h) * 64 + grow) * 64 : O_WKV_S + (((size_t)(sq - 8) * 8 + h) * 64 + grow) * 64) + kq * KPL;
#pragma unroll
    for (int j = 0; j < NV; ++j) ((float4*)so)[j] = make_float4(S[j * 4], S[j * 4 + 1], S[j * 4 + 2], S[j * 4 + 3]);
  }
  __syncthreads();
}
__device__ void rwkv_post(const Params& p) {
  const int tid = threadIdx.x;
  const int h = (tid >> 4) & 7, kg = tid & 15, k4 = kg * 4, hc = h * 64 + k4;
  float muv[4], gnw[4], gnb[4];
#pragma unroll
  for (int j = 0; j < 4; ++j) { muv[j] = p.mu[1024 + hc + j]; gnw[j] = p.gn_w[hc + j]; gnb[j] = p.gn_b[hc + j]; }
  for (int it = blockIdx.x; it < NTOK / 2; it += gridDim.x) {
    const int tok = it * 2 + (tid >> 7);
    const int t = t_of(tok);
    const bfu* pc = p.PJ + (size_t)tok * INC + 512 + 1024 + hc;
    const uint2 cv = *(const uint2*)pc;
    float pv_[4];
    if (t == 0) {
      if (tok < NPT) { pv_[0] = pv_[1] = pv_[2] = pv_[3] = 0.f; }
      else { const float* s0 = p.shift0 + (size_t)(sq_of(tok) - 8) * RC + 1024 + hc; pv_[0] = s0[0]; pv_[1] = s0[1]; pv_[2] = s0[2]; pv_[3] = s0[3]; }
    } else {
      const uint2 qv = *(const uint2*)(pc - INC);
      pv_[0] = bflo(qv.x); pv_[1] = bfhi(qv.x); pv_[2] = bflo(qv.y); pv_[3] = bfhi(qv.y);
    }
    const float c_v[4] = {bflo(cv.x), bfhi(cv.x), bflo(cv.y), bfhi(cv.y)};
    float* yp = p.out + (size_t)tok * 1024 + 512 + hc;
    const float4 y4 = *(const float4*)yp;
    const float mean = red_lpr<16>(y4.x + y4.y + y4.z + y4.w) * (1.f / 64.f);
    const float dd[4] = {y4.x - mean, y4.y - mean, y4.z - mean, y4.w - mean};
    const float rstd = rsqrtf(red_lpr<16>(dd[0] * dd[0] + dd[1] * dd[1] + dd[2] * dd[2] + dd[3] * dd[3]) * (1.f / 64.f) + GN_EPS);
    const float bon = p.BON[(size_t)tok * 8 + h];
    const uint2 gv = *(const uint2*)(p.GG + (size_t)tok * 512 + hc);
    const float g4[4] = {bflo(gv.x), bfhi(gv.x), bflo(gv.y), bfhi(gv.y)};
    float o4[4];
#pragma unroll
    for (int j = 0; j < 4; ++j) {
      const float v = c_v[j] + (pv_[j] - c_v[j]) * muv[j];
      o4[j] = (dd[j] * rstd * gnw[j] + gnb[j] + bon * v) * g4[j];
    }
    *(uint2*)(p.CAT + (size_t)tok * 1024 + 512 + hc) = make_uint2(pk2(o4[0], o4[1]), pk2(o4[2], o4[3]));
  }
}

#ifndef P3MODE
#define P3MODE 0
#endif
__device__ void phase3(const Params& p, unsigned char* lds, int cw = 0, int mode = 0) {
  volatile int* jb = (volatile int*)(lds + LDS_JOB);
  for (;;) {
    __syncthreads();
    if (threadIdx.x == 0) *jb = (int)atomicAdd(&p.bar[cw], 1u);
    __syncthreads();
    const int j = *jb;
    if (j >= 4352) break;
    if (j < 256) { if (mode != 1) rwkv_job<16, true>(p, j >> 5, (j >> 2) & 7, j & 3, lds); }
    else if (j < 2304) { if (mode != 2) s5_job_c(p, j - 256, true, lds); }
    else if (j < 3328) { const int q = j - 2304; if (mode != 1) rwkv_job<4, false>(p, 8 + (q >> 3), q & 7, 0, lds); }
    else { if (mode != 2) s5_job_c(p, j - 3328, false, lds); }
  }
}

__device__ void phase4a(const Params& p, unsigned char* lds) {
  rwkv_post(p);
  for (int t = blockIdx.x; t < 136 * 4; t += gridDim.x) {
    const int mt = t >> 2, nt = t & 3;
    auto al = [&](int row, int k, uint4& o0, uint4& o1, uint4& o2, uint4& o3) {
      const float4* s = (const float4*)(p.Y5 + (size_t)row * 512 + k);
      auto one = [&](int i) -> uint4 { const float4 a = s[i * 2], b = s[i * 2 + 1]; return make_uint4(pk2(a.x, a.y), pk2(a.z, a.w), pk2(b.x, b.y), pk2(b.z, b.w)); };
      o0 = one(0); o1 = one(1); o2 = one(2); o3 = one(3);
    };
    auto ep = [&](int row, int col, float4 v) {
      const float4 y = *(const float4*)(p.Y5 + (size_t)row * 512 + col), bg = *(const float4*)(p.b_glu + col);
      *(uint2*)(p.CAT + (size_t)row * 1024 + col) = make_uint2(pk2(y.x * sigmoidf_(v.x + bg.x), y.y * sigmoidf_(v.y + bg.y)), pk2(y.z * sigmoidf_(v.z + bg.z), y.w * sigmoidf_(v.w + bg.w)));
    };
    gemm_tile(mt * 128, nt * 128, 512, p.WgluT, al, ep, lds);
  }
}
__device__ void phase4b(const Params& p, unsigned char* lds) {
  for (int t = blockIdx.x; t < 136 * 8; t += gridDim.x) {
    const int mt = t >> 3, nt = t & 7;
    auto al = [&](int row, int k, uint4& o0, uint4& o1, uint4& o2, uint4& o3) {
      const uint4* s_ = (const uint4*)(p.CAT + (size_t)row * 1024 + k);
      o0 = s_[0]; o1 = s_[1]; o2 = s_[2]; o3 = s_[3];
    };
    auto ep = [&](int row, int col, float4 v) {
      const int sq = sq_of(row);
      const float4 x = *(const float4*)(xrow(p, row) + col), g = *(const float4*)(p.mod + (size_t)sq * 6144 + 2048 + col);
      *(float4*)(p.X1 + (size_t)row * 1024 + col) = make_float4(x.x + g.x * v.x, x.y + g.y * v.y, x.z + g.z * v.z, x.w + g.w * v.w);
    };
    gemm_tile(mt * 128, nt * 128, 1024, p.WoutT, al, ep, lds);
  }
}
template <bool FROMX>
__device__ void norm_rows(const Params& p, const float* __restrict__ gsrc, int sh_off, bfu* __restrict__ dst) {
  const int lane = threadIdx.x & 63, gw = (blockIdx.x * NT + threadIdx.x) >> 6, nw = (gridDim.x * NT) >> 6;
  for (int tok = gw; tok < NTOK; tok += nw) {
    const float* xr = FROMX ? xrow(p, tok) : p.X1 + (size_t)tok * 1024;
    const float* md = p.mod + (size_t)sq_of(tok) * 6144 + sh_off;
    float4 v[4];
    float s = 0.f;
#pragma unroll
    for (int i = 0; i < 4; ++i) { const float4 a = *(const float4*)(xr + lane * 16 + i * 4); v[i] = a; s += a.x * a.x + a.y * a.y + a.z * a.z + a.w * a.w; }
#pragma unroll
    for (int o = 32; o > 0; o >>= 1) s += __shfl_xor(s, o);
    const float rs = rsqrtf(s * (1.f / 1024.f) + NORM_EPS);
    float f[16];
#pragma unroll
    for (int i = 0; i < 4; ++i) {
      const int k = lane * 16 + i * 4;
      const float4 g4 = *(const float4*)(gsrc + k), sh = *(const float4*)(md + k), sc = *(const float4*)(md + 1024 + k);
      const float4 a = v[i];
      f[i * 4 + 0] = a.x * rs * g4.x * (1.f + sc.x) + sh.x;
      f[i * 4 + 1] = a.y * rs * g4.y * (1.f + sc.y) + sh.y;
      f[i * 4 + 2] = a.z * rs * g4.z * (1.f + sc.z) + sh.z;
      f[i * 4 + 3] = a.w * rs * g4.w * (1.f + sc.w) + sh.w;
    }
    uint4* d = (uint4*)(dst + (size_t)tok * 1024 + lane * 16);
    d[0] = make_uint4(pk2(f[0], f[1]), pk2(f[2], f[3]), pk2(f[4], f[5]), pk2(f[6], f[7]));
    d[1] = make_uint4(pk2(f[8], f[9]), pk2(f[10], f[11]), pk2(f[12], f[13]), pk2(f[14], f[15]));
  }
}
__device__ void phase0b(const Params& p) { norm_rows<true>(p, p.n1g, 0, p.H1); }
__device__ void phase5a(const Params& p) { norm_rows<false>(p, p.n2g, 3072, p.H2); }
__device__ void phase5b(const Params& p, unsigned char* lds) {
  for (int t = blockIdx.x; t < 136 * 8; t += gridDim.x) {
    const int mt = t >> 3, nt = t & 7;
    auto al = [&](int row, int k, uint4& o0, uint4& o1, uint4& o2, uint4& o3) {
      const uint4* s = (const uint4*)(p.H2 + (size_t)row * 1024 + k);
      o0 = s[0]; o1 = s[1]; o2 = s[2]; o3 = s[3];
    };
    auto ep = [&](int row, int col, float4 v) { *(uint2*)(p.Q + (size_t)row * 1024 + col) = make_uint2(pk2(v.x, v.y), pk2(v.z, v.w)); };
    gemm_tile(mt * 128, nt * 128, 1024, p.WqT, al, ep, lds);
  }
}

__device__ __forceinline__ void ins16(float (&L)[16], float x) {
#pragma unroll
  for (int j = 0; j < 16; ++j) { const float hi = fmaxf(L[j], x); x = fminf(L[j], x); L[j] = hi; }
}
__device__ __forceinline__ void ce_desc(float& a, float& b) { const float hi = fmaxf(a, b), lo = fminf(a, b); a = hi; b = lo; }
__device__ __forceinline__ void sort16_desc(float (&a)[16]) {
#pragma unroll
  for (int k = 2; k <= 16; k <<= 1)
#pragma unroll
    for (int j = k >> 1; j > 0; j >>= 1)
#pragma unroll
      for (int i = 0; i < 16; ++i) {
        const int l = i ^ j;
        if (l > i) {
          if ((i & k) == 0) ce_desc(a[i], a[l]);
          else ce_desc(a[l], a[i]);
        }
      }
}
__device__ __forceinline__ void merge16_desc(float (&L)[16], const float (&T)[16]) {
#pragma unroll
  for (int i = 0; i < 16; ++i) L[i] = fmaxf(L[i], T[15 - i]);
#pragma unroll
  for (int j = 8; j > 0; j >>= 1)
#pragma unroll
    for (int i = 0; i < 16; ++i) { const int l = i ^ j; if (l > i) ce_desc(L[i], L[l]); }
}
__device__ __forceinline__ void peer_side_top16(const Params& p, const bfu* __restrict__ keys, int tok, int h, int side, int lane, float (&L)[16]) {
  const int l31 = lane & 31, lh = lane >> 5;
  bf16x8 bq[4];
#pragma unroll
  for (int ks = 0; ks < 4; ++ks) bq[ks] = *(const bf16x8*)(p.Q + (size_t)tok * 1024 + h * 128 + side * 64 + ks * 16 + lh * 8);
#pragma unroll
  for (int nt = 0; nt < 4; ++nt) {
    f32x16 acc;
#pragma unroll
    for (int r = 0; r < 16; ++r) acc[r] = 0.f;
#pragma unroll
    for (int ks = 0; ks < 4; ++ks) {
      const bf16x8 ak = *(const bf16x8*)(keys + ((size_t)(h * 128 + nt * 32 + l31)) * 64 + ks * 16 + lh * 8);
      acc = __builtin_amdgcn_mfma_f32_32x32x16_bf16(ak, bq[ks], acc, 0, 0, 0);
    }
    float V[16];
#pragma unroll
    for (int r = 0; r < 16; ++r) {
      const unsigned n = (unsigned)(nt * 32 + (r & 3) + 8 * (r >> 2)) + 4u * (unsigned)lh;
      V[r] = __uint_as_float((__float_as_uint(acc[r]) & ~127u) | n);
    }
    sort16_desc(V);
    if (nt == 0) {
#pragma unroll
      for (int j = 0; j < 16; ++j) L[j] = V[j];
    } else merge16_desc(L, V);
  }
  float P[16];
#pragma unroll
  for (int j = 0; j < 16; ++j) P[j] = __shfl_xor(L[j], 32);
  merge16_desc(L, P);
}
__device__ void phase6(const Params& p, unsigned char* lds) {
  const int tid = threadIdx.x, lane = tid & 63, wid = tid >> 6;
  unsigned char* ib = lds + wid * (64 * 36);
  const int gw = (blockIdx.x * NT + tid) >> 6, nw = (gridDim.x * NT) >> 6;
  for (int job = gw; job < (NTOK / 32) * 8; job += nw) {
    const int tile = job >> 3, h = job & 7;
    const int tok = tile * 32 + (lane & 31);
    float L1[16], L2[16];
    peer_side_top16(p, p.K1, tok, h, 0, lane, L1);
    peer_side_top16(p, p.K2, tok, h, 1, lane, L2);
    {
      unsigned* iw = (unsigned*)(ib + lane * 36);
#pragma unroll
      for (int q = 0; q < 4; ++q) {
        iw[q] = (__float_as_uint(L1[q * 4]) & 127u) | ((__float_as_uint(L1[q * 4 + 1]) & 127u) << 8) | ((__float_as_uint(L1[q * 4 + 2]) & 127u) << 16) | ((__float_as_uint(L1[q * 4 + 3]) & 127u) << 24);
        iw[4 + q] = (__float_as_uint(L2[q * 4]) & 127u) | ((__float_as_uint(L2[q * 4 + 1]) & 127u) << 8) | ((__float_as_uint(L2[q * 4 + 2]) & 127u) << 16) | ((__float_as_uint(L2[q * 4 + 3]) & 127u) << 24);
      }
    }
    float C[16];
    {
      auto cand = [&](int i, int j) -> float {
        const float v = __uint_as_float(__float_as_uint(L1[i]) & ~127u) + __uint_as_float(__float_as_uint(L2[j]) & ~127u);
        return __uint_as_float((__float_as_uint(v) & ~255u) | (unsigned)(i * 16 + j));
      };
      float R[16];
#pragma unroll
      for (int j = 0; j < 16; ++j) { C[j] = cand(0, j); R[j] = j < 8 ? cand(1, j) : -3.0e38f; }
      merge16_desc(C, R);
      R[0] = cand(2, 0); R[1] = cand(2, 1); R[2] = cand(2, 2); R[3] = cand(2, 3); R[4] = cand(2, 4);
      R[5] = cand(3, 0); R[6] = cand(3, 1); R[7] = cand(3, 2); R[8] = cand(3, 3);
      R[9] = cand(4, 0); R[10] = cand(4, 1); R[11] = cand(4, 2);
      R[12] = cand(5, 0); R[13] = cand(5, 1); R[14] = cand(6, 0); R[15] = cand(6, 1);
      sort16_desc(R);
      merge16_desc(C, R);
      R[0] = cand(7, 0); R[1] = cand(7, 1);
#pragma unroll
      for (int i = 8; i < 16; ++i) R[i - 6] = cand(i, 0);
#pragma unroll
      for (int j = 10; j < 16; ++j) R[j] = -3.0e38f;
      sort16_desc(R);
      merge16_desc(C, R);
    }
    __builtin_amdgcn_wave_barrier();
    const float m = __uint_as_float(__float_as_uint(C[0]) & ~255u);
    float e[16], sum = 0.f;
    unsigned idx[16];
#pragma unroll
    for (int j = 0; j < 16; ++j) {
      const unsigned cb = __float_as_uint(C[j]);
      e[j] = __expf(__uint_as_float(cb & ~255u) - m);
      sum += e[j];
      const unsigned i1 = ib[lane * 36 + ((cb >> 4) & 15u)], i2 = ib[lane * 36 + 16 + (cb & 15u)];
      idx[j] = i1 * 128u + i2;
    }
    const float inv = 1.f / sum;
    if (lane < 32) {
      uint4* eo = (uint4*)(p.EI + (size_t)tok * 128 + h * 16);
      float4* go = (float4*)(p.EG + (size_t)tok * 128 + h * 16);
#pragma unroll
      for (int q = 0; q < 4; ++q) {
        eo[q] = make_uint4(idx[q * 4], idx[q * 4 + 1], idx[q * 4 + 2], idx[q * 4 + 3]);
        go[q] = make_float4(e[q * 4] * inv, e[q * 4 + 1] * inv, e[q * 4 + 2] * inv, e[q * 4 + 3] * inv);
      }
    }
    __builtin_amdgcn_wave_barrier();
  }
}

typedef float v32f __attribute__((ext_vector_type(32)));
typedef float v2f __attribute__((ext_vector_type(2)));
typedef unsigned v6u __attribute__((ext_vector_type(6)));
typedef __bf16 v2bf __attribute__((ext_vector_type(2)));
typedef __bf16 v32bf __attribute__((ext_vector_type(32)));
__device__ __forceinline__ v32f unpack_fp6(const uint4 a, const uint2 b) {
  v6u w; w[0] = a.x; w[1] = a.y; w[2] = a.z; w[3] = a.w; w[4] = b.x; w[5] = b.y;
  return __builtin_amdgcn_cvt_scalef32_pk32_f32_fp6(w, 1.0f);
}
__device__ void phase7(const Params& p) {
  const int lane = threadIdx.x & 63, l31 = lane & 31, half = lane >> 5;
  const int gw = (blockIdx.x * NT + threadIdx.x) >> 6, nw = (gridDim.x * NT) >> 6;
  for (int tok = gw; tok < NTOK; tok += nw) {
    unsigned hp16[16];
    {
      const uint2* hp = (const uint2*)(p.H2 + (size_t)tok * 1024 + l31 * 4);
#pragma unroll
      for (int i = 0; i < 8; ++i) { const uint2 a = hp[i * 32]; hp16[i * 2] = a.x; hp16[i * 2 + 1] = a.y; }
    }
    const unsigned ei0 = p.EI[(size_t)tok * 128 + lane] & 16383u, ei1 = p.EI[(size_t)tok * 128 + 64 + lane] & 16383u;
    const float eg0 = p.EG[(size_t)tok * 128 + lane] * p.SV[ei0], eg1 = p.EG[(size_t)tok * 128 + 64 + lane] * p.SV[ei1];
    const float su0 = p.SU[ei0], su1 = p.SU[ei1];
    float ff[32];
#pragma unroll
    for (int j = 0; j < 32; ++j) ff[j] = 0.f;
#pragma unroll 1
    for (int grp = 0; grp < 16; ++grp) {
      const unsigned eiv = grp < 8 ? ei0 : ei1;
      const float egv = grp < 8 ? eg0 : eg1;
      const float suv = grp < 8 ? su0 : su1;
      const int lb = (grp & 7) * 8;
      uint4 ua[4], va[4];
#pragma unroll
      for (int i = 0; i < 4; ++i) {
        const unsigned id = (unsigned)__shfl((int)eiv, lb + 2 * i + half);
        const unsigned char* ur = p.TU + (size_t)id * 512;
        const unsigned char* vr = p.TV + (size_t)id * 512;
        ua[i] = *(const uint4*)(ur + l31 * 16);
        va[i] = *(const uint4*)(vr + l31 * 16);
      }
      float part[4];
#pragma unroll
      for (int i = 0; i < 4; ++i) {
        const unsigned wq[4] = {ua[i].x, ua[i].y, ua[i].z, ua[i].w};
        float s0 = 0.f, s1 = 0.f;
#pragma unroll
        for (int d = 0; d < 4; ++d) {
          s0 = __builtin_amdgcn_fdot2_f32_bf16(__builtin_amdgcn_cvt_scalef32_pk_bf16_fp4(wq[d], 1.0f, 0), __builtin_bit_cast(v2bf, hp16[d * 4 + 0]), s0, false);
          s1 = __builtin_amdgcn_fdot2_f32_bf16(__builtin_amdgcn_cvt_scalef32_pk_bf16_fp4(wq[d], 1.0f, 1), __builtin_bit_cast(v2bf, hp16[d * 4 + 1]), s1, false);
          s0 = __builtin_amdgcn_fdot2_f32_bf16(__builtin_amdgcn_cvt_scalef32_pk_bf16_fp4(wq[d], 1.0f, 2), __builtin_bit_cast(v2bf, hp16[d * 4 + 2]), s0, false);
          s1 = __builtin_amdgcn_fdot2_f32_bf16(__builtin_amdgcn_cvt_scalef32_pk_bf16_fp4(wq[d], 1.0f, 3), __builtin_bit_cast(v2bf, hp16[d * 4 + 3]), s1, false);
        }
        part[i] = s0 + s1;
        __builtin_amdgcn_sched_barrier(0);
      }
      float r2[2], r1;
      {
        const bool h4 = lane & 16;
#pragma unroll
        for (int i = 0; i < 2; ++i) { const float keep = h4 ? part[i + 2] : part[i], send = h4 ? part[i] : part[i + 2]; r2[i] = keep + __shfl_xor(send, 16); }
        const bool h3 = lane & 8;
        { const float keep = h3 ? r2[1] : r2[0], send = h3 ? r2[0] : r2[1]; r1 = keep + __shfl_xor(send, 8); }
        r1 += dppf<0x141>(r1); r1 += dppf<0x4E>(r1); r1 += dppf<0xB1>(r1);
      }
      const int myI = ((lane >> 4) & 1) * 2 + ((lane >> 3) & 1);
      const int slot = lb + 2 * myI + half;
      const float gate = __shfl(egv, slot), su = __shfl(suv, slot);
      const float coef = gate * gelu_(r1 * su);
#pragma unroll
      for (int i = 0; i < 4; ++i) {
        const float c = __shfl(coef, (lane & 32) + ((i >> 1) & 1) * 16 + (i & 1) * 8);
        const unsigned wv[4] = {va[i].x, va[i].y, va[i].z, va[i].w};
#pragma unroll
        for (int d = 0; d < 4; ++d) {
          const v2f v0 = __builtin_amdgcn_cvt_scalef32_pk_f32_fp4(wv[d], 1.0f, 0);
          const v2f v1 = __builtin_amdgcn_cvt_scalef32_pk_f32_fp4(wv[d], 1.0f, 1);
          const v2f v2 = __builtin_amdgcn_cvt_scalef32_pk_f32_fp4(wv[d], 1.0f, 2);
          const v2f v3 = __builtin_amdgcn_cvt_scalef32_pk_f32_fp4(wv[d], 1.0f, 3);
          ff[d * 8 + 0] += c * v0[0]; ff[d * 8 + 1] += c * v0[1]; ff[d * 8 + 2] += c * v1[0]; ff[d * 8 + 3] += c * v1[1];
          ff[d * 8 + 4] += c * v2[0]; ff[d * 8 + 5] += c * v2[1]; ff[d * 8 + 6] += c * v3[0]; ff[d * 8 + 7] += c * v3[1];
        }
        __builtin_amdgcn_sched_barrier(0);
      }
    }
    float fs[16];
#pragma unroll
    for (int j = 0; j < 16; ++j) {
      const float mine = half ? ff[16 + j] : ff[j], other = half ? ff[j] : ff[16 + j];
      fs[j] = mine + __shfl_xor(other, 32);
    }
    const int k0 = half * 512 + l31 * 4;
    const float* x1 = p.X1 + (size_t)tok * 1024 + k0;
    const float* ga = p.mod + (size_t)sq_of(tok) * 6144 + 5120 + k0;
    float xf[16];
    float s = 0.f;
#pragma unroll
    for (int i = 0; i < 4; ++i) {
      const float4 a = *(const float4*)(x1 + i * 128), g4 = *(const float4*)(ga + i * 128);
      xf[i * 4] = a.x + g4.x * fs[i * 4]; xf[i * 4 + 1] = a.y + g4.y * fs[i * 4 + 1]; xf[i * 4 + 2] = a.z + g4.z * fs[i * 4 + 2]; xf[i * 4 + 3] = a.w + g4.w * fs[i * 4 + 3];
      s += xf[i * 4] * xf[i * 4] + xf[i * 4 + 1] * xf[i * 4 + 1] + xf[i * 4 + 2] * xf[i * 4 + 2] + xf[i * 4 + 3] * xf[i * 4 + 3];
    }
#pragma unroll
    for (int o = 32; o > 0; o >>= 1) s += __shfl_xor(s, o);
    const float rs = rsqrtf(s * (1.f / 1024.f) + NORM_EPS);
#pragma unroll
    for (int i = 0; i < 4; ++i) {
      const float4 g4 = *(const float4*)(p.fng + k0 + i * 128);
      *(float4*)(p.out + (size_t)tok * 1024 + k0 + i * 128) = make_float4(xf[i * 4] * rs * g4.x, xf[i * 4 + 1] * rs * g4.y, xf[i * 4 + 2] * rs * g4.z, xf[i * 4 + 3] * rs * g4.w);
    }
  }
}


template <int PH>
__global__ void __launch_bounds__(NT, 2) phase_kernel(Params p) {
  __shared__ __attribute__((aligned(16))) unsigned char lds[LDS_BYTES];
  if (PH == 0) phase0(p, lds);
  if (PH == 1) { phase0b(p); phase1(p, lds); }
  if (PH == 2) phase2(p, lds);
  if (PH == 3) phase3(p, lds);
  if (PH == 4) phase4a(p, lds);
  if (PH == 5) phase4b(p, lds);
  if (PH == 6) phase5a(p);
  if (PH == 7) phase5b(p, lds);
  if (PH == 8) phase6(p, lds);
  if (PH == 9) phase7(p);
}

__global__ void __launch_bounds__(NT, 2) mega_kernel(Params p) {
  __shared__ __attribute__((aligned(16))) unsigned char lds[LDS_BYTES + 16];
  if (p.never) cg::this_grid().sync();
  volatile unsigned* st = (volatile unsigned*)(lds + LDS_BYTES);
  if (threadIdx.x == 0) { st[0] = 0u; st[1] = 0u; st[2] = 0u; st[3] = 0u; }
  __syncthreads();
  XcdBarrier b = xcd_barrier_post(p.bar, st);
  phase0(p, lds);  xcd_barrier(b);
  if (DUP == 0) { phase0(p, lds); xcd_barrier(b); }
  phase0b(p);      xcd_barrier(b);
  phase1(p, lds);  xcd_barrier(b);
  if (DUP == 1) { phase1(p, lds); xcd_barrier(b); }
  phase2(p, lds);  xcd_barrier(b);
  if (DUP == 2) { phase2(p, lds); xcd_barrier(b); }
  phase3(p, lds);  xcd_barrier(b);
  if (DUP == 3) { phase3(p, lds, 64, P3MODE); xcd_barrier(b); }
  phase4a(p, lds); xcd_barrier(b);
  if (DUP == 4) { phase4a(p, lds); xcd_barrier(b); }
  phase4b(p, lds); xcd_barrier(b);
  if (DUP == 5) { phase4b(p, lds); xcd_barrier(b); }
  phase5a(p);      xcd_barrier(b);
  if (DUP == 6) { phase5a(p); xcd_barrier(b); }
  phase5b(p, lds); xcd_barrier(b);
  if (DUP == 7) { phase5b(p, lds); xcd_barrier(b); }
  phase6(p, lds);  xcd_barrier(b);
  if (DUP == 8) { phase6(p, lds); xcd_barrier(b); }
  phase7(p);
  if (DUP == 9) { xcd_barrier(b); phase7(p); }
}

extern "C" void kernel_launch(void* const* d_in, const int* in_sizes, int n_in, void* d_out, int out_size, void* d_ws, size_t ws_size,
                              hipStream_t stream) {
  Params p;
  memset(&p, 0, sizeof(p));
  const float** f = (const float**)&p.xp;
  for (int i = 0; i < 41; ++i) f[i] = (const float*)d_in[i];
  p.out = (float*)d_out;
  unsigned char* w = (unsigned char*)d_ws;
  size_t off = 0;
  auto take = [&](size_t bytes) { unsigned char* r = w + off; off += (bytes + 255) & ~(size_t)255; return r; };
  p.bar = (unsigned*)take(XCD_BAR_WORDS * 4);
  p.TU = take((size_t)16384 * 512);
  p.TV = take((size_t)16384 * 512);
  p.SU = (float*)take(16384 * 4);
  p.SV = (float*)take(16384 * 4);
  p.WinT = (bfu*)take((size_t)2304 * 1024 * 2);
  p.WoutT = (bfu*)take((size_t)1024 * 1024 * 2);
  p.WqT = (bfu*)take((size_t)1024 * 1024 * 2);
  p.WgluT = (bfu*)take((size_t)512 * 512 * 2);
  p.K1 = (bfu*)take(65536 * 2);
  p.K2 = (bfu*)take(65536 * 2);
  p.mod = (float*)take((size_t)NSQ * 6144 * 4);
  p.rs1 = (float*)take(NTOK * 4);
  p.lbre = (float*)take(2048 * 4); p.lbim = (float*)take(2048 * 4);
  p.lbLre = (float*)take(2048 * 4); p.lbLim = (float*)take(2048 * 4);
  p.BBre = (float*)take(32768 * 4); p.BBim = (float*)take(32768 * 4);
  p.BON = (float*)take((size_t)NTOK * 8 * 4);
  p.BONX = (float*)take((size_t)NTOK * 8 * 4);
  p.w2T = (bfu*)take(512 * 64 * 2); p.a2T = (bfu*)take(512 * 64 * 2); p.g2T = (bfu*)take(512 * 128 * 2);
  p.BBh = (bfu*)take(32 * 128 * 16 * 2); p.CCh = (bfu*)take(32 * 16 * 128 * 2);
  p.E = (float*)take((size_t)8 * 32 * 32 * 128 * 4);
  unsigned char* regC = take((size_t)NTOK * INC * 2);
  p.PJ = (bfu*)regC; p.X1 = (float*)regC;
  unsigned char* regDE = take((size_t)NTOK * 1024 * 2);
  p.LD = (bfu*)regDE; p.AA = (bfu*)(regDE + (size_t)NTOK * 512 * 2); p.Q = (bfu*)regDE;
  unsigned char* regF = take((size_t)NTOK * 128 * 8);
  p.GG = (bfu*)regF; p.EI = (unsigned*)regF; p.EG = (float*)(regF + (size_t)NTOK * 128 * 4);
  unsigned char* regY = take((size_t)NTOK * 512 * 4);
  p.Y5 = (float*)regY; p.H2 = (bfu*)regY; p.H1 = (bfu*)regY; p.CAT = (bfu*)regDE;
  if (off > ws_size) { fprintf(stderr, "workspace too small: need %zu have %zu\n", off, ws_size); return; }
  p.never = 0;

  (void)hipMemsetAsync(p.bar, 0, XCD_BAR_WORDS * 4, stream);
  (void)hipMemsetAsync(p.mod, 0, (size_t)NSQ * 6144 * 4, stream);
#if MULTI
  const int G = 512;
  phase_kernel<0><<<G, NT, 0, stream>>>(p);
  phase_kernel<1><<<G, NT, 0, stream>>>(p);
  phase_kernel<2><<<G, NT, 0, stream>>>(p);
  phase_kernel<3><<<G, NT, 0, stream>>>(p);
  phase_kernel<4><<<G, NT, 0, stream>>>(p);
  phase_kernel<5><<<G, NT, 0, stream>>>(p);
  phase_kernel<6><<<G, NT, 0, stream>>>(p);
  phase_kernel<7><<<G, NT, 0, stream>>>(p);
  phase_kernel<8><<<G, NT, 0, stream>>>(p);
  phase_kernel<9><<<G, NT, 0, stream>>>(p);
#else
  static int grid_blocks = 0;
  if (!grid_blocks) {
    int dev = 0, cus = 0, per_cu = 0;
    hipGetDevice(&dev);
    hipDeviceGetAttribute(&cus, hipDeviceAttributeMultiprocessorCount, dev);
    hipOccupancyMaxActiveBlocksPerMultiprocessor(&per_cu, mega_kernel, NT, 0);
    if (per_cu > 2) per_cu = 2;
    if (per_cu < 1) per_cu = 1;
    grid_blocks = cus * per_cu;
  }
  void* args[] = {&p};
  hipError_t e = hipLaunchCooperativeKernel((void*)mega_kernel, dim3(grid_blocks), dim3(NT), args, 0, stream);
  if (e != hipSuccess) fprintf(stderr, "cooperative launch failed: %s (grid %d)\n", hipGetErrorString(e), grid_blocks);
#endif
}
```

```cpp
#include <hip/hip_runtime.h>
#include <hip/hip_cooperative_groups.h>
#include <stdint.h>
#include <stdio.h>
#include <string.h>
namespace cg = cooperative_groups;

#ifndef MULTI
#define MULTI 0
#endif
#ifndef DUP
#define DUP -1
#endif

typedef unsigned short bfu;
using bf16x8 = __attribute__((ext_vector_type(8))) short;
using f32x16 = __attribute__((ext_vector_type(16))) float;

constexpr int NTOK = 17408, NPT = 16384, NSQ = 136, DM = 1024, INC = 2304, RC = 1792;
constexpr int O_S5RE_P = 17825792, O_S5IM_P = 17842176, O_WKV_P = 17858560, O_SH_P = 18120704;
constexpr int O_S5RE_S = 18135040, O_S5IM_S = 18397184, O_WKV_S = 18659328, O_SH_S = 22853632;
constexpr float NORM_EPS = 1e-6f, GN_EPS = 64e-5f;
constexpr int NT = 256;
constexpr int LDS_BYTES = 75776;
constexpr int LDS_JOB = LDS_BYTES - 16;

struct Params {
  const float *xp, *xs, *s5re0, *s5im0, *wkv0, *shift0, *cp, *cs, *w_ada, *b_ada, *n1g, *n2g, *w_in, *w_out;
  const float *s5are, *s5aim, *s5ldt, *s5bre, *s5bim, *s5cre, *s5cim, *s5d, *w_glu, *b_glu;
  const float *mu, *w0, *w2, *a0, *a2, *g2, *k_k, *k_a, *r_k, *gn_w, *gn_b, *w_q, *keys1, *keys2, *pu, *pv, *fng;
  float* out;
  unsigned char *TU, *TV; float *SU, *SV;
  bfu *WinT, *WoutT, *WqT, *WgluT, *K1, *K2;
  float *mod, *rs1, *lbre, *lbim, *lbLre, *lbLim, *BBre, *BBim;
  bfu* PJ; float* X1; bfu *LD, *AA, *GG; float* Y5; bfu *Q, *H2; unsigned* EI; float* EG; float* BON; float* BONX; bfu *H1, *CAT; bfu *w2T, *a2T, *g2T, *BBh, *CCh; float* E;
  unsigned* bar;
  int never; int pad_;
};

__device__ __forceinline__ bfu f2bf(float f) { unsigned u = __float_as_uint(f); u += 0x7fffu + ((u >> 16) & 1u); return (bfu)(u >> 16); }
__device__ __forceinline__ float bf2f(bfu h) { return __uint_as_float(((unsigned)h) << 16); }
__device__ __forceinline__ unsigned pk2(float a, float b) { return (unsigned)f2bf(a) | ((unsigned)f2bf(b) << 16); }
__device__ __forceinline__ float bflo(unsigned u) { return __uint_as_float(u << 16); }
__device__ __forceinline__ float bfhi(unsigned u) { return __uint_as_float(u & 0xffff0000u); }
__device__ __forceinline__ int sq_of(int tok) { return tok < NPT ? (tok >> 11) : 8 + ((tok - NPT) >> 3); }
__device__ __forceinline__ int t_of(int tok) { return tok < NPT ? (tok & 2047) : ((tok - NPT) & 7); }
__device__ __forceinline__ const float* xrow(const Params& p, int tok) { return tok < NPT ? p.xp + (size_t)tok * DM : p.xs + (size_t)(tok - NPT) * DM; }
__device__ __forceinline__ float sigmoidf_(float x) { return 1.f / (1.f + __expf(-x)); }
__device__ __forceinline__ float gelu_(float x) { return 0.5f * x * (1.f + erff(x * 0.70710678118654752f)); }

#define XB_TMO 128
#define XB_XCNT(j) (256 + 64 * (j))
#define XB_XSUB(j) (1280 + 64 * (j))
#define XB_XGEN(j) (2304 + 64 * (j))
#define XB_TOP 3328
#define XB_TOPGEN 3392
#define XCD_BAR_WORDS 3456
#define XB_SPIN_CAP (1u << 22)
#define LAS __attribute__((address_space(3)))
__device__ __forceinline__ unsigned xb_ld(unsigned* p) { return __hip_atomic_load(p, __ATOMIC_RELAXED, __HIP_MEMORY_SCOPE_AGENT); }
__device__ __forceinline__ unsigned xb_add(unsigned* p, unsigned v) { return __hip_atomic_fetch_add(p, v, __ATOMIC_RELAXED, __HIP_MEMORY_SCOPE_AGENT); }
__device__ __forceinline__ unsigned xb_xcc_id() { return (unsigned)__builtin_amdgcn_s_getreg((3 << 11) | 20) & 0xFu; }
#define XB_SPIN(cond, bar) do { unsigned _sp = 0; while (cond) { __builtin_amdgcn_s_sleep(1); \
    if ((++_sp & 255u) == 0u) { if (xb_ld(&(bar)[XB_TMO])) break; if (_sp > XB_SPIN_CAP) { atomicAdd(&(bar)[XB_TMO], 1u); break; } } } } while (0)
struct XcdBarrier { unsigned* bar; unsigned x; volatile unsigned* st; };
__device__ __forceinline__ XcdBarrier xcd_barrier_post(unsigned* bar, volatile unsigned* st) {
  XcdBarrier b; b.bar = bar; b.x = xb_xcc_id(); b.st = st;
  if (threadIdx.x == 0) (void)xb_add(&bar[XB_XCNT(b.x)], 1u);
  return b;
}
__device__ __forceinline__ void xcd_barrier_complete(unsigned* bar, unsigned x, unsigned& nloc, unsigned& nx) {
  const unsigned G = gridDim.x;
  unsigned sum, cnt, mine, sp = 0u;
  for (;;) {
    sum = 0u; cnt = 0u; mine = 0u;
#pragma unroll
    for (unsigned j = 0; j < 16; ++j) { const unsigned c = xb_ld(&bar[XB_XCNT(j)]); sum += c; cnt += (c > 0u) ? 1u : 0u; mine = (j == x) ? c : mine; }
    if (sum == G) break;
    __builtin_amdgcn_s_sleep(1);
    if ((++sp & 255u) == 0u) { if (xb_ld(&bar[XB_TMO])) break; if (sp > XB_SPIN_CAP) { atomicAdd(&bar[XB_TMO], 1u); break; } }
  }
  nloc = mine > 0u ? mine : 1u; nx = cnt > 0u ? cnt : 1u;
}
__device__ __forceinline__ void xcd_barrier(const XcdBarrier& b) {
  asm volatile("s_waitcnt vmcnt(0)" ::: "memory");
  __syncthreads();
  if (threadIdx.x == 0) {
    unsigned* bar = b.bar;
    __builtin_amdgcn_s_waitcnt(0);
    unsigned nloc = b.st[0], nx = b.st[1];
    if (nloc == 0u) { xcd_barrier_complete(bar, b.x, nloc, nx); b.st[0] = nloc; b.st[1] = nx; }
    const unsigned old = xb_add(&bar[XB_XSUB(b.x)], 1u);
    const unsigned gen = old / nloc;
    if (old + 1u == (gen + 1u) * nloc) {
      __builtin_amdgcn_fence(__ATOMIC_RELEASE, "agent");
      asm volatile("s_waitcnt vmcnt(0)" ::: "memory");
      const unsigned og = xb_add(&bar[XB_TOP], 1u);
      const unsigned tg = og / nx;
      if (og + 1u == (tg + 1u) * nx) xb_add(&bar[XB_TOPGEN], 1u);
      else XB_SPIN(xb_ld(&bar[XB_TOPGEN]) == tg, bar);
      __builtin_amdgcn_fence(__ATOMIC_ACQUIRE, "agent");
      xb_add(&bar[XB_XGEN(b.x)], 1u);
      asm volatile("s_waitcnt vmcnt(0)" ::: "memory");
    } else {
      XB_SPIN(xb_ld(&bar[XB_XGEN(b.x)]) == gen, bar);
      __builtin_amdgcn_fence(__ATOMIC_ACQUIRE, "agent");
      asm volatile("s_waitcnt vmcnt(0)" ::: "memory");
    }
  }
  __syncthreads();
}

struct U4x4 { uint4 a, b, c, d; };
constexpr int GLD = 144;
template <int BM, class AL, class EP>
__device__ __forceinline__ void gemm_tile_t(int m0, int n0, int K, const bfu* __restrict__ Bt, AL al, EP ep, unsigned char* lds) {
  constexpr int BUF = 256 * GLD;
  constexpr int MI = BM / 64;
  const int tid = threadIdx.x, lane = tid & 63, wid = tid >> 6;
  const int wr = wid >> 1, wc = wid & 1;
  const int l31 = lane & 31, lh = lane >> 5;
  f32x16 acc[MI][2];
#pragma unroll
  for (int i = 0; i < MI; ++i)
#pragma unroll
    for (int j = 0; j < 2; ++j)
#pragma unroll
      for (int r = 0; r < 16; ++r) acc[i][j][r] = 0.f;
  const int srow = tid >> 1, sk = (tid & 1) * 32;
  const bool aon = srow < BM;
  uint4 av0, av1, av2, av3, bv0, bv1, bv2, bv3;
  auto gl = [&](int k0) {
    if (BM == 128 || aon) al(m0 + srow, k0 + sk, av0, av1, av2, av3);
    const uint4* bp = (const uint4*)(Bt + (size_t)(n0 + srow) * K + k0 + sk);
    bv0 = bp[0]; bv1 = bp[1]; bv2 = bp[2]; bv3 = bp[3];
  };
  auto st = [&](int buf) {
    uint4* da = (uint4*)(lds + buf * BUF + srow * GLD + sk * 2);
    uint4* db = (uint4*)(lds + buf * BUF + 128 * GLD + srow * GLD + sk * 2);
    if (BM == 128 || aon) { da[0] = av0; da[1] = av1; da[2] = av2; da[3] = av3; }
    db[0] = bv0; db[1] = bv1; db[2] = bv2; db[3] = bv3;
  };
  gl(0);
  __syncthreads();
  st(0);
  if (64 < K) gl(64);
  __syncthreads();
  const int nk = K >> 6;
  for (int kt = 0; kt < nk; ++kt) {
    const unsigned char* ldsA = lds + (kt & 1) * BUF;
    const unsigned char* ldsB = ldsA + 128 * GLD;
    if (kt + 1 < nk) st((kt + 1) & 1);
    if (kt + 2 < nk) gl((kt + 2) * 64);
#pragma unroll
    for (int s = 0; s < 4; ++s) {
      bf16x8 af[MI];
#pragma unroll
      for (int i = 0; i < MI; ++i) af[i] = *(const bf16x8*)(ldsA + (wr * (BM / 2) + i * 32 + l31) * GLD + s * 32 + lh * 16);
      const bf16x8 bf0 = *(const bf16x8*)(ldsB + (wc * 64 + l31) * GLD + s * 32 + lh * 16);
      const bf16x8 bf1 = *(const bf16x8*)(ldsB + (wc * 64 + 32 + l31) * GLD + s * 32 + lh * 16);
#pragma unroll
      for (int i = 0; i < MI; ++i) {
        acc[i][0] = __builtin_amdgcn_mfma_f32_32x32x16_bf16(af[i], bf0, acc[i][0], 0, 0, 0);
        acc[i][1] = __builtin_amdgcn_mfma_f32_32x32x16_bf16(af[i], bf1, acc[i][1], 0, 0, 0);
      }
    }
    __syncthreads();
  }
  {
    float* ct = (float*)lds;
#pragma unroll
    for (int i = 0; i < MI; ++i)
#pragma unroll
      for (int j = 0; j < 2; ++j)
#pragma unroll
        for (int r = 0; r < 16; ++r)
          ct[(wr * (BM / 2) + i * 32 + (r & 3) + 8 * (r >> 2) + 4 * lh) * 132 + wc * 64 + j * 32 + l31] = acc[i][j][r];
    __syncthreads();
#pragma unroll 4
    for (int it = 0; it < BM / 8; ++it) {
      const int idx = it * NT + tid, rl = idx >> 5, c4 = (idx & 31) * 4;
      ep(m0 + rl, n0 + c4, *(const float4*)(ct + rl * 132 + c4));
    }
  }
  __syncthreads();
}
template <class AL, class EP>
__device__ __forceinline__ void gemm_tile(int m0, int n0, int K, const bfu* __restrict__ Bt, AL al, EP ep, unsigned char* lds) {
  gemm_tile_t<128>(m0, n0, K, Bt, al, ep, lds);
}
template <class F128, class F64>
__device__ __forceinline__ void tiles_with_half_tail(int ntn, int tailm, F128 f128, F64 f64) {
  const int full = (136 - tailm) * ntn, total = full + tailm * 2 * ntn;
  for (int t = blockIdx.x; t < total; t += gridDim.x) {
    if (t < full) f128((t / ntn) * 128, (t % ntn) * 128);
    else { const int u = t - full; f64((136 - tailm) * 128 + (u / ntn) * 64, (u % ntn) * 128); }
  }
}

__device__ void phase0(const Params& p, unsigned char* lds) {
  const int tid = threadIdx.x, G = gridDim.x, gtid = blockIdx.x * NT + tid, gsz = G * NT;
  {
    const int lane = tid & 63, l31 = lane & 31, gw = gtid >> 6, nw = gsz >> 6;
    for (int rp = gw; rp < 16384; rp += nw) {
      const int r = rp * 2 + (lane >> 5);
      const bool isv = r >= 16384;
      const int row = r & 16383;
      const float4* src = (const float4*)((isv ? p.pv : p.pu) + (size_t)row * 1024 + l31 * 4);
      float x[32];
#pragma unroll
      for (int i = 0; i < 8; ++i) { const float4 v = src[i * 32]; x[i * 4] = v.x; x[i * 4 + 1] = v.y; x[i * 4 + 2] = v.z; x[i * 4 + 3] = v.w; }
      float m = 0.f;
#pragma unroll
      for (int i = 0; i < 32; ++i) m = fmaxf(m, fabsf(x[i]));
#pragma unroll
      for (int o = 16; o > 0; o >>= 1) m = fmaxf(m, __shfl_xor(m, o));
      {
        const float sc4 = m > 0.f ? 6.f / m : 1.f;
        unsigned wq[4] = {0u, 0u, 0u, 0u};
#pragma unroll
        for (int i = 0; i < 32; ++i) {
          const float a_ = fabsf(x[i]) * sc4;
          const unsigned code = (unsigned)(a_ >= 0.25f) + (unsigned)(a_ >= 0.75f) + (unsigned)(a_ >= 1.25f) + (unsigned)(a_ >= 1.75f) +
                                (unsigned)(a_ >= 2.5f) + (unsigned)(a_ >= 3.5f) + (unsigned)(a_ >= 5.f);
          wq[i >> 3] |= (code | (x[i] < 0.f ? 8u : 0u)) << (4 * (i & 7));
        }
        *(uint4*)((isv ? p.TV : p.TU) + (size_t)row * 512 + l31 * 16) = make_uint4(wq[0], wq[1], wq[2], wq[3]);
        if (l31 == 0) (isv ? p.SV : p.SU)[row] = m > 0.f ? m * (1.f / 6.f) : 1.f;
        continue;
      }
      const float sc = m > 0.f ? 7.5f / m : 1.f;
      unsigned long long w0 = 0ull, w1 = 0ull, w2 = 0ull;
#pragma unroll
      for (int i = 0; i < 32; ++i) {
        const float a_ = fminf(fabsf(x[i]) * sc, 7.5f);
        int code;
        if (a_ < 2.f) code = __float2int_rn(a_ * 8.f);
        else if (a_ < 4.f) code = 8 + __float2int_rn(a_ * 4.f);
        else code = 16 + __float2int_rn(a_ * 2.f);
        code = min(code, 31);
        const unsigned long long c6 = (unsigned long long)((unsigned)code | (x[i] < 0.f ? 32u : 0u));
        const int bit = 6 * i, wi = bit >> 6, sh = bit & 63;
        if (wi == 0) w0 |= c6 << sh; else if (wi == 1) w1 |= c6 << sh; else w2 |= c6 << sh;
        if (sh > 58) { if (wi == 0) w1 |= c6 >> (64 - sh); else if (wi == 1) w2 |= c6 >> (64 - sh); }
      }
      unsigned char* dst = p.TV + (size_t)row * 768;
      *(uint4*)(dst + l31 * 16) = make_uint4((unsigned)w0, (unsigned)(w0 >> 32), (unsigned)w1, (unsigned)(w1 >> 32));
      *(uint2*)(dst + 512 + l31 * 8) = make_uint2((unsigned)w2, (unsigned)(w2 >> 32));
      if (l31 == 0) p.SV[row] = m > 0.f ? m * (1.f / 7.5f) : 1.f;
    }
  }
  for (int i = gtid; i < 65536; i += gsz) { p.K1[i] = f2bf(p.keys1[i]); p.K2[i] = f2bf(p.keys2[i]); }
  {
    auto tr = [&](const float* __restrict__ src, bfu* __restrict__ dst, const int K, const int N) {
      for (int i = gtid; i < N * (K / 8); i += gsz) {
        const int n = i % N, k8 = i / N;
        float v[8];
#pragma unroll
        for (int j = 0; j < 8; ++j) v[j] = src[(size_t)(k8 * 8 + j) * N + n];
        *(uint4*)(dst + (size_t)n * K + k8 * 8) = make_uint4(pk2(v[0], v[1]), pk2(v[2], v[3]), pk2(v[4], v[5]), pk2(v[6], v[7]));
      }
    };
    tr(p.w_in, p.WinT, 1024, 2304);
    tr(p.w_out, p.WoutT, 1024, 1024);
    tr(p.w_q, p.WqT, 1024, 1024);
    tr(p.w_glu, p.WgluT, 512, 512);
    tr(p.w2, p.w2T, 64, 512);
    tr(p.a2, p.a2T, 64, 512);
    tr(p.g2, p.g2T, 128, 512);
  }
  for (int i = gtid; i < 2048; i += gsz) {
    const int g = i >> 6;
    const float dt = expf(p.s5ldt[g]);
    const float lre = p.s5are[i], lim = p.s5aim[i];
    const float mag = expf(lre * dt), ang = lim * dt;
    float sn, cs; sincosf(ang, &sn, &cs);
    const float lbr = mag * cs, lbi = mag * sn;
    p.lbre[i] = lbr; p.lbim[i] = lbi;
    float pr = lbr, pi = lbi;
#pragma unroll
    for (int s = 0; s < 6; ++s) { const float nr = pr * pr - pi * pi, ni = 2.f * pr * pi; pr = nr; pi = ni; }
    p.lbLre[i] = pr; p.lbLim[i] = pi;
    const float den = lre * lre + lim * lim;
    const float nre = lbr - 1.f, nim = lbi;
    const float cr = (nre * lre + nim * lim) / den, ci = (nim * lre - nre * lim) / den;
#pragma unroll
    for (int h = 0; h < 16; ++h) {
      const float br = p.s5bre[i * 16 + h], bi = p.s5bim[i * 16 + h];
      p.BBh[(g * 128 + (i & 63)) * 16 + h] = f2bf(cr * br - ci * bi);
      p.BBh[(g * 128 + 64 + (i & 63)) * 16 + h] = f2bf(cr * bi + ci * br);
    }
  }
  for (int i = gtid; i < 32 * 16 * 64; i += gsz) {
    const int gh = i >> 6, k = i & 63;
    p.CCh[gh * 128 + k] = f2bf(p.s5cre[i]);
    p.CCh[gh * 128 + 64 + k] = f2bf(-p.s5cim[i]);
  }
  {
    float* sc = (float*)lds;
    for (int it = blockIdx.x; it < 17 * 24 * 4; it += G) {
      const int kp = it & 3, slab = (it >> 2) % 24, sg = (it >> 2) / 24;
      __syncthreads();
      for (int i = tid; i < 8 * 256; i += NT) {
        const int sq = sg * 8 + (i >> 8), k = kp * 256 + (i & 255);
        const float c = sq < 8 ? p.cp[sq * 1024 + k] : p.cs[(sq - 8) * 1024 + k];
        sc[i] = c / (1.f + __expf(-c));
      }
      __syncthreads();
      const int col = slab * 256 + tid;
      float acc[8];
#pragma unroll
      for (int i = 0; i < 8; ++i) acc[i] = 0.f;
      const float* wp = p.w_ada + (size_t)(kp * 256) * 6144 + col;
#pragma unroll 4
      for (int k = 0; k < 256; k += 4) {
        float w[4];
#pragma unroll
        for (int j = 0; j < 4; ++j) w[j] = wp[(size_t)(k + j) * 6144];
#pragma unroll
        for (int i = 0; i < 8; ++i) {
          const float4 s4 = *(const float4*)(sc + i * 256 + k);
          acc[i] += s4.x * w[0] + s4.y * w[1] + s4.z * w[2] + s4.w * w[3];
        }
      }
      const float bb = kp == 0 ? p.b_ada[col] : 0.f;
#pragma unroll
      for (int i = 0; i < 8; ++i) atomicAdd(&p.mod[(size_t)(sg * 8 + i) * 6144 + col], acc[i] + bb);
    }
    __syncthreads();
  }
}

__device__ void phase1(const Params& p, unsigned char* lds) {
  const int ntile = 136 * 18;
  for (int t = blockIdx.x; t < ntile; t += gridDim.x) {
    const int mt = t / 18, nt = t % 18;
    auto al = [&](int row, int k, uint4& o0, uint4& o1, uint4& o2, uint4& o3) {
      const uint4* s_ = (const uint4*)(p.H1 + (size_t)row * 1024 + k);
      o0 = s_[0]; o1 = s_[1]; o2 = s_[2]; o3 = s_[3];
    };
    auto ep = [&](int row, int col, float4 v) {
      *(uint2*)(p.PJ + (size_t)row * INC + col) = make_uint2(pk2(v.x, v.y), pk2(v.z, v.w));
      if (col >= 512) {
        if (row < NPT) { if ((row & 2047) == 2047) *(float4*)(p.out + O_SH_P + (row >> 11) * RC + col - 512) = v; }
        else { const int r = row - NPT; if ((r & 7) == 7) *(float4*)(p.out + O_SH_S + (r >> 3) * RC + col - 512) = v; }
      }
    };
    gemm_tile(mt * 128, nt * 128, 1024, p.WinT, al, ep, lds);
  }
}

struct Cx { float r, i; };
__device__ __forceinline__ Cx cfma(const Cx a, const Cx b, const Cx c) { Cx o; o.r = a.r * b.r - a.i * b.i + c.r; o.i = a.r * b.i + a.i * b.r + c.i; return o; }
using f32x4 = __attribute__((ext_vector_type(4))) float;
constexpr int HIMG = 272;
template <int MT, bool OUT>
__device__ __forceinline__ void s5_chunk(const Params& p, const int tok0, const int nvalid, const int g, Cx (&st)[2], const int Gend,
                                         unsigned char* himg, const int lane) {
  const int c = lane & 31, half = lane >> 5;
  Cx l1[2], l2[2], l3[2], l4[2];
#pragma unroll
  for (int s = 0; s < 2; ++s) {
    const int gp = g * 64 + 32 * s + c;
    l1[s].r = p.lbre[gp]; l1[s].i = p.lbim[gp];
    const Cx z = {0.f, 0.f};
    l2[s] = cfma(l1[s], l1[s], z); l3[s] = cfma(l2[s], l1[s], z); l4[s] = cfma(l2[s], l2[s], z);
  }
  bf16x8 bfr[4];
#pragma unroll
  for (int nt = 0; nt < 4; ++nt) bfr[nt] = *(const bf16x8*)(p.BBh + ((size_t)(g * 128 + 32 * nt + c)) * 16 + 8 * half);
  bf16x8 cfr[4];
  float dsk = 0.f;
  if (OUT) {
#pragma unroll
    for (int ks = 0; ks < 4; ++ks) cfr[ks] = *(const bf16x8*)(p.CCh + ((size_t)(g * 16 + (lane & 15))) * 128 + 32 * ks + 8 * (lane >> 4));
    dsk = p.s5d[g * 16 + (lane & 15)];
  }
  Cx endst[2] = {st[0], st[1]};
#pragma unroll
  for (int mt = 0; mt < MT; ++mt) {
    bf16x8 af;
#pragma unroll
    for (int j = 0; j < 8; ++j) af[j] = 0;
    if (32 * mt + c < nvalid) af = *(const bf16x8*)(p.PJ + (size_t)(tok0 + 32 * mt + c) * INC + g * 16 + 8 * half);
#pragma unroll
    for (int s = 0; s < 2; ++s) {
      f32x16 bre, bim;
#pragma unroll
      for (int r = 0; r < 16; ++r) { bre[r] = 0.f; bim[r] = 0.f; }
      bre = __builtin_amdgcn_mfma_f32_32x32x16_bf16(af, bfr[s], bre, 0, 0, 0);
      bim = __builtin_amdgcn_mfma_f32_32x32x16_bf16(af, bfr[2 + s], bim, 0, 0, 0);
      Cx e[4], pe[4];
#pragma unroll
      for (int q = 0; q < 4; ++q) {
        Cx x; x.r = bre[4 * q]; x.i = bim[4 * q];
#pragma unroll
        for (int i = 1; i < 4; ++i) { Cx b_; b_.r = bre[4 * q + i]; b_.i = bim[4 * q + i]; x = cfma(l1[s], x, b_); bre[4 * q + i] = x.r; bim[4 * q + i] = x.i; }
        e[q] = x;
      }
#pragma unroll
      for (int q = 0; q < 4; ++q) { pe[q].r = __shfl_xor(e[q].r, 32); pe[q].i = __shfl_xor(e[q].i, 32); }
      Cx carry = st[s];
      Cx cin[4];
#pragma unroll
      for (int q = 0; q < 4; ++q) {
        const Cx ee = half ? pe[q] : e[q];
        const Cx eo = half ? e[q] : pe[q];
        const Cx cin_e = carry;
        carry = cfma(l4[s], carry, ee);
        if (8 * mt + 2 * q == Gend) endst[s] = carry;
        const Cx cin_o = carry;
        carry = cfma(l4[s], carry, eo);
        if (8 * mt + 2 * q + 1 == Gend) endst[s] = carry;
        cin[q] = half ? cin_o : cin_e;
      }
      st[s] = carry;
      if (OUT) {
        bfu* hi16 = (bfu*)himg;
#pragma unroll
        for (int q = 0; q < 4; ++q)
#pragma unroll
          for (int i = 0; i < 4; ++i) {
            const Cx lp = i == 0 ? l1[s] : (i == 1 ? l2[s] : (i == 2 ? l3[s] : l4[s]));
            Cx b_; b_.r = bre[4 * q + i]; b_.i = bim[4 * q + i];
            const Cx h = cfma(lp, cin[q], b_);
            const int tl = i + 8 * q + 4 * half;
            hi16[tl * (HIMG / 2) + 32 * s + c] = f2bf(h.r);
            hi16[tl * (HIMG / 2) + 64 + 32 * s + c] = f2bf(h.i);
          }
      }
    }
    if (OUT) {
      __builtin_amdgcn_wave_barrier();
#pragma unroll
      for (int rt = 0; rt < 2; ++rt) {
        f32x4 acc = {0.f, 0.f, 0.f, 0.f};
#pragma unroll
        for (int ks = 0; ks < 4; ++ks) {
          const bf16x8 a_ = *(const bf16x8*)(himg + (16 * rt + (lane & 15)) * HIMG + (32 * ks + 8 * (lane >> 4)) * 2);
          acc = __builtin_amdgcn_mfma_f32_16x16x32_bf16(a_, cfr[ks], acc, 0, 0, 0);
        }
#pragma unroll
        for (int r = 0; r < 4; ++r) {
          const int t = 32 * mt + 16 * rt + 4 * (lane >> 4) + r;
          if (t < nvalid) {
            const float u = bf2f(p.PJ[(size_t)(tok0 + t) * INC + g * 16 + (lane & 15)]);
            p.Y5[(size_t)(tok0 + t) * 512 + g * 16 + (lane & 15)] = gelu_(acc[r] + dsk * u);
          }
        }
      }
      __builtin_amdgcn_wave_barrier();
    }
  }
  st[0] = endst[0]; st[1] = endst[1];
}
__device__ void s5_pass_a(const Params& p) {
  const int lane = threadIdx.x & 63, gw = (blockIdx.x * NT + threadIdx.x) >> 6, nw = (gridDim.x * NT) >> 6;
  for (int job = gw; job < 8 * 32 * 32; job += nw) {
    const int c = job & 31, g = (job >> 5) & 31, b = job >> 10;
    Cx st[2] = {{0.f, 0.f}, {0.f, 0.f}};
    s5_chunk<2, false>(p, b * 2048 + c * 64, 64, g, st, 15, nullptr, lane);
    if (lane < 32) {
      float* e = p.E + (size_t)job * 128;
      e[lane] = st[0].r; e[32 + lane] = st[1].r; e[64 + lane] = st[0].i; e[96 + lane] = st[1].i;
    }
  }
}
__device__ void s5_job_c(const Params& p, int bj, bool prompt, unsigned char* lds) {
  const int lane = threadIdx.x & 63, wid = threadIdx.x >> 6;
  unsigned char* himg = lds + wid * (32 * HIMG);
  const int job = bj * 4 + wid;
  const int cc = lane & 31;
  if (prompt) {
    const int c = job & 31, g = (job >> 5) & 31, b = job >> 10;
    Cx L64[2], st[2];
#pragma unroll
    for (int s = 0; s < 2; ++s) { const int gp = g * 64 + 32 * s + cc; L64[s].r = p.lbLre[gp]; L64[s].i = p.lbLim[gp]; st[s].r = 0.f; st[s].i = 0.f; }
    const float* e = p.E + (size_t)(job - c) * 128;
    for (int j = 0; j < c; ++j) {
      Cx e0, e1;
      e0.r = e[j * 128 + cc]; e1.r = e[j * 128 + 32 + cc]; e0.i = e[j * 128 + 64 + cc]; e1.i = e[j * 128 + 96 + cc];
      st[0] = cfma(L64[0], st[0], e0); st[1] = cfma(L64[1], st[1], e1);
    }
    s5_chunk<2, true>(p, b * 2048 + c * 64, 64, g, st, 15, himg, lane);
    if (c == 31 && lane < 32) {
      float* o = p.out + O_S5RE_P + (b * 32 + g) * 64;
      o[lane] = st[0].r; o[32 + lane] = st[1].r;
      o = p.out + O_S5IM_P + (b * 32 + g) * 64;
      o[lane] = st[0].i; o[32 + lane] = st[1].i;
    }
  } else {
    const int g = job & 31, bs = job >> 5;
    Cx st[2];
    const float* r0 = p.s5re0 + ((size_t)bs * 32 + g) * 64;
    const float* i0 = p.s5im0 + ((size_t)bs * 32 + g) * 64;
    st[0].r = r0[cc]; st[1].r = r0[32 + cc]; st[0].i = i0[cc]; st[1].i = i0[32 + cc];
    s5_chunk<1, true>(p, NPT + bs * 8, 8, g, st, 1, himg, lane);
    if (lane < 32) {
      float* o = p.out + O_S5RE_S + ((size_t)bs * 32 + g) * 64;
      o[lane] = st[0].r; o[32 + lane] = st[1].r;
      o = p.out + O_S5IM_S + ((size_t)bs * 32 + g) * 64;
      o[lane] = st[0].i; o[32 + lane] = st[1].i;
    }
  }
}

__device__ __forceinline__ float tanh_fast(float x) { const float e = __expf(2.f * x); return 1.f - 2.f / (e + 1.f); }
template <int WHICH>
__device__ void lora_tiles(const Params& p, unsigned char* lds) {
  constexpr int base = WHICH == 0 ? 1536 : (WHICH == 1 ? 1600 : 1664);
  for (int t = blockIdx.x; t < 136 * 4; t += gridDim.x) {
    const int mt = t >> 2, nt = t & 3;
    auto al = [&](int row, int k, uint4& o0, uint4& o1, uint4& o2, uint4& o3) {
      const bfu* pc = p.PJ + (size_t)row * INC + 512 + base + k;
      const int tt = t_of(row);
      auto one = [&](int i) -> uint4 {
        const uint4 cu = *(const uint4*)(pc + i * 8);
        const float cur[8] = {bflo(cu.x), bfhi(cu.x), bflo(cu.y), bfhi(cu.y), bflo(cu.z), bfhi(cu.z), bflo(cu.w), bfhi(cu.w)};
        float prv[8];
        if (tt == 0) {
          if (row < NPT) {
#pragma unroll
            for (int j = 0; j < 8; ++j) prv[j] = 0.f;
          } else {
            const float4* s0 = (const float4*)(p.shift0 + (size_t)(sq_of(row) - 8) * RC + base + k + i * 8);
            const float4 a = s0[0], b_ = s0[1];
            prv[0] = a.x; prv[1] = a.y; prv[2] = a.z; prv[3] = a.w; prv[4] = b_.x; prv[5] = b_.y; prv[6] = b_.z; prv[7] = b_.w;
          }
        } else {
          const uint4 pu_ = *(const uint4*)(pc - INC + i * 8);
          prv[0] = bflo(pu_.x); prv[1] = bfhi(pu_.x); prv[2] = bflo(pu_.y); prv[3] = bfhi(pu_.y); prv[4] = bflo(pu_.z); prv[5] = bfhi(pu_.z); prv[6] = bflo(pu_.w); prv[7] = bfhi(pu_.w);
        }
        const float4 m0 = *(const float4*)(p.mu + base + k + i * 8), m1 = *(const float4*)(p.mu + base + k + i * 8 + 4);
        const float mm[8] = {m0.x, m0.y, m0.z, m0.w, m1.x, m1.y, m1.z, m1.w};
        float f[8];
#pragma unroll
        for (int j = 0; j < 8; ++j) {
          const float ps = cur[j] + (prv[j] - cur[j]) * mm[j];
          f[j] = WHICH == 0 ? tanh_fast(ps) : (WHICH == 1 ? ps : sigmoidf_(ps));
        }
        return make_uint4(pk2(f[0], f[1]), pk2(f[2], f[3]), pk2(f[4], f[5]), pk2(f[6], f[7]));
      };
      o0 = one(0); o1 = one(1); o2 = one(2); o3 = one(3);
    };
    auto ep = [&](int row, int col, float4 v4) {
      const size_t o = (size_t)row * 512 + col;
      const float v[4] = {v4.x, v4.y, v4.z, v4.w};
      float f[4];
      if (WHICH == 0) {
        const float4 w0 = *(const float4*)(p.w0 + col);
        const float ww[4] = {w0.x, w0.y, w0.z, w0.w};
#pragma unroll
        for (int j = 0; j < 4; ++j) {
          const float z = -(ww[j] + v[j]);
          const float sp = fmaxf(z, 0.f) + __logf(1.f + __expf(-fabsf(z)));
          f[j] = -__expf(-sp - 0.5f);
        }
        *(uint2*)(p.LD + o) = make_uint2(pk2(f[0], f[1]), pk2(f[2], f[3]));
      } else if (WHICH == 1) {
        const float4 a0 = *(const float4*)(p.a0 + col);
        const float aa[4] = {a0.x, a0.y, a0.z, a0.w};
#pragma unroll
        for (int j = 0; j < 4; ++j) f[j] = sigmoidf_(aa[j] + v[j]);
        *(uint2*)(p.AA + o) = make_uint2(pk2(f[0], f[1]), pk2(f[2], f[3]));
      } else {
        *(uint2*)(p.GG + o) = make_uint2(pk2(v[0], v[1]), pk2(v[2], v[3]));
      }
    };
    gemm_tile(mt * 128, nt * 128, WHICH == 2 ? 128 : 64, WHICH == 0 ? p.w2T : (WHICH == 1 ? p.a2T : p.g2T), al, ep, lds);
  }
}
__device__ void phase2(const Params& p, unsigned char* lds) {
  lora_tiles<0>(p, lds);
  lora_tiles<1>(p, lds);
  lora_tiles<2>(p, lds);
  s5_pass_a(p);
}

template <int CTRL>
__device__ __forceinline__ float dppf(float x) { return __uint_as_float((unsigned)__builtin_amdgcn_update_dpp(0, (int)__float_as_uint(x), CTRL, 0xf, 0xf, true)); }
template <int LPR>
__device__ __forceinline__ float red_lpr(float x) {
  x += dppf<0xB1>(x); x += dppf<0x4E>(x);
  if (LPR == 16) { x += dppf<0x141>(x); x += dppf<0x140>(x); }
  return x;
}
struct RwVec { float4 w, kk, b, k, r; };
template <int LPR, bool PROMPT>
__device__ void rwkv_job(const Params& p, int sq, int h, int rg, unsigned char* lds) {
  constexpr int ROWS = NT / LPR, KPL = 64 / LPR, NV = KPL / 4;
  float* Lr = (float*)lds;
  float* Lw = Lr + 17 * 64;
  float* Lk = Lw + 17 * 64;
  float* Lkk = Lk + 17 * 64;
  float* Lb = Lkk + 17 * 64;
  float* Lv = Lb + 17 * 64;
  float* Lyp0 = Lv + 17 * 64;
  const int tid = threadIdx.x;
  constexpr bool prompt = PROMPT;
  constexpr int T = PROMPT ? 2048 : 8;
  const int tokbase = prompt ? sq * 2048 : NPT + (sq - 8) * 8;
  const int row = tid / LPR, kq = tid % LPR;
  const int grow = rg * ROWS + row;
  float S[KPL];
  if (prompt) {
#pragma unroll
    for (int j = 0; j < KPL; ++j) S[j] = 0.f;
  } else {
    const float* s0 = p.wkv0 + (((size_t)(sq - 8) * 8 + h) * 64 + grow) * 64 + kq * KPL;
#pragma unroll
    for (int j = 0; j < NV; ++j) { const float4 v = ((const float4*)s0)[j]; S[j * 4] = v.x; S[j * 4 + 1] = v.y; S[j * 4 + 2] = v.z; S[j * 4 + 3] = v.w; }
  }
  const int tt = tid >> 4, kg = tid & 15, k4 = kg * 4;
  const int hc = h * 64 + k4;
  float mur[4], muk[4], muv[4], kkc[4], kac[4], rkc[4];
#pragma unroll
  for (int j = 0; j < 4; ++j) {
    mur[j] = p.mu[hc + j]; muk[j] = p.mu[512 + hc + j]; muv[j] = p.mu[1024 + hc + j];
    kkc[j] = p.k_k[hc + j]; kac[j] = p.k_a[hc + j]; rkc[j] = p.r_k[hc + j];
  }
  uint2 Acr, Ack, Acv, Aqr, Aqk, Aqv, Ald, Aaa;
  uint2 Bcr, Bck, Bcv, Bqr, Bqk, Bqv, Bld, Baa;
  auto gload = [&](int c0, uint2& cr, uint2& ck, uint2& cv, uint2& qr, uint2& qk, uint2& qv, uint2& ldv, uint2& aav) {
    const int cc0 = PROMPT ? min(c0, T - 16) : 0;
    const int nst = PROMPT ? 16 : 8;
    const int t = cc0 + (tt < nst ? tt : 0);
    const int tok = tokbase + t;
    const bfu* pc = p.PJ + (size_t)tok * INC + 512 + hc;
    const bfu* pp = pc - (t > 0 ? INC : 0);
    cr = *(const uint2*)(pc); ck = *(const uint2*)(pc + 512); cv = *(const uint2*)(pc + 1024);
    qr = *(const uint2*)(pp); qk = *(const uint2*)(pp + 512); qv = *(const uint2*)(pp + 1024);
    ldv = *(const uint2*)(p.LD + (size_t)tok * 512 + hc);
    aav = *(const uint2*)(p.AA + (size_t)tok * 512 + hc);
  };
  auto store_y = [&](int c0, const float* Lyp) {
    constexpr int nst = PROMPT ? 16 : 8;
    for (int i = tid; i < nst * ROWS; i += NT) {
      const int s = i / ROWS, rr = i % ROWS;
      const float4* yp = (const float4*)(Lyp + (size_t)i * LPR);
      float y = 0.f;
#pragma unroll
      for (int j = 0; j < LPR / 4; ++j) { const float4 v = yp[j]; y += (v.x + v.y) + (v.z + v.w); }
      p.out[(size_t)(tokbase + c0 + s) * 1024 + 512 + h * 64 + rg * ROWS + rr] = y;
    }
  };
  auto process = [&](int c0, int par, uint2& cr, uint2& ck, uint2& cv, uint2& qr, uint2& qk, uint2& qv, uint2& ldv, uint2& aav) {
    float* Lyp = Lyp0 + par * (16 * NT);
    constexpr int nst = PROMPT ? 16 : 8;
    const bool act = PROMPT ? true : (tt < nst);
    const int t = c0 + (act ? tt : 0);
    const int tok = tokbase + t;
    {
      float pr[4], pk_[4], pv_[4];
      if (t == 0) {
        if (prompt) {
#pragma unroll
          for (int j = 0; j < 4; ++j) pr[j] = pk_[j] = pv_[j] = 0.f;
        } else {
          const float* s0 = p.shift0 + (size_t)(sq - 8) * RC + hc;
#pragma unroll
          for (int j = 0; j < 4; ++j) { pr[j] = s0[j]; pk_[j] = s0[512 + j]; pv_[j] = s0[1024 + j]; }
        }
      } else {
        pr[0] = bflo(qr.x); pr[1] = bfhi(qr.x); pr[2] = bflo(qr.y); pr[3] = bfhi(qr.y);
        pk_[0] = bflo(qk.x); pk_[1] = bfhi(qk.x); pk_[2] = bflo(qk.y); pk_[3] = bfhi(qk.y);
        pv_[0] = bflo(qv.x); pv_[1] = bfhi(qv.x); pv_[2] = bflo(qv.y); pv_[3] = bfhi(qv.y);
      }
      const float c_r[4] = {bflo(cr.x), bfhi(cr.x), bflo(cr.y), bfhi(cr.y)};
      const float c_k[4] = {bflo(ck.x), bfhi(ck.x), bflo(ck.y), bfhi(ck.y)};
      const float c_v[4] = {bflo(cv.x), bfhi(cv.x), bflo(cv.y), bfhi(cv.y)};
      const float ld4[4] = {bflo(ldv.x), bfhi(ldv.x), bflo(ldv.y), bfhi(ldv.y)};
      const float aa4[4] = {bflo(aav.x), bfhi(aav.x), bflo(aav.y), bfhi(aav.y)};
      float r4[4], kx4[4], v4[4], w4[4], kk4[4];
      float ssq = 0.f, bon = 0.f;
#pragma unroll
      for (int j = 0; j < 4; ++j) {
        r4[j] = c_r[j] + (pr[j] - c_r[j]) * mur[j];
        const float kx = c_k[j] + (pk_[j] - c_k[j]) * muk[j];
        v4[j] = c_v[j] + (pv_[j] - c_v[j]) * muv[j];
        w4[j] = __expf(ld4[j]);
        kk4[j] = kx * kkc[j];
        ssq += kk4[j] * kk4[j];
        kx4[j] = kx * (1.f + (aa4[j] - 1.f) * kac[j]);
        bon += r4[j] * kx4[j] * rkc[j];
      }
      ssq = red_lpr<16>(ssq); bon = red_lpr<16>(bon);
      const float inv = rsqrtf(fmaxf(ssq, 1e-24f));
      __syncthreads();
      if (act) {
        *(float4*)(Lr + tt * 64 + k4) = make_float4(r4[0], r4[1], r4[2], r4[3]);
        *(float4*)(Lw + tt * 64 + k4) = make_float4(w4[0], w4[1], w4[2], w4[3]);
        *(float4*)(Lk + tt * 64 + k4) = make_float4(kx4[0], kx4[1], kx4[2], kx4[3]);
        *(float4*)(Lkk + tt * 64 + k4) = make_float4(kk4[0] * inv, kk4[1] * inv, kk4[2] * inv, kk4[3] * inv);
        *(float4*)(Lb + tt * 64 + k4) = make_float4(kk4[0] * inv * aa4[0], kk4[1] * inv * aa4[1], kk4[2] * inv * aa4[2], kk4[3] * inv * aa4[3]);
        *(float4*)(Lv + tt * 64 + k4) = make_float4(v4[0], v4[1], v4[2], v4[3]);
        (rg == 0 ? p.BON : p.BONX)[(size_t)tok * 8 + h] = bon;
      }
    }
    __syncthreads();
    if (PROMPT) store_y(max(c0 - 16, 0), Lyp0 + (par ^ 1) * (16 * NT));
    gload(c0 + 32, cr, ck, cv, qr, qk, qv, ldv, aav);
    {
      auto ldvec = [&](int s, int j) -> RwVec {
        RwVec v;
        const int o = s * 64 + kq * KPL + j * 4;
        v.w = *(const float4*)(Lw + o); v.kk = *(const float4*)(Lkk + o); v.b = *(const float4*)(Lb + o);
        v.k = *(const float4*)(Lk + o); v.r = *(const float4*)(Lr + o);
        return v;
      };
      RwVec cur[NV];
      float vcur;
#pragma unroll
      for (int j = 0; j < NV; ++j) cur[j] = ldvec(0, j);
      vcur = Lv[grow];
      for (int s = 0; s < nst; ++s) {
        RwVec nxt[NV];
        float vnx;
#pragma unroll
        for (int j = 0; j < NV; ++j) nxt[j] = ldvec(s + 1, j);
        vnx = Lv[(s + 1) * 64 + grow];
        float sa0 = 0.f, sa1 = 0.f;
#pragma unroll
        for (int j = 0; j < NV; ++j) {
          sa0 += S[j * 4] * cur[j].kk.x; sa1 += S[j * 4 + 1] * cur[j].kk.y;
          sa0 += S[j * 4 + 2] * cur[j].kk.z; sa1 += S[j * 4 + 3] * cur[j].kk.w;
        }
        float tq[KPL];
#pragma unroll
        for (int j = 0; j < NV; ++j) {
          tq[j * 4] = S[j * 4] * cur[j].w.x + vcur * cur[j].k.x;
          tq[j * 4 + 1] = S[j * 4 + 1] * cur[j].w.y + vcur * cur[j].k.y;
          tq[j * 4 + 2] = S[j * 4 + 2] * cur[j].w.z + vcur * cur[j].k.z;
          tq[j * 4 + 3] = S[j * 4 + 3] * cur[j].w.w + vcur * cur[j].k.w;
        }
        float sa = -red_lpr<LPR>(sa0 + sa1);
        float y0 = 0.f, y1 = 0.f;
#pragma unroll
        for (int j = 0; j < NV; ++j) {
          S[j * 4] = tq[j * 4] + sa * cur[j].b.x;
          S[j * 4 + 1] = tq[j * 4 + 1] + sa * cur[j].b.y;
          S[j * 4 + 2] = tq[j * 4 + 2] + sa * cur[j].b.z;
          S[j * 4 + 3] = tq[j * 4 + 3] + sa * cur[j].b.w;
          y0 += S[j * 4] * cur[j].r.x; y1 += S[j * 4 + 1] * cur[j].r.y;
          y0 += S[j * 4 + 2] * cur[j].r.z; y1 += S[j * 4 + 3] * cur[j].r.w;
        }
        Lyp[(s * ROWS + row) * LPR + kq] = y0 + y1;
#pragma unroll
        for (int j = 0; j < NV; ++j) cur[j] = nxt[j];
        vcur = vnx;
      }
    }
  };
  gload(0, Acr, Ack, Acv, Aqr, Aqk, Aqv, Ald, Aaa);
  gload(16, Bcr, Bck, Bcv, Bqr, Bqk, Bqv, Bld, Baa);
  for (int c0 = 0; c0 < T; c0 += 32) {
    process(c0, 0, Acr, Ack, Acv, Aqr, Aqk, Aqv, Ald, Aaa);
    if (PROMPT) process(c0 + 16, 1, Bcr, Bck, Bcv, Bqr, Bqk, Bqv, Bld, Baa);
  }
  __syncthreads();
  {
    const int lastc = ((T - 1) >> 4) << 4;
    store_y(lastc, Lyp0 + ((lastc >> 4) & 1) * (16 * NT));
  }
  {
    float* so = p.out + (prompt ? O_WKV_P + (((size_t)sq * 8 + h) * 64 + grow) * 64 : O_WKV_S + (((size_t)(sq - 8) * 8 + h) * 64 + grow) * 64) + kq * KPL;
#pragma unroll
    for (int j = 0; j < NV; ++j) ((float4*)so)[j] = make_float4(S[j * 4], S[j * 4 + 1], S[j * 4 + 2], S[j * 4 + 3]);
  }
  __syncthreads();
}
__device__ void rwkv_post(const Params& p) {
  const int tid = threadIdx.x;
  const int h = (tid >> 4) & 7, kg = tid & 15, k4 = kg * 4, hc = h * 64 + k4;
  float muv[4], gnw[4], gnb[4];
#pragma unroll
  for (int j = 0; j < 4; ++j) { muv[j] = p.mu[1024 + hc + j]; gnw[j] = p.gn_w[hc + j]; gnb[j] = p.gn_b[hc + j]; }
  for (int it = blockIdx.x; it < NTOK / 2; it += gridDim.x) {
    const int tok = it * 2 + (tid >> 7);
    const int t = t_of(tok);
    const bfu* pc = p.PJ + (size_t)tok * INC + 512 + 1024 + hc;
    const uint2 cv = *(const uint2*)pc;
    float pv_[4];
    if (t == 0) {
      if (tok < NPT) { pv_[0] = pv_[1] = pv_[2] = pv_[3] = 0.f; }
      else { const float* s0 = p.shift0 + (size_t)(sq_of(tok) - 8) * RC + 1024 + hc; pv_[0] = s0[0]; pv_[1] = s0[1]; pv_[2] = s0[2]; pv_[3] = s0[3]; }
    } else {
      const uint2 qv = *(const uint2*)(pc - INC);
      pv_[0] = bflo(qv.x); pv_[1] = bfhi(qv.x); pv_[2] = bflo(qv.y); pv_[3] = bfhi(qv.y);
    }
    const float c_v[4] = {bflo(cv.x), bfhi(cv.x), bflo(cv.y), bfhi(cv.y)};
    float* yp = p.out + (size_t)tok * 1024 + 512 + hc;
    const float4 y4 = *(const float4*)yp;
    const float mean = red_lpr<16>(y4.x + y4.y + y4.z + y4.w) * (1.f / 64.f);
    const float dd[4] = {y4.x - mean, y4.y - mean, y4.z - mean, y4.w - mean};
    const float rstd = rsqrtf(red_lpr<16>(dd[0] * dd[0] + dd[1] * dd[1] + dd[2] * dd[2] + dd[3] * dd[3]) * (1.f / 64.f) + GN_EPS);
    const float bon = p.BON[(size_t)tok * 8 + h];
    const uint2 gv = *(const uint2*)(p.GG + (size_t)tok * 512 + hc);
    const float g4[4] = {bflo(gv.x), bfhi(gv.x), bflo(gv.y), bfhi(gv.y)};
    float o4[4];
#pragma unroll
    for (int j = 0; j < 4; ++j) {
      const float v = c_v[j] + (pv_[j] - c_v[j]) * muv[j];
      o4[j] = (dd[j] * rstd * gnw[j] + gnb[j] + bon * v) * g4[j];
    }
    *(uint2*)(p.CAT + (size_t)tok * 1024 + 512 + hc) = make_uint2(pk2(o4[0], o4[1]), pk2(o4[2], o4[3]));
  }
}

#ifndef P3MODE
#define P3MODE 0
#endif
__device__ void phase3(const Params& p, unsigned char* lds, int cw = 0, int mode = 0) {
  volatile int* jb = (volatile int*)(lds + LDS_JOB);
  for (;;) {
    __syncthreads();
    if (threadIdx.x == 0) *jb = (int)atomicAdd(&p.bar[cw], 1u);
    __syncthreads();
    const int j = *jb;
    if (j >= 4352) break;
    if (j < 256) { if (mode != 1) rwkv_job<16, true>(p, j >> 5, (j >> 2) & 7, j & 3, lds); }
    else if (j < 2304) { if (mode != 2) s5_job_c(p, j - 256, true, lds); }
    else if (j < 3328) { const int q = j - 2304; if (mode != 1) rwkv_job<4, false>(p, 8 + (q >> 3), q & 7, 0, lds); }
    else { if (mode != 2) s5_job_c(p, j - 3328, false, lds); }
  }
}

__device__ void phase4a(const Params& p, unsigned char* lds) {
  rwkv_post(p);
  {
    auto al = [&](int row, int k, uint4& o0, uint4& o1, uint4& o2, uint4& o3) {
      const float4* s = (const float4*)(p.Y5 + (size_t)row * 512 + k);
      auto one = [&](int i) -> uint4 { const float4 a = s[i * 2], b = s[i * 2 + 1]; return make_uint4(pk2(a.x, a.y), pk2(a.z, a.w), pk2(b.x, b.y), pk2(b.z, b.w)); };
      o0 = one(0); o1 = one(1); o2 = one(2); o3 = one(3);
    };
    auto ep = [&](int row, int col, float4 v) {
      const float4 y = *(const float4*)(p.Y5 + (size_t)row * 512 + col), bg = *(const float4*)(p.b_glu + col);
      *(uint2*)(p.CAT + (size_t)row * 1024 + col) = make_uint2(pk2(y.x * sigmoidf_(v.x + bg.x), y.y * sigmoidf_(v.y + bg.y)), pk2(y.z * sigmoidf_(v.z + bg.z), y.w * sigmoidf_(v.w + bg.w)));
    };
    tiles_with_half_tail(4, 8, [&](int m0, int n0) { gemm_tile_t<128>(m0, n0, 512, p.WgluT, al, ep, lds); },
                         [&](int m0, int n0) { gemm_tile_t<64>(m0, n0, 512, p.WgluT, al, ep, lds); });
  }
}
__device__ void phase4b(const Params& p, unsigned char* lds) {
  auto al = [&](int row, int k, uint4& o0, uint4& o1, uint4& o2, uint4& o3) {
    const uint4* s_ = (const uint4*)(p.CAT + (size_t)row * 1024 + k);
    o0 = s_[0]; o1 = s_[1]; o2 = s_[2]; o3 = s_[3];
  };
  auto ep = [&](int row, int col, float4 v) {
    const int sq = sq_of(row);
    const float4 x = *(const float4*)(xrow(p, row) + col), g = *(const float4*)(p.mod + (size_t)sq * 6144 + 2048 + col);
    *(float4*)(p.X1 + (size_t)row * 1024 + col) = make_float4(x.x + g.x * v.x, x.y + g.y * v.y, x.z + g.z * v.z, x.w + g.w * v.w);
  };
  tiles_with_half_tail(8, 8, [&](int m0, int n0) { gemm_tile_t<128>(m0, n0, 1024, p.WoutT, al, ep, lds); },
                       [&](int m0, int n0) { gemm_tile_t<64>(m0, n0, 1024, p.WoutT, al, ep, lds); });
}
template <bool FROMX>
__device__ void norm_rows(const Params& p, const float* __restrict__ gsrc, int sh_off, bfu* __restrict__ dst) {
  const int lane = threadIdx.x & 63, gw = (blockIdx.x * NT + threadIdx.x) >> 6, nw = (gridDim.x * NT) >> 6;
  for (int tok = gw; tok < NTOK; tok += nw) {
    const float* xr = FROMX ? xrow(p, tok) : p.X1 + (size_t)tok * 1024;
    const float* md = p.mod + (size_t)sq_of(tok) * 6144 + sh_off;
    float4 v[4];
    float s = 0.f;
#pragma unroll
    for (int i = 0; i < 4; ++i) { const float4 a = *(const float4*)(xr + lane * 16 + i * 4); v[i] = a; s += a.x * a.x + a.y * a.y + a.z * a.z + a.w * a.w; }
#pragma unroll
    for (int o = 32; o > 0; o >>= 1) s += __shfl_xor(s, o);
    const float rs = rsqrtf(s * (1.f / 1024.f) + NORM_EPS);
    float f[16];
#pragma unroll
    for (int i = 0; i < 4; ++i) {
      const int k = lane * 16 + i * 4;
      const float4 g4 = *(const float4*)(gsrc + k), sh = *(const float4*)(md + k), sc = *(const float4*)(md + 1024 + k);
      const float4 a = v[i];
      f[i * 4 + 0] = a.x * rs * g4.x * (1.f + sc.x) + sh.x;
      f[i * 4 + 1] = a.y * rs * g4.y * (1.f + sc.y) + sh.y;
      f[i * 4 + 2] = a.z * rs * g4.z * (1.f + sc.z) + sh.z;
      f[i * 4 + 3] = a.w * rs * g4.w * (1.f + sc.w) + sh.w;
    }
    uint4* d = (uint4*)(dst + (size_t)tok * 1024 + lane * 16);
    d[0] = make_uint4(pk2(f[0], f[1]), pk2(f[2], f[3]), pk2(f[4], f[5]), pk2(f[6], f[7]));
    d[1] = make_uint4(pk2(f[8], f[9]), pk2(f[10], f[11]), pk2(f[12], f[13]), pk2(f[14], f[15]));
  }
}
__device__ void phase0b(const Params& p) { norm_rows<true>(p, p.n1g, 0, p.H1); }
__device__ void phase5a(const Params& p) { norm_rows<false>(p, p.n2g, 3072, p.H2); }
__device__ void phase5b(const Params& p, unsigned char* lds) {
  auto al = [&](int row, int k, uint4& o0, uint4& o1, uint4& o2, uint4& o3) {
    const uint4* s = (const uint4*)(p.H2 + (size_t)row * 1024 + k);
    o0 = s[0]; o1 = s[1]; o2 = s[2]; o3 = s[3];
  };
  auto ep = [&](int row, int col, float4 v) { *(uint2*)(p.Q + (size_t)row * 1024 + col) = make_uint2(pk2(v.x, v.y), pk2(v.z, v.w)); };
  tiles_with_half_tail(8, 8, [&](int m0, int n0) { gemm_tile_t<128>(m0, n0, 1024, p.WqT, al, ep, lds); },
                       [&](int m0, int n0) { gemm_tile_t<64>(m0, n0, 1024, p.WqT, al, ep, lds); });
}

__device__ __forceinline__ void ins16(float (&L)[16], float x) {
#pragma unroll
  for (int j = 0; j < 16; ++j) { const float hi = fmaxf(L[j], x); x = fminf(L[j], x); L[j] = hi; }
}
__device__ __forceinline__ void ce_desc(float& a, float& b) { const float hi = fmaxf(a, b), lo = fminf(a, b); a = hi; b = lo; }
__device__ __forceinline__ void sort16_desc(float (&a)[16]) {
#pragma unroll
  for (int k = 2; k <= 16; k <<= 1)
#pragma unroll
    for (int j = k >> 1; j > 0; j >>= 1)
#pragma unroll
      for (int i = 0; i < 16; ++i) {
        const int l = i ^ j;
        if (l > i) {
          if ((i & k) == 0) ce_desc(a[i], a[l]);
          else ce_desc(a[l], a[i]);
        }
      }
}
__device__ __forceinline__ void merge16_desc(float (&L)[16], const float (&T)[16]) {
#pragma unroll
  for (int i = 0; i < 16; ++i) L[i] = fmaxf(L[i], T[15 - i]);
#pragma unroll
  for (int j = 8; j > 0; j >>= 1)
#pragma unroll
    for (int i = 0; i < 16; ++i) { const int l = i ^ j; if (l > i) ce_desc(L[i], L[l]); }
}
__device__ __forceinline__ void peer_side_top16(const Params& p, const bfu* __restrict__ keys, int tok, int h, int side, int lane, float (&L)[16]) {
  const int l31 = lane & 31, lh = lane >> 5;
  bf16x8 bq[4];
#pragma unroll
  for (int ks = 0; ks < 4; ++ks) bq[ks] = *(const bf16x8*)(p.Q + (size_t)tok * 1024 + h * 128 + side * 64 + ks * 16 + lh * 8);
#pragma unroll
  for (int nt = 0; nt < 4; ++nt) {
    f32x16 acc;
#pragma unroll
    for (int r = 0; r < 16; ++r) acc[r] = 0.f;
#pragma unroll
    for (int ks = 0; ks < 4; ++ks) {
      const bf16x8 ak = *(const bf16x8*)(keys + ((size_t)(h * 128 + nt * 32 + l31)) * 64 + ks * 16 + lh * 8);
      acc = __builtin_amdgcn_mfma_f32_32x32x16_bf16(ak, bq[ks], acc, 0, 0, 0);
    }
    float V[16];
#pragma unroll
    for (int r = 0; r < 16; ++r) {
      const unsigned n = (unsigned)(nt * 32 + (r & 3) + 8 * (r >> 2)) + 4u * (unsigned)lh;
      V[r] = __uint_as_float((__float_as_uint(acc[r]) & ~127u) | n);
    }
    sort16_desc(V);
    if (nt == 0) {
#pragma unroll
      for (int j = 0; j < 16; ++j) L[j] = V[j];
    } else merge16_desc(L, V);
  }
  float P[16];
#pragma unroll
  for (int j = 0; j < 16; ++j) P[j] = __shfl_xor(L[j], 32);
  merge16_desc(L, P);
}
__device__ void phase6(const Params& p, unsigned char* lds) {
  const int tid = threadIdx.x, lane = tid & 63, wid = tid >> 6;
  unsigned char* ib = lds + wid * (64 * 36);
  const int gw = (blockIdx.x * NT + tid) >> 6, nw = (gridDim.x * NT) >> 6;
  for (int job = gw; job < (NTOK / 32) * 8; job += nw) {
    const int tile = job >> 3, h = job & 7;
    const int tok = tile * 32 + (lane & 31);
    float L1[16], L2[16];
    peer_side_top16(p, p.K1, tok, h, 0, lane, L1);
    peer_side_top16(p, p.K2, tok, h, 1, lane, L2);
    {
      unsigned* iw = (unsigned*)(ib + lane * 36);
#pragma unroll
      for (int q = 0; q < 4; ++q) {
        iw[q] = (__float_as_uint(L1[q * 4]) & 127u) | ((__float_as_uint(L1[q * 4 + 1]) & 127u) << 8) | ((__float_as_uint(L1[q * 4 + 2]) & 127u) << 16) | ((__float_as_uint(L1[q * 4 + 3]) & 127u) << 24);
        iw[4 + q] = (__float_as_uint(L2[q * 4]) & 127u) | ((__float_as_uint(L2[q * 4 + 1]) & 127u) << 8) | ((__float_as_uint(L2[q * 4 + 2]) & 127u) << 16) | ((__float_as_uint(L2[q * 4 + 3]) & 127u) << 24);
      }
    }
    float C[16];
    {
      auto cand = [&](int i, int j) -> float {
        const float v = __uint_as_float(__float_as_uint(L1[i]) & ~127u) + __uint_as_float(__float_as_uint(L2[j]) & ~127u);
        return __uint_as_float((__float_as_uint(v) & ~255u) | (unsigned)(i * 16 + j));
      };
      float R[16];
#pragma unroll
      for (int j = 0; j < 16; ++j) { C[j] = cand(0, j); R[j] = j < 8 ? cand(1, j) : -3.0e38f; }
      merge16_desc(C, R);
      R[0] = cand(2, 0); R[1] = cand(2, 1); R[2] = cand(2, 2); R[3] = cand(2, 3); R[4] = cand(2, 4);
      R[5] = cand(3, 0); R[6] = cand(3, 1); R[7] = cand(3, 2); R[8] = cand(3, 3);
      R[9] = cand(4, 0); R[10] = cand(4, 1); R[11] = cand(4, 2);
      R[12] = cand(5, 0); R[13] = cand(5, 1); R[14] = cand(6, 0); R[15] = cand(6, 1);
      sort16_desc(R);
      merge16_desc(C, R);
      R[0] = cand(7, 0); R[1] = cand(7, 1);
#pragma unroll
      for (int i = 8; i < 16; ++i) R[i - 6] = cand(i, 0);
#pragma unroll
      for (int j = 10; j < 16; ++j) R[j] = -3.0e38f;
      sort16_desc(R);
      merge16_desc(C, R);
    }
    __builtin_amdgcn_wave_barrier();
    const float m = __uint_as_float(__float_as_uint(C[0]) & ~255u);
    float e[16], sum = 0.f;
    unsigned idx[16];
#pragma unroll
    for (int j = 0; j < 16; ++j) {
      const unsigned cb = __float_as_uint(C[j]);
      e[j] = __expf(__uint_as_float(cb & ~255u) - m);
      sum += e[j];
      const unsigned i1 = ib[lane * 36 + ((cb >> 4) & 15u)], i2 = ib[lane * 36 + 16 + (cb & 15u)];
      idx[j] = i1 * 128u + i2;
    }
    const float inv = 1.f / sum;
    if (lane < 32) {
      uint4* eo = (uint4*)(p.EI + (size_t)tok * 128 + h * 16);
      float4* go = (float4*)(p.EG + (size_t)tok * 128 + h * 16);
#pragma unroll
      for (int q = 0; q < 4; ++q) {
        eo[q] = make_uint4(idx[q * 4], idx[q * 4 + 1], idx[q * 4 + 2], idx[q * 4 + 3]);
        go[q] = make_float4(e[q * 4] * inv, e[q * 4 + 1] * inv, e[q * 4 + 2] * inv, e[q * 4 + 3] * inv);
      }
    }
    __builtin_amdgcn_wave_barrier();
  }
}

typedef float v32f __attribute__((ext_vector_type(32)));
typedef float v2f __attribute__((ext_vector_type(2)));
typedef unsigned v6u __attribute__((ext_vector_type(6)));
typedef __bf16 v2bf __attribute__((ext_vector_type(2)));
typedef __bf16 v32bf __attribute__((ext_vector_type(32)));
__device__ __forceinline__ v32f unpack_fp6(const uint4 a, const uint2 b) {
  v6u w; w[0] = a.x; w[1] = a.y; w[2] = a.z; w[3] = a.w; w[4] = b.x; w[5] = b.y;
  return __builtin_amdgcn_cvt_scalef32_pk32_f32_fp6(w, 1.0f);
}
__device__ void phase7(const Params& p) {
  const int lane = threadIdx.x & 63, l31 = lane & 31, half = lane >> 5;
  const int gw = (blockIdx.x * NT + threadIdx.x) >> 6, nw = (gridDim.x * NT) >> 6;
  for (int tok = gw; tok < NTOK; tok += nw) {
    unsigned hp16[16];
    {
      const uint2* hp = (const uint2*)(p.H2 + (size_t)tok * 1024 + l31 * 4);
#pragma unroll
      for (int i = 0; i < 8; ++i) { const uint2 a = hp[i * 32]; hp16[i * 2] = a.x; hp16[i * 2 + 1] = a.y; }
    }
    const unsigned ei0 = p.EI[(size_t)tok * 128 + lane] & 16383u, ei1 = p.EI[(size_t)tok * 128 + 64 + lane] & 16383u;
    const float eg0 = p.EG[(size_t)tok * 128 + lane] * p.SV[ei0], eg1 = p.EG[(size_t)tok * 128 + 64 + lane] * p.SV[ei1];
    const float su0 = p.SU[ei0], su1 = p.SU[ei1];
    float ff[32];
#pragma unroll
    for (int j = 0; j < 32; ++j) ff[j] = 0.f;
#pragma unroll 1
    for (int grp = 0; grp < 16; ++grp) {
      const unsigned eiv = grp < 8 ? ei0 : ei1;
      const float egv = grp < 8 ? eg0 : eg1;
      const float suv = grp < 8 ? su0 : su1;
      const int lb = (grp & 7) * 8;
      uint4 ua[4], va[4];
#pragma unroll
      for (int i = 0; i < 4; ++i) {
        const unsigned id = (unsigned)__shfl((int)eiv, lb + 2 * i + half);
        const unsigned char* ur = p.TU + (size_t)id * 512;
        const unsigned char* vr = p.TV + (size_t)id * 512;
        ua[i] = *(const uint4*)(ur + l31 * 16);
        va[i] = *(const uint4*)(vr + l31 * 16);
      }
      float part[4];
#pragma unroll
      for (int i = 0; i < 4; ++i) {
        const unsigned wq[4] = {ua[i].x, ua[i].y, ua[i].z, ua[i].w};
        float s0 = 0.f, s1 = 0.f;
#pragma unroll
        for (int d = 0; d < 4; ++d) {
          s0 = __builtin_amdgcn_fdot2_f32_bf16(__builtin_amdgcn_cvt_scalef32_pk_bf16_fp4(wq[d], 1.0f, 0), __builtin_bit_cast(v2bf, hp16[d * 4 + 0]), s0, false);
          s1 = __builtin_amdgcn_fdot2_f32_bf16(__builtin_amdgcn_cvt_scalef32_pk_bf16_fp4(wq[d], 1.0f, 1), __builtin_bit_cast(v2bf, hp16[d * 4 + 1]), s1, false);
          s0 = __builtin_amdgcn_fdot2_f32_bf16(__builtin_amdgcn_cvt_scalef32_pk_bf16_fp4(wq[d], 1.0f, 2), __builtin_bit_cast(v2bf, hp16[d * 4 + 2]), s0, false);
          s1 = __builtin_amdgcn_fdot2_f32_bf16(__builtin_amdgcn_cvt_scalef32_pk_bf16_fp4(wq[d], 1.0f, 3), __builtin_bit_cast(v2bf, hp16[d * 4 + 3]), s1, false);
        }
        part[i] = s0 + s1;
        __builtin_amdgcn_sched_barrier(0);
      }
      float r2[2], r1;
      {
        const bool h4 = lane & 16;
#pragma unroll
        for (int i = 0; i < 2; ++i) { const float keep = h4 ? part[i + 2] : part[i], send = h4 ? part[i] : part[i + 2]; r2[i] = keep + __shfl_xor(send, 16); }
        const bool h3 = lane & 8;
        { const float keep = h3 ? r2[1] : r2[0], send = h3 ? r2[0] : r2[1]; r1 = keep + __shfl_xor(send, 8); }
        r1 += dppf<0x141>(r1); r1 += dppf<0x4E>(r1); r1 += dppf<0xB1>(r1);
      }
      const int myI = ((lane >> 4) & 1) * 2 + ((lane >> 3) & 1);
      const int slot = lb + 2 * myI + half;
      const float gate = __shfl(egv, slot), su = __shfl(suv, slot);
      const float coef = gate * gelu_(r1 * su);
#pragma unroll
      for (int i = 0; i < 4; ++i) {
        const float c = __shfl(coef, (lane & 32) + ((i >> 1) & 1) * 16 + (i & 1) * 8);
        const unsigned wv[4] = {va[i].x, va[i].y, va[i].z, va[i].w};
#pragma unroll
        for (int d = 0; d < 4; ++d) {
          const v2f v0 = __builtin_amdgcn_cvt_scalef32_pk_f32_fp4(wv[d], 1.0f, 0);
          const v2f v1 = __builtin_amdgcn_cvt_scalef32_pk_f32_fp4(wv[d], 1.0f, 1);
          const v2f v2 = __builtin_amdgcn_cvt_scalef32_pk_f32_fp4(wv[d], 1.0f, 2);
          const v2f v3 = __builtin_amdgcn_cvt_scalef32_pk_f32_fp4(wv[d], 1.0f, 3);
          ff[d * 8 + 0] += c * v0[0]; ff[d * 8 + 1] += c * v0[1]; ff[d * 8 + 2] += c * v1[0]; ff[d * 8 + 3] += c * v1[1];
          ff[d * 8 + 4] += c * v2[0]; ff[d * 8 + 5] += c * v2[1]; ff[d * 8 + 6] += c * v3[0]; ff[d * 8 + 7] += c * v3[1];
        }
        __builtin_amdgcn_sched_barrier(0);
      }
    }
    float fs[16];
#pragma unroll
    for (int j = 0; j < 16; ++j) {
      const float mine = half ? ff[16 + j] : ff[j], other = half ? ff[j] : ff[16 + j];
      fs[j] = mine + __shfl_xor(other, 32);
    }
    const int k0 = half * 512 + l31 * 4;
    const float* x1 = p.X1 + (size_t)tok * 1024 + k0;
    const float* ga = p.mod + (size_t)sq_of(tok) * 6144 + 5120 + k0;
    float xf[16];
    float s = 0.f;
#pragma unroll
    for (int i = 0; i < 4; ++i) {
      const float4 a = *(const float4*)(x1 + i * 128), g4 = *(const float4*)(ga + i * 128);
      xf[i * 4] = a.x + g4.x * fs[i * 4]; xf[i * 4 + 1] = a.y + g4.y * fs[i * 4 + 1]; xf[i * 4 + 2] = a.z + g4.z * fs[i * 4 + 2]; xf[i * 4 + 3] = a.w + g4.w * fs[i * 4 + 3];
      s += xf[i * 4] * xf[i * 4] + xf[i * 4 + 1] * xf[i * 4 + 1] + xf[i * 4 + 2] * xf[i * 4 + 2] + xf[i * 4 + 3] * xf[i * 4 + 3];
    }
#pragma unroll
    for (int o = 32; o > 0; o >>= 1) s += __shfl_xor(s, o);
    const float rs = rsqrtf(s * (1.f / 1024.f) + NORM_EPS);
#pragma unroll
    for (int i = 0; i < 4; ++i) {
      const float4 g4 = *(const float4*)(p.fng + k0 + i * 128);
      *(float4*)(p.out + (size_t)tok * 1024 + k0 + i * 128) = make_float4(xf[i * 4] * rs * g4.x, xf[i * 4 + 1] * rs * g4.y, xf[i * 4 + 2] * rs * g4.z, xf[i * 4 + 3] * rs * g4.w);
    }
  }
}


template <int PH>
__global__ void __launch_bounds__(NT, 2) phase_kernel(Params p) {
  __shared__ __attribute__((aligned(16))) unsigned char lds[LDS_BYTES];
  if (PH == 0) phase0(p, lds);
  if (PH == 1) { phase0b(p); phase1(p, lds); }
  if (PH == 2) phase2(p, lds);
  if (PH == 3) phase3(p, lds);
  if (PH == 4) phase4a(p, lds);
  if (PH == 5) phase4b(p, lds);
  if (PH == 6) phase5a(p);
  if (PH == 7) phase5b(p, lds);
  if (PH == 8) phase6(p, lds);
  if (PH == 9) phase7(p);
}

__global__ void __launch_bounds__(NT, 2) mega_kernel(Params p) {
  __shared__ __attribute__((aligned(16))) unsigned char lds[LDS_BYTES + 16];
  if (p.never) cg::this_grid().sync();
  volatile unsigned* st = (volatile unsigned*)(lds + LDS_BYTES);
  if (threadIdx.x == 0) { st[0] = 0u; st[1] = 0u; st[2] = 0u; st[3] = 0u; }
  __syncthreads();
  XcdBarrier b = xcd_barrier_post(p.bar, st);
  phase0(p, lds);  xcd_barrier(b);
  if (DUP == 0) { phase0(p, lds); xcd_barrier(b); }
  phase0b(p);      xcd_barrier(b);
  phase1(p, lds);  xcd_barrier(b);
  if (DUP == 1) { phase1(p, lds); xcd_barrier(b); }
  phase2(p, lds);  xcd_barrier(b);
  if (DUP == 2) { phase2(p, lds); xcd_barrier(b); }
  phase3(p, lds);  xcd_barrier(b);
  if (DUP == 3) { phase3(p, lds, 64, P3MODE); xcd_barrier(b); }
  phase4a(p, lds); xcd_barrier(b);
  if (DUP == 4) { phase4a(p, lds); xcd_barrier(b); }
  phase4b(p, lds); xcd_barrier(b);
  if (DUP == 5) { phase4b(p, lds); xcd_barrier(b); }
  phase5a(p);      xcd_barrier(b);
  if (DUP == 6) { phase5a(p); xcd_barrier(b); }
  phase5b(p, lds); xcd_barrier(b);
  if (DUP == 7) { phase5b(p, lds); xcd_barrier(b); }
  phase6(p, lds);  xcd_barrier(b);
  if (DUP == 8) { phase6(p, lds); xcd_barrier(b); }
  phase7(p);
  if (DUP == 9) { xcd_barrier(b); phase7(p); }
}

extern "C" void kernel_launch(void* const* d_in, const int* in_sizes, int n_in, void* d_out, int out_size, void* d_ws, size_t ws_size,
                              hipStream_t stream) {
  Params p;
  memset(&p, 0, sizeof(p));
  const float** f = (const float**)&p.xp;
  for (int i = 0; i < 41; ++i) f[i] = (const float*)d_in[i];
  p.out = (float*)d_out;
  unsigned char* w = (unsigned char*)d_ws;
  size_t off = 0;
  auto take = [&](size_t bytes) { unsigned char* r = w + off; off += (bytes + 255) & ~(size_t)255; return r; };
  p.bar = (unsigned*)take(XCD_BAR_WORDS * 4);
  p.TU = take((size_t)16384 * 512);
  p.TV = take((size_t)16384 * 512);
  p.SU = (float*)take(16384 * 4);
  p.SV = (float*)take(16384 * 4);
  p.WinT = (bfu*)take((size_t)2304 * 1024 * 2);
  p.WoutT = (bfu*)take((size_t)1024 * 1024 * 2);
  p.WqT = (bfu*)take((size_t)1024 * 1024 * 2);
  p.WgluT = (bfu*)take((size_t)512 * 512 * 2);
  p.K1 = (bfu*)take(65536 * 2);
  p.K2 = (bfu*)take(65536 * 2);
  p.mod = (float*)take((size_t)NSQ * 6144 * 4);
  p.rs1 = (float*)take(NTOK * 4);
  p.lbre = (float*)take(2048 * 4); p.lbim = (float*)take(2048 * 4);
  p.lbLre = (float*)take(2048 * 4); p.lbLim = (float*)take(2048 * 4);
  p.BBre = (float*)take(32768 * 4); p.BBim = (float*)take(32768 * 4);
  p.BON = (float*)take((size_t)NTOK * 8 * 4);
  p.BONX = (float*)take((size_t)NTOK * 8 * 4);
  p.w2T = (bfu*)take(512 * 64 * 2); p.a2T = (bfu*)take(512 * 64 * 2); p.g2T = (bfu*)take(512 * 128 * 2);
  p.BBh = (bfu*)take(32 * 128 * 16 * 2); p.CCh = (bfu*)take(32 * 16 * 128 * 2);
  p.E = (float*)take((size_t)8 * 32 * 32 * 128 * 4);
  unsigned char* regC = take((size_t)NTOK * INC * 2);
  p.PJ = (bfu*)regC; p.X1 = (float*)regC;
  unsigned char* regDE = take((size_t)NTOK * 1024 * 2);
  p.LD = (bfu*)regDE; p.AA = (bfu*)(regDE + (size_t)NTOK * 512 * 2); p.Q = (bfu*)regDE;
  unsigned char* regF = take((size_t)NTOK * 128 * 8);
  p.GG = (bfu*)regF; p.EI = (unsigned*)regF; p.EG = (float*)(regF + (size_t)NTOK * 128 * 4);
  unsigned char* regY = take((size_t)NTOK * 512 * 4);
  p.Y5 = (float*)regY; p.H2 = (bfu*)regY; p.H1 = (bfu*)regY; p.CAT = (bfu*)regDE;
  if (off > ws_size) { fprintf(stderr, "workspace too small: need %zu have %zu\n", off, ws_size); return; }
  p.never = 0;

  (void)hipMemsetAsync(p.bar, 0, XCD_BAR_WORDS * 4, stream);
  (void)hipMemsetAsync(p.mod, 0, (size_t)NSQ * 6144 * 4, stream);
#if MULTI
  const int G = 512;
  phase_kernel<0><<<G, NT, 0, stream>>>(p);
  phase_kernel<1><<<G, NT, 0, stream>>>(p);
  phase_kernel<2><<<G, NT, 0, stream>>>(p);
  phase_kernel<3><<<G, NT, 0, stream>>>(p);
  phase_kernel<4><<<G, NT, 0, stream>>>(p);
  phase_kernel<5><<<G, NT, 0, stream>>>(p);
  phase_kernel<6><<<G, NT, 0, stream>>>(p);
  phase_kernel<7><<<G, NT, 0, stream>>>(p);
  phase_kernel<8><<<G, NT, 0, stream>>>(p);
  phase_kernel<9><<<G, NT, 0, stream>>>(p);
#else
  static int grid_blocks = 0;
  if (!grid_blocks) {
    int dev = 0, cus = 0, per_cu = 0;
    hipGetDevice(&dev);
    hipDeviceGetAttribute(&cus, hipDeviceAttributeMultiprocessorCount, dev);
    hipOccupancyMaxActiveBlocksPerMultiprocessor(&per_cu, mega_kernel, NT, 0);
    if (per_cu > 2) per_cu = 2;
    if (per_cu < 1) per_cu = 1;
    grid_blocks = cus * per_cu;
  }
  void* args[] = {&p};
  hipError_t e = hipLaunchCooperativeKernel((void*)mega_kernel, dim3(grid_blocks), dim3(NT), args, 0, stream);
  if (e != hipSuccess) fprintf(stderr, "cooperative launch failed: %s (grid %d)\n", hipGetErrorString(e), grid_blocks);
#endif
}
```

```cpp
#include <hip/hip_runtime.h>
#include <hip/hip_cooperative_groups.h>
#include <stdint.h>
#include <stdio.h>
#include <string.h>
namespace cg = cooperative_groups;

#ifndef MULTI
#define MULTI 0
#endif
#ifndef DUP
#define DUP -1
#endif

typedef unsigned short bfu;
using bf16x8 = __attribute__((ext_vector_type(8))) short;
using f32x16 = __attribute__((ext_vector_type(16))) float;

constexpr int NTOK = 17408, NPT = 16384, NSQ = 136, DM = 1024, INC = 2304, RC = 1792;
constexpr int O_S5RE_P = 17825792, O_S5IM_P = 17842176, O_WKV_P = 17858560, O_SH_P = 18120704;
constexpr int O_S5RE_S = 18135040, O_S5IM_S = 18397184, O_WKV_S = 18659328, O_SH_S = 22853632;
constexpr float NORM_EPS = 1e-6f, GN_EPS = 64e-5f;
constexpr int NT = 256;
constexpr int LDS_BYTES = 75776;
constexpr int LDS_JOB = LDS_BYTES - 16;

struct Params {
  const float *xp, *xs, *s5re0, *s5im0, *wkv0, *shift0, *cp, *cs, *w_ada, *b_ada, *n1g, *n2g, *w_in, *w_out;
  const float *s5are, *s5aim, *s5ldt, *s5bre, *s5bim, *s5cre, *s5cim, *s5d, *w_glu, *b_glu;
  const float *mu, *w0, *w2, *a0, *a2, *g2, *k_k, *k_a, *r_k, *gn_w, *gn_b, *w_q, *keys1, *keys2, *pu, *pv, *fng;
  float* out;
  unsigned char *TU, *TV; float *SU, *SV;
  bfu *WinT, *WoutT, *WqT, *WgluT, *K1, *K2;
  float *mod, *rs1, *lbre, *lbim, *lbLre, *lbLim, *BBre, *BBim;
  bfu* PJ; float* X1; bfu *LD, *AA, *GG; float* Y5; bfu *Q, *H2; unsigned* EI; float* EG; float* BON; float* BONX; bfu *H1, *CAT; bfu *w2T, *a2T, *g2T, *BBh, *CCh; float* E;
  unsigned* bar;
  int never; int pad_;
};

__device__ __forceinline__ bfu f2bf(float f) { unsigned u = __float_as_uint(f); u += 0x7fffu + ((u >> 16) & 1u); return (bfu)(u >> 16); }
__device__ __forceinline__ float bf2f(bfu h) { return __uint_as_float(((unsigned)h) << 16); }
__device__ __forceinline__ unsigned pk2(float a, float b) { return (unsigned)f2bf(a) | ((unsigned)f2bf(b) << 16); }
__device__ __forceinline__ float bflo(unsigned u) { return __uint_as_float(u << 16); }
__device__ __forceinline__ float bfhi(unsigned u) { return __uint_as_float(u & 0xffff0000u); }
__device__ __forceinline__ int sq_of(int tok) { return tok < NPT ? (tok >> 11) : 8 + ((tok - NPT) >> 3); }
__device__ __forceinline__ int t_of(int tok) { return tok < NPT ? (tok & 2047) : ((tok - NPT) & 7); }
__device__ __forceinline__ const float* xrow(const Params& p, int tok) { return tok < NPT ? p.xp + (size_t)tok * DM : p.xs + (size_t)(tok - NPT) * DM; }
__device__ __forceinline__ float sigmoidf_(float x) { return 1.f / (1.f + __expf(-x)); }
__device__ __forceinline__ float gelu_(float x) { return 0.5f * x * (1.f + erff(x * 0.70710678118654752f)); }

#define XB_TMO 128
#define XB_XCNT(j) (256 + 64 * (j))
#define XB_XSUB(j) (1280 + 64 * (j))
#define XB_XGEN(j) (2304 + 64 * (j))
#define XB_TOP 3328
#define XB_TOPGEN 3392
#define XCD_BAR_WORDS 3456
#define XB_SPIN_CAP (1u << 22)
#define LAS __attribute__((address_space(3)))
__device__ __forceinline__ unsigned xb_ld(unsigned* p) { return __hip_atomic_load(p, __ATOMIC_RELAXED, __HIP_MEMORY_SCOPE_AGENT); }
__device__ __forceinline__ unsigned xb_add(unsigned* p, unsigned v) { return __hip_atomic_fetch_add(p, v, __ATOMIC_RELAXED, __HIP_MEMORY_SCOPE_AGENT); }
__device__ __forceinline__ unsigned xb_xcc_id() { return (unsigned)__builtin_amdgcn_s_getreg((3 << 11) | 20) & 0xFu; }
#define XB_SPIN(cond, bar) do { unsigned _sp = 0; while (cond) { __builtin_amdgcn_s_sleep(1); \
    if ((++_sp & 255u) == 0u) { if (xb_ld(&(bar)[XB_TMO])) break; if (_sp > XB_SPIN_CAP) { atomicAdd(&(bar)[XB_TMO], 1u); break; } } } } while (0)
struct XcdBarrier { unsigned* bar; unsigned x; volatile unsigned* st; };
__device__ __forceinline__ XcdBarrier xcd_barrier_post(unsigned* bar, volatile unsigned* st) {
  XcdBarrier b; b.bar = bar; b.x = xb_xcc_id(); b.st = st;
  if (threadIdx.x == 0) (void)xb_add(&bar[XB_XCNT(b.x)], 1u);
  return b;
}
__device__ __forceinline__ void xcd_barrier_complete(unsigned* bar, unsigned x, unsigned& nloc, unsigned& nx) {
  const unsigned G = gridDim.x;
  unsigned sum, cnt, mine, sp = 0u;
  for (;;) {
    sum = 0u; cnt = 0u; mine = 0u;
#pragma unroll
    for (unsigned j = 0; j < 16; ++j) { const unsigned c = xb_ld(&bar[XB_XCNT(j)]); sum += c; cnt += (c > 0u) ? 1u : 0u; mine = (j == x) ? c : mine; }
    if (sum == G) break;
    __builtin_amdgcn_s_sleep(1);
    if ((++sp & 255u) == 0u) { if (xb_ld(&bar[XB_TMO])) break; if (sp > XB_SPIN_CAP) { atomicAdd(&bar[XB_TMO], 1u); break; } }
  }
  nloc = mine > 0u ? mine : 1u; nx = cnt > 0u ? cnt : 1u;
}
__device__ __forceinline__ void xcd_barrier(const XcdBarrier& b) {
  asm volatile("s_waitcnt vmcnt(0)" ::: "memory");
  __syncthreads();
  if (threadIdx.x == 0) {
    unsigned* bar = b.bar;
    __builtin_amdgcn_s_waitcnt(0);
    unsigned nloc = b.st[0], nx = b.st[1];
    if (nloc == 0u) { xcd_barrier_complete(bar, b.x, nloc, nx); b.st[0] = nloc; b.st[1] = nx; }
    const unsigned old = xb_add(&bar[XB_XSUB(b.x)], 1u);
    const unsigned gen = old / nloc;
    if (old + 1u == (gen + 1u) * nloc) {
      __builtin_amdgcn_fence(__ATOMIC_RELEASE, "agent");
      asm volatile("s_waitcnt vmcnt(0)" ::: "memory");
      const unsigned og = xb_add(&bar[XB_TOP], 1u);
      const unsigned tg = og / nx;
      if (og + 1u == (tg + 1u) * nx) xb_add(&bar[XB_TOPGEN], 1u);
      else XB_SPIN(xb_ld(&bar[XB_TOPGEN]) == tg, bar);
      __builtin_amdgcn_fence(__ATOMIC_ACQUIRE, "agent");
      xb_add(&bar[XB_XGEN(b.x)], 1u);
      asm volatile("s_waitcnt vmcnt(0)" ::: "memory");
    } else {
      XB_SPIN(xb_ld(&bar[XB_XGEN(b.x)]) == gen, bar);
      __builtin_amdgcn_fence(__ATOMIC_ACQUIRE, "agent");
      asm volatile("s_waitcnt vmcnt(0)" ::: "memory");
    }
  }
  __syncthreads();
}

struct U4x4 { uint4 a, b, c, d; };
constexpr int GLD = 144;
template <int BM, class AL, class EP>
__device__ __forceinline__ void gemm_tile_t(int m0, int n0, int K, const bfu* __restrict__ Bt, AL al, EP ep, unsigned char* lds) {
  constexpr int BUF = 256 * GLD;
  constexpr int MI = BM / 64;
  const int tid = threadIdx.x, lane = tid & 63, wid = tid >> 6;
  const int wr = wid >> 1, wc = wid & 1;
  const int l31 = lane & 31, lh = lane >> 5;
  f32x16 acc[MI][2];
#pragma unroll
  for (int i = 0; i < MI; ++i)
#pragma unroll
    for (int j = 0; j < 2; ++j)
#pragma unroll
      for (int r = 0; r < 16; ++r) acc[i][j][r] = 0.f;
  const int srow = tid >> 1, sk = (tid & 1) * 32;
  const bool aon = srow < BM;
  uint4 av0, av1, av2, av3, bv0, bv1, bv2, bv3;
  auto gl = [&](int k0) {
    if (BM == 128 || aon) al(m0 + srow, k0 + sk, av0, av1, av2, av3);
    const uint4* bp = (const uint4*)(Bt + (size_t)(n0 + srow) * K + k0 + sk);
    bv0 = bp[0]; bv1 = bp[1]; bv2 = bp[2]; bv3 = bp[3];
  };
  auto st = [&](int buf) {
    uint4* da = (uint4*)(lds + buf * BUF + srow * GLD + sk * 2);
    uint4* db = (uint4*)(lds + buf * BUF + 128 * GLD + srow * GLD + sk * 2);
    if (BM == 128 || aon) { da[0] = av0; da[1] = av1; da[2] = av2; da[3] = av3; }
    db[0] = bv0; db[1] = bv1; db[2] = bv2; db[3] = bv3;
  };
  gl(0);
  __syncthreads();
  st(0);
  if (64 < K) gl(64);
  __syncthreads();
  const int nk = K >> 6;
  for (int kt = 0; kt < nk; ++kt) {
    const unsigned char* ldsA = lds + (kt & 1) * BUF;
    const unsigned char* ldsB = ldsA + 128 * GLD;
    if (kt + 1 < nk) st((kt + 1) & 1);
    if (kt + 2 < nk) gl((kt + 2) * 64);
#pragma unroll
    for (int s = 0; s < 4; ++s) {
      bf16x8 af[MI];
#pragma unroll
      for (int i = 0; i < MI; ++i) af[i] = *(const bf16x8*)(ldsA + (wr * (BM / 2) + i * 32 + l31) * GLD + s * 32 + lh * 16);
      const bf16x8 bf0 = *(const bf16x8*)(ldsB + (wc * 64 + l31) * GLD + s * 32 + lh * 16);
      const bf16x8 bf1 = *(const bf16x8*)(ldsB + (wc * 64 + 32 + l31) * GLD + s * 32 + lh * 16);
#pragma unroll
      for (int i = 0; i < MI; ++i) {
        acc[i][0] = __builtin_amdgcn_mfma_f32_32x32x16_bf16(af[i], bf0, acc[i][0], 0, 0, 0);
        acc[i][1] = __builtin_amdgcn_mfma_f32_32x32x16_bf16(af[i], bf1, acc[i][1], 0, 0, 0);
      }
    }
    __syncthreads();
  }
  {
    float* ct = (float*)lds;
#pragma unroll
    for (int i = 0; i < MI; ++i)
#pragma unroll
      for (int j = 0; j < 2; ++j)
#pragma unroll
        for (int r = 0; r < 16; ++r)
          ct[(wr * (BM / 2) + i * 32 + (r & 3) + 8 * (r >> 2) + 4 * lh) * 132 + wc * 64 + j * 32 + l31] = acc[i][j][r];
    __syncthreads();
#pragma unroll 4
    for (int it = 0; it < BM / 8; ++it) {
      const int idx = it * NT + tid, rl = idx >> 5, c4 = (idx & 31) * 4;
      ep(m0 + rl, n0 + c4, *(const float4*)(ct + rl * 132 + c4));
    }
  }
  __syncthreads();
}
template <class AL, class EP>
__device__ __forceinline__ void gemm_tile(int m0, int n0, int K, const bfu* __restrict__ Bt, AL al, EP ep, unsigned char* lds) {
  gemm_tile_t<128>(m0, n0, K, Bt, al, ep, lds);
}
template <class F128, class F64>
__device__ __forceinline__ void tiles_with_half_tail(int ntn, int tailm, F128 f128, F64 f64) {
  const int full = (136 - tailm) * ntn, total = full + tailm * 2 * ntn;
  for (int t = blockIdx.x; t < total; t += gridDim.x) {
    if (t < full) f128((t / ntn) * 128, (t % ntn) * 128);
    else { const int u = t - full; f64((136 - tailm) * 128 + (u / ntn) * 64, (u % ntn) * 128); }
  }
}

__device__ void phase0(const Params& p, unsigned char* lds) {
  const int tid = threadIdx.x, G = gridDim.x, gtid = blockIdx.x * NT + tid, gsz = G * NT;
  {
    const int lane = tid & 63, l31 = lane & 31, gw = gtid >> 6, nw = gsz >> 6;
    for (int rp = gw; rp < 16384; rp += nw) {
      const int r = rp * 2 + (lane >> 5);
      const bool isv = r >= 16384;
      const int row = r & 16383;
      const float4* src = (const float4*)((isv ? p.pv : p.pu) + (size_t)row * 1024 + l31 * 4);
      float x[32];
#pragma unroll
      for (int i = 0; i < 8; ++i) { const float4 v = src[i * 32]; x[i * 4] = v.x; x[i * 4 + 1] = v.y; x[i * 4 + 2] = v.z; x[i * 4 + 3] = v.w; }
      float m = 0.f;
#pragma unroll
      for (int i = 0; i < 32; ++i) m = fmaxf(m, fabsf(x[i]));
#pragma unroll
      for (int o = 16; o > 0; o >>= 1) m = fmaxf(m, __shfl_xor(m, o));
      {
        const float sc4 = m > 0.f ? 6.f / m : 1.f;
        unsigned wq[4] = {0u, 0u, 0u, 0u};
#pragma unroll
        for (int i = 0; i < 32; ++i) {
          const float a_ = fabsf(x[i]) * sc4;
          const unsigned code = (unsigned)(a_ >= 0.25f) + (unsigned)(a_ >= 0.75f) + (unsigned)(a_ >= 1.25f) + (unsigned)(a_ >= 1.75f) +
                                (unsigned)(a_ >= 2.5f) + (unsigned)(a_ >= 3.5f) + (unsigned)(a_ >= 5.f);
          wq[i >> 3] |= (code | (x[i] < 0.f ? 8u : 0u)) << (4 * (i & 7));
        }
        *(uint4*)((isv ? p.TV : p.TU) + (size_t)row * 512 + l31 * 16) = make_uint4(wq[0], wq[1], wq[2], wq[3]);
        if (l31 == 0) (isv ? p.SV : p.SU)[row] = m > 0.f ? m * (1.f / 6.f) : 1.f;
        continue;
      }
      const float sc = m > 0.f ? 7.5f / m : 1.f;
      unsigned long long w0 = 0ull, w1 = 0ull, w2 = 0ull;
#pragma unroll
      for (int i = 0; i < 32; ++i) {
        const float a_ = fminf(fabsf(x[i]) * sc, 7.5f);
        int code;
        if (a_ < 2.f) code = __float2int_rn(a_ * 8.f);
        else if (a_ < 4.f) code = 8 + __float2int_rn(a_ * 4.f);
        else code = 16 + __float2int_rn(a_ * 2.f);
        code = min(code, 31);
        const unsigned long long c6 = (unsigned long long)((unsigned)code | (x[i] < 0.f ? 32u : 0u));
        const int bit = 6 * i, wi = bit >> 6, sh = bit & 63;
        if (wi == 0) w0 |= c6 << sh; else if (wi == 1) w1 |= c6 << sh; else w2 |= c6 << sh;
        if (sh > 58) { if (wi == 0) w1 |= c6 >> (64 - sh); else if (wi == 1) w2 |= c6 >> (64 - sh); }
      }
      unsigned char* dst = p.TV + (size_t)row * 768;
      *(uint4*)(dst + l31 * 16) = make_uint4((unsigned)w0, (unsigned)(w0 >> 32), (unsigned)w1, (unsigned)(w1 >> 32));
      *(uint2*)(dst + 512 + l31 * 8) = make_uint2((unsigned)w2, (unsigned)(w2 >> 32));
      if (l31 == 0) p.SV[row] = m > 0.f ? m * (1.f / 7.5f) : 1.f;
    }
  }
  for (int i = gtid; i < 65536; i += gsz) { p.K1[i] = f2bf(p.keys1[i]); p.K2[i] = f2bf(p.keys2[i]); }
  {
    auto tr = [&](const float* __restrict__ src, bfu* __restrict__ dst, const int K, const int N) {
      for (int i = gtid; i < N * (K / 8); i += gsz) {
        const int n = i % N, k8 = i / N;
        float v[8];
#pragma unroll
        for (int j = 0; j < 8; ++j) v[j] = src[(size_t)(k8 * 8 + j) * N + n];
        *(uint4*)(dst + (size_t)n * K + k8 * 8) = make_uint4(pk2(v[0], v[1]), pk2(v[2], v[3]), pk2(v[4], v[5]), pk2(v[6], v[7]));
      }
    };
    tr(p.w_in, p.WinT, 1024, 2304);
    tr(p.w_out, p.WoutT, 1024, 1024);
    tr(p.w_q, p.WqT, 1024, 1024);
    tr(p.w_glu, p.WgluT, 512, 512);
    tr(p.w2, p.w2T, 64, 512);
    tr(p.a2, p.a2T, 64, 512);
    tr(p.g2, p.g2T, 128, 512);
  }
  for (int i = gtid; i < 2048; i += gsz) {
    const int g = i >> 6;
    const float dt = expf(p.s5ldt[g]);
    const float lre = p.s5are[i], lim = p.s5aim[i];
    const float mag = expf(lre * dt), ang = lim * dt;
    float sn, cs; sincosf(ang, &sn, &cs);
    const float lbr = mag * cs, lbi = mag * sn;
    p.lbre[i] = lbr; p.lbim[i] = lbi;
    float pr = lbr, pi = lbi;
#pragma unroll
    for (int s = 0; s < 6; ++s) { const float nr = pr * pr - pi * pi, ni = 2.f * pr * pi; pr = nr; pi = ni; }
    p.lbLre[i] = pr; p.lbLim[i] = pi;
    const float den = lre * lre + lim * lim;
    const float nre = lbr - 1.f, nim = lbi;
    const float cr = (nre * lre + nim * lim) / den, ci = (nim * lre - nre * lim) / den;
#pragma unroll
    for (int h = 0; h < 16; ++h) {
      const float br = p.s5bre[i * 16 + h], bi = p.s5bim[i * 16 + h];
      p.BBh[(g * 128 + (i & 63)) * 16 + h] = f2bf(cr * br - ci * bi);
      p.BBh[(g * 128 + 64 + (i & 63)) * 16 + h] = f2bf(cr * bi + ci * br);
    }
  }
  for (int i = gtid; i < 32 * 16 * 64; i += gsz) {
    const int gh = i >> 6, k = i & 63;
    p.CCh[gh * 128 + k] = f2bf(p.s5cre[i]);
    p.CCh[gh * 128 + 64 + k] = f2bf(-p.s5cim[i]);
  }
  {
    float* sc = (float*)lds;
    for (int it = blockIdx.x; it < 17 * 24 * 4; it += G) {
      const int kp = it & 3, slab = (it >> 2) % 24, sg = (it >> 2) / 24;
      __syncthreads();
      for (int i = tid; i < 8 * 256; i += NT) {
        const int sq = sg * 8 + (i >> 8), k = kp * 256 + (i & 255);
        const float c = sq < 8 ? p.cp[sq * 1024 + k] : p.cs[(sq - 8) * 1024 + k];
        sc[i] = c / (1.f + __expf(-c));
      }
      __syncthreads();
      const int col = slab * 256 + tid;
      float acc[8];
#pragma unroll
      for (int i = 0; i < 8; ++i) acc[i] = 0.f;
      const float* wp = p.w_ada + (size_t)(kp * 256) * 6144 + col;
#pragma unroll 4
      for (int k = 0; k < 256; k += 4) {
        float w[4];
#pragma unroll
        for (int j = 0; j < 4; ++j) w[j] = wp[(size_t)(k + j) * 6144];
#pragma unroll
        for (int i = 0; i < 8; ++i) {
          const float4 s4 = *(const float4*)(sc + i * 256 + k);
          acc[i] += s4.x * w[0] + s4.y * w[1] + s4.z * w[2] + s4.w * w[3];
        }
      }
      const float bb = kp == 0 ? p.b_ada[col] : 0.f;
#pragma unroll
      for (int i = 0; i < 8; ++i) atomicAdd(&p.mod[(size_t)(sg * 8 + i) * 6144 + col], acc[i] + bb);
    }
    __syncthreads();
  }
}

__device__ void phase1(const Params& p, unsigned char* lds) {
  const int ntile = 136 * 18;
  for (int t = blockIdx.x; t < ntile; t += gridDim.x) {
    const int mt = t / 18, nt = t % 18;
    auto al = [&](int row, int k, uint4& o0, uint4& o1, uint4& o2, uint4& o3) {
      const uint4* s_ = (const uint4*)(p.H1 + (size_t)row * 1024 + k);
      o0 = s_[0]; o1 = s_[1]; o2 = s_[2]; o3 = s_[3];
    };
    auto ep = [&](int row, int col, float4 v) {
      *(uint2*)(p.PJ + (size_t)row * INC + col) = make_uint2(pk2(v.x, v.y), pk2(v.z, v.w));
      if (col >= 512) {
        if (row < NPT) { if ((row & 2047) == 2047) *(float4*)(p.out + O_SH_P + (row >> 11) * RC + col - 512) = v; }
        else { const int r = row - NPT; if ((r & 7) == 7) *(float4*)(p.out + O_SH_S + (r >> 3) * RC + col - 512) = v; }
      }
    };
    gemm_tile(mt * 128, nt * 128, 1024, p.WinT, al, ep, lds);
  }
}

struct Cx { float r, i; };
__device__ __forceinline__ Cx cfma(const Cx a, const Cx b, const Cx c) { Cx o; o.r = a.r * b.r - a.i * b.i + c.r; o.i = a.r * b.i + a.i * b.r + c.i; return o; }
using f32x4 = __attribute__((ext_vector_type(4))) float;
constexpr int HIMG = 272;
template <int MT, bool OUT>
__device__ __forceinline__ void s5_chunk(const Params& p, const int tok0, const int nvalid, const int g, Cx (&st)[2], const int Gend,
                                         unsigned char* himg, const int lane) {
  const int c = lane & 31, half = lane >> 5;
  Cx l1[2], l2[2], l3[2], l4[2];
#pragma unroll
  for (int s = 0; s < 2; ++s) {
    const int gp = g * 64 + 32 * s + c;
    l1[s].r = p.lbre[gp]; l1[s].i = p.lbim[gp];
    const Cx z = {0.f, 0.f};
    l2[s] = cfma(l1[s], l1[s], z); l3[s] = cfma(l2[s], l1[s], z); l4[s] = cfma(l2[s], l2[s], z);
  }
  bf16x8 bfr[4];
#pragma unroll
  for (int nt = 0; nt < 4; ++nt) bfr[nt] = *(const bf16x8*)(p.BBh + ((size_t)(g * 128 + 32 * nt + c)) * 16 + 8 * half);
  bf16x8 cfr[4];
  float dsk = 0.f;
  if (OUT) {
#pragma unroll
    for (int ks = 0; ks < 4; ++ks) cfr[ks] = *(const bf16x8*)(p.CCh + ((size_t)(g * 16 + (lane & 15))) * 128 + 32 * ks + 8 * (lane >> 4));
    dsk = p.s5d[g * 16 + (lane & 15)];
  }
  Cx endst[2] = {st[0], st[1]};
#pragma unroll
  for (int mt = 0; mt < MT; ++mt) {
    bf16x8 af;
#pragma unroll
    for (int j = 0; j < 8; ++j) af[j] = 0;
    if (32 * mt + c < nvalid) af = *(const bf16x8*)(p.PJ + (size_t)(tok0 + 32 * mt + c) * INC + g * 16 + 8 * half);
#pragma unroll
    for (int s = 0; s < 2; ++s) {
      f32x16 bre, bim;
#pragma unroll
      for (int r = 0; r < 16; ++r) { bre[r] = 0.f; bim[r] = 0.f; }
      bre = __builtin_amdgcn_mfma_f32_32x32x16_bf16(af, bfr[s], bre, 0, 0, 0);
      bim = __builtin_amdgcn_mfma_f32_32x32x16_bf16(af, bfr[2 + s], bim, 0, 0, 0);
      Cx e[4], pe[4];
#pragma unroll
      for (int q = 0; q < 4; ++q) {
        Cx x; x.r = bre[4 * q]; x.i = bim[4 * q];
#pragma unroll
        for (int i = 1; i < 4; ++i) { Cx b_; b_.r = bre[4 * q + i]; b_.i = bim[4 * q + i]; x = cfma(l1[s], x, b_); bre[4 * q + i] = x.r; bim[4 * q + i] = x.i; }
        e[q] = x;
      }
#pragma unroll
      for (int q = 0; q < 4; ++q) { pe[q].r = __shfl_xor(e[q].r, 32); pe[q].i = __shfl_xor(e[q].i, 32); }
      Cx carry = st[s];
      Cx cin[4];
#pragma unroll
      for (int q = 0; q < 4; ++q) {
        const Cx ee = half ? pe[q] : e[q];
        const Cx eo = half ? e[q] : pe[q];
        const Cx cin_e = carry;
        carry = cfma(l4[s], carry, ee);
        if (8 * mt + 2 * q == Gend) endst[s] = carry;
        const Cx cin_o = carry;
        carry = cfma(l4[s], carry, eo);
        if (8 * mt + 2 * q + 1 == Gend) endst[s] = carry;
        cin[q] = half ? cin_o : cin_e;
      }
      st[s] = carry;
      if (OUT) {
        bfu* hi16 = (bfu*)himg;
#pragma unroll
        for (int q = 0; q < 4; ++q)
#pragma unroll
          for (int i = 0; i < 4; ++i) {
            const Cx lp = i == 0 ? l1[s] : (i == 1 ? l2[s] : (i == 2 ? l3[s] : l4[s]));
            Cx b_; b_.r = bre[4 * q + i]; b_.i = bim[4 * q + i];
            const Cx h = cfma(lp, cin[q], b_);
            const int tl = i + 8 * q + 4 * half;
            hi16[tl * (HIMG / 2) + 32 * s + c] = f2bf(h.r);
            hi16[tl * (HIMG / 2) + 64 + 32 * s + c] = f2bf(h.i);
          }
      }
    }
    if (OUT) {
      __builtin_amdgcn_wave_barrier();
#pragma unroll
      for (int rt = 0; rt < 2; ++rt) {
        f32x4 acc = {0.f, 0.f, 0.f, 0.f};
#pragma unroll
        for (int ks = 0; ks < 4; ++ks) {
          const bf16x8 a_ = *(const bf16x8*)(himg + (16 * rt + (lane & 15)) * HIMG + (32 * ks + 8 * (lane >> 4)) * 2);
          acc = __builtin_amdgcn_mfma_f32_16x16x32_bf16(a_, cfr[ks], acc, 0, 0, 0);
        }
#pragma unroll
        for (int r = 0; r < 4; ++r) {
          const int t = 32 * mt + 16 * rt + 4 * (lane >> 4) + r;
          if (t < nvalid) {
            const float u = bf2f(p.PJ[(size_t)(tok0 + t) * INC + g * 16 + (lane & 15)]);
            p.Y5[(size_t)(tok0 + t) * 512 + g * 16 + (lane & 15)] = gelu_(acc[r] + dsk * u);
          }
        }
      }
      __builtin_amdgcn_wave_barrier();
    }
  }
  st[0] = endst[0]; st[1] = endst[1];
}
__device__ void s5_pass_a(const Params& p) {
  const int lane = threadIdx.x & 63, gw = (blockIdx.x * NT + threadIdx.x) >> 6, nw = (gridDim.x * NT) >> 6;
  for (int job = gw; job < 8 * 32 * 32; job += nw) {
    const int c = job & 31, g = (job >> 5) & 31, b = job >> 10;
    Cx st[2] = {{0.f, 0.f}, {0.f, 0.f}};
    s5_chunk<2, false>(p, b * 2048 + c * 64, 64, g, st, 15, nullptr, lane);
    if (lane < 32) {
      float* e = p.E + (size_t)job * 128;
      e[lane] = st[0].r; e[32 + lane] = st[1].r; e[64 + lane] = st[0].i; e[96 + lane] = st[1].i;
    }
  }
}
__device__ void s5_job_c(const Params& p, int bj, bool prompt, unsigned char* lds) {
  const int lane = threadIdx.x & 63, wid = threadIdx.x >> 6;
  unsigned char* himg = lds + wid * (32 * HIMG);
  const int job = bj * 4 + wid;
  const int cc = lane & 31;
  if (prompt) {
    const int c = job & 31, g = (job >> 5) & 31, b = job >> 10;
    Cx L64[2], st[2];
#pragma unroll
    for (int s = 0; s < 2; ++s) { const int gp = g * 64 + 32 * s + cc; L64[s].r = p.lbLre[gp]; L64[s].i = p.lbLim[gp]; st[s].r = 0.f; st[s].i = 0.f; }
    const float* e = p.E + (size_t)(job - c) * 128;
    for (int j = 0; j < c; ++j) {
      Cx e0, e1;
      e0.r = e[j * 128 + cc]; e1.r = e[j * 128 + 32 + cc]; e0.i = e[j * 128 + 64 + cc]; e1.i = e[j * 128 + 96 + cc];
      st[0] = cfma(L64[0], st[0], e0); st[1] = cfma(L64[1], st[1], e1);
    }
    s5_chunk<2, true>(p, b * 2048 + c * 64, 64, g, st, 15, himg, lane);
    if (c == 31 && lane < 32) {
      float* o = p.out + O_S5RE_P + (b * 32 + g) * 64;
      o[lane] = st[0].r; o[32 + lane] = st[1].r;
      o = p.out + O_S5IM_P + (b * 32 + g) * 64;
      o[lane] = st[0].i; o[32 + lane] = st[1].i;
    }
  } else {
    const int g = job & 31, bs = job >> 5;
    Cx st[2];
    const float* r0 = p.s5re0 + ((size_t)bs * 32 + g) * 64;
    const float* i0 = p.s5im0 + ((size_t)bs * 32 + g) * 64;
    st[0].r = r0[cc]; st[1].r = r0[32 + cc]; st[0].i = i0[cc]; st[1].i = i0[32 + cc];
    s5_chunk<1, true>(p, NPT + bs * 8, 8, g, st, 1, himg, lane);
    if (lane < 32) {
      float* o = p.out + O_S5RE_S + ((size_t)bs * 32 + g) * 64;
      o[lane] = st[0].r; o[32 + lane] = st[1].r;
      o = p.out + O_S5IM_S + ((size_t)bs * 32 + g) * 64;
      o[lane] = st[0].i; o[32 + lane] = st[1].i;
    }
  }
}

__device__ __forceinline__ float tanh_fast(float x) { const float e = __expf(2.f * x); return 1.f - 2.f / (e + 1.f); }
template <int WHICH>
__device__ void lora_tiles(const Params& p, unsigned char* lds) {
  constexpr int base = WHICH == 0 ? 1536 : (WHICH == 1 ? 1600 : 1664);
  const int G_ = (int)gridDim.x;
  for (int t = (((int)blockIdx.x - WHICH * 544) % G_ + G_) % G_; t < 136 * 4; t += G_) {
    const int mt = t >> 2, nt = t & 3;
    auto al = [&](int row, int k, uint4& o0, uint4& o1, uint4& o2, uint4& o3) {
      const bfu* pc = p.PJ + (size_t)row * INC + 512 + base + k;
      const int tt = t_of(row);
      auto one = [&](int i) -> uint4 {
        const uint4 cu = *(const uint4*)(pc + i * 8);
        const float cur[8] = {bflo(cu.x), bfhi(cu.x), bflo(cu.y), bfhi(cu.y), bflo(cu.z), bfhi(cu.z), bflo(cu.w), bfhi(cu.w)};
        float prv[8];
        if (tt == 0) {
          if (row < NPT) {
#pragma unroll
            for (int j = 0; j < 8; ++j) prv[j] = 0.f;
          } else {
            const float4* s0 = (const float4*)(p.shift0 + (size_t)(sq_of(row) - 8) * RC + base + k + i * 8);
            const float4 a = s0[0], b_ = s0[1];
            prv[0] = a.x; prv[1] = a.y; prv[2] = a.z; prv[3] = a.w; prv[4] = b_.x; prv[5] = b_.y; prv[6] = b_.z; prv[7] = b_.w;
          }
        } else {
          const uint4 pu_ = *(const uint4*)(pc - INC + i * 8);
          prv[0] = bflo(pu_.x); prv[1] = bfhi(pu_.x); prv[2] = bflo(pu_.y); prv[3] = bfhi(pu_.y); prv[4] = bflo(pu_.z); prv[5] = bfhi(pu_.z); prv[6] = bflo(pu_.w); prv[7] = bfhi(pu_.w);
        }
        const float4 m0 = *(const float4*)(p.mu + base + k + i * 8), m1 = *(const float4*)(p.mu + base + k + i * 8 + 4);
        const float mm[8] = {m0.x, m0.y, m0.z, m0.w, m1.x, m1.y, m1.z, m1.w};
        float f[8];
#pragma unroll
        for (int j = 0; j < 8; ++j) {
          const float ps = cur[j] + (prv[j] - cur[j]) * mm[j];
          f[j] = WHICH == 0 ? tanh_fast(ps) : (WHICH == 1 ? ps : sigmoidf_(ps));
        }
        return make_uint4(pk2(f[0], f[1]), pk2(f[2], f[3]), pk2(f[4], f[5]), pk2(f[6], f[7]));
      };
      o0 = one(0); o1 = one(1); o2 = one(2); o3 = one(3);
    };
    auto ep = [&](int row, int col, float4 v4) {
      const size_t o = (size_t)row * 512 + col;
      const float v[4] = {v4.x, v4.y, v4.z, v4.w};
      float f[4];
      if (WHICH == 0) {
        const float4 w0 = *(const float4*)(p.w0 + col);
        const float ww[4] = {w0.x, w0.y, w0.z, w0.w};
#pragma unroll
        for (int j = 0; j < 4; ++j) {
          const float z = -(ww[j] + v[j]);
          const float sp = fmaxf(z, 0.f) + __logf(1.f + __expf(-fabsf(z)));
          f[j] = -__expf(-sp - 0.5f);
        }
        *(uint2*)(p.LD + o) = make_uint2(pk2(f[0], f[1]), pk2(f[2], f[3]));
      } else if (WHICH == 1) {
        const float4 a0 = *(const float4*)(p.a0 + col);
        const float aa[4] = {a0.x, a0.y, a0.z, a0.w};
#pragma unroll
        for (int j = 0; j < 4; ++j) f[j] = sigmoidf_(aa[j] + v[j]);
        *(uint2*)(p.AA + o) = make_uint2(pk2(f[0], f[1]), pk2(f[2], f[3]));
      } else {
        *(uint2*)(p.GG + o) = make_uint2(pk2(v[0], v[1]), pk2(v[2], v[3]));
      }
    };
    gemm_tile(mt * 128, nt * 128, WHICH == 2 ? 128 : 64, WHICH == 0 ? p.w2T : (WHICH == 1 ? p.a2T : p.g2T), al, ep, lds);
  }
}
__device__ void phase2(const Params& p, unsigned char* lds) {
  lora_tiles<0>(p, lds);
  lora_tiles<1>(p, lds);
  lora_tiles<2>(p, lds);
  s5_pass_a(p);
}

template <int CTRL>
__device__ __forceinline__ float dppf(float x) { return __uint_as_float((unsigned)__builtin_amdgcn_update_dpp(0, (int)__float_as_uint(x), CTRL, 0xf, 0xf, true)); }
template <int LPR>
__device__ __forceinline__ float red_lpr(float x) {
  x += dppf<0xB1>(x); x += dppf<0x4E>(x);
  if (LPR == 16) { x += dppf<0x141>(x); x += dppf<0x140>(x); }
  return x;
}
struct RwVec { float4 w, kk, b, k, r; };
template <int LPR, bool PROMPT>
__device__ void rwkv_job(const Params& p, int sq, int h, int rg, unsigned char* lds) {
  constexpr int ROWS = NT / LPR, KPL = 64 / LPR, NV = KPL / 4;
  float* Lr = (float*)lds;
  float* Lw = Lr + 17 * 64;
  float* Lk = Lw + 17 * 64;
  float* Lkk = Lk + 17 * 64;
  float* Lb = Lkk + 17 * 64;
  float* Lv = Lb + 17 * 64;
  float* Lyp0 = Lv + 17 * 64;
  const int tid = threadIdx.x;
  constexpr bool prompt = PROMPT;
  constexpr int T = PROMPT ? 2048 : 8;
  const int tokbase = prompt ? sq * 2048 : NPT + (sq - 8) * 8;
  const int row = tid / LPR, kq = tid % LPR;
  const int grow = rg * ROWS + row;
  float S[KPL];
  if (prompt) {
#pragma unroll
    for (int j = 0; j < KPL; ++j) S[j] = 0.f;
  } else {
    const float* s0 = p.wkv0 + (((size_t)(sq - 8) * 8 + h) * 64 + grow) * 64 + kq * KPL;
#pragma unroll
    for (int j = 0; j < NV; ++j) { const float4 v = ((const float4*)s0)[j]; S[j * 4] = v.x; S[j * 4 + 1] = v.y; S[j * 4 + 2] = v.z; S[j * 4 + 3] = v.w; }
  }
  const int tt = tid >> 4, kg = tid & 15, k4 = kg * 4;
  const int hc = h * 64 + k4;
  float mur[4], muk[4], muv[4], kkc[4], kac[4], rkc[4];
#pragma unroll
  for (int j = 0; j < 4; ++j) {
    mur[j] = p.mu[hc + j]; muk[j] = p.mu[512 + hc + j]; muv[j] = p.mu[1024 + hc + j];
    kkc[j] = p.k_k[hc + j]; kac[j] = p.k_a[hc + j]; rkc[j] = p.r_k[hc + j];
  }
  uint2 Acr, Ack, Acv, Aqr, Aqk, Aqv, Ald, Aaa;
  uint2 Bcr, Bck, Bcv, Bqr, Bqk, Bqv, Bld, Baa;
  auto gload = [&](int c0, uint2& cr, uint2& ck, uint2& cv, uint2& qr, uint2& qk, uint2& qv, uint2& ldv, uint2& aav) {
    const int cc0 = PROMPT ? min(c0, T - 16) : 0;
    const int nst = PROMPT ? 16 : 8;
    const int t = cc0 + (tt < nst ? tt : 0);
    const int tok = tokbase + t;
    const bfu* pc = p.PJ + (size_t)tok * INC + 512 + hc;
    const bfu* pp = pc - (t > 0 ? INC : 0);
    cr = *(const uint2*)(pc); ck = *(const uint2*)(pc + 512); cv = *(const uint2*)(pc + 1024);
    qr = *(const uint2*)(pp); qk = *(const uint2*)(pp + 512); qv = *(const uint2*)(pp + 1024);
    ldv = *(const uint2*)(p.LD + (size_t)tok * 512 + hc);
    aav = *(const uint2*)(p.AA + (size_t)tok * 512 + hc);
  };
  auto store_y = [&](int c0, const float* Lyp) {
    constexpr int nst = PROMPT ? 16 : 8;
    for (int i = tid; i < nst * ROWS; i += NT) {
      const int s = i / ROWS, rr = i % ROWS;
      const float4* yp = (const float4*)(Lyp + (size_t)i * LPR);
      float y = 0.f;
#pragma unroll
      for (int j = 0; j < LPR / 4; ++j) { const float4 v = yp[j]; y += (v.x + v.y) + (v.z + v.w); }
      p.out[(size_t)(tokbase + c0 + s) * 1024 + 512 + h * 64 + rg * ROWS + rr] = y;
    }
  };
  auto process = [&](int c0, int par, uint2& cr, uint2& ck, uint2& cv, uint2& qr, uint2& qk, uint2& qv, uint2& ldv, uint2& aav) {
    float* Lyp = Lyp0 + par * (16 * NT);
    constexpr int nst = PROMPT ? 16 : 8;
    const bool act = PROMPT ? true : (tt < nst);
    const int t = c0 + (act ? tt : 0);
    const int tok = tokbase + t;
    {
      float pr[4], pk_[4], pv_[4];
      if (t == 0) {
        if (prompt) {
#pragma unroll
          for (int j = 0; j < 4; ++j) pr[j] = pk_[j] = pv_[j] = 0.f;
        } else {
          const float* s0 = p.shift0 + (size_t)(sq - 8) * RC + hc;
#pragma unroll
          for (int j = 0; j < 4; ++j) { pr[j] = s0[j]; pk_[j] = s0[512 + j]; pv_[j] = s0[1024 + j]; }
        }
      } else {
        pr[0] = bflo(qr.x); pr[1] = bfhi(qr.x); pr[2] = bflo(qr.y); pr[3] = bfhi(qr.y);
        pk_[0] = bflo(qk.x); pk_[1] = bfhi(qk.x); pk_[2] = bflo(qk.y); pk_[3] = bfhi(qk.y);
        pv_[0] = bflo(qv.x); pv_[1] = bfhi(qv.x); pv_[2] = bflo(qv.y); pv_[3] = bfhi(qv.y);
      }
      const float c_r[4] = {bflo(cr.x), bfhi(cr.x), bflo(cr.y), bfhi(cr.y)};
      const float c_k[4] = {bflo(ck.x), bfhi(ck.x), bflo(ck.y), bfhi(ck.y)};
      const float c_v[4] = {bflo(cv.x), bfhi(cv.x), bflo(cv.y), bfhi(cv.y)};
      const float ld4[4] = {bflo(ldv.x), bfhi(ldv.x), bflo(ldv.y), bfhi(ldv.y)};
      const float aa4[4] = {bflo(aav.x), bfhi(aav.x), bflo(aav.y), bfhi(aav.y)};
      float r4[4], kx4[4], v4[4], w4[4], kk4[4];
      float ssq = 0.f, bon = 0.f;
#pragma unroll
      for (int j = 0; j < 4; ++j) {
        r4[j] = c_r[j] + (pr[j] - c_r[j]) * mur[j];
        const float kx = c_k[j] + (pk_[j] - c_k[j]) * muk[j];
        v4[j] = c_v[j] + (pv_[j] - c_v[j]) * muv[j];
        w4[j] = __expf(ld4[j]);
        kk4[j] = kx * kkc[j];
        ssq += kk4[j] * kk4[j];
        kx4[j] = kx * (1.f + (aa4[j] - 1.f) * kac[j]);
        bon += r4[j] * kx4[j] * rkc[j];
      }
      ssq = red_lpr<16>(ssq); bon = red_lpr<16>(bon);
      const float inv = rsqrtf(fmaxf(ssq, 1e-24f));
      __syncthreads();
      if (act) {
        *(float4*)(Lr + tt * 64 + k4) = make_float4(r4[0], r4[1], r4[2], r4[3]);
        *(float4*)(Lw + tt * 64 + k4) = make_float4(w4[0], w4[1], w4[2], w4[3]);
        *(float4*)(Lk + tt * 64 + k4) = make_float4(kx4[0], kx4[1], kx4[2], kx4[3]);
        *(float4*)(Lkk + tt * 64 + k4) = make_float4(kk4[0] * inv, kk4[1] * inv, kk4[2] * inv, kk4[3] * inv);
        *(float4*)(Lb + tt * 64 + k4) = make_float4(kk4[0] * inv * aa4[0], kk4[1] * inv * aa4[1], kk4[2] * inv * aa4[2], kk4[3] * inv * aa4[3]);
        *(float4*)(Lv + tt * 64 + k4) = make_float4(v4[0], v4[1], v4[2], v4[3]);
        (rg == 0 ? p.BON : p.BONX)[(size_t)tok * 8 + h] = bon;
      }
    }
    __syncthreads();
    if (PROMPT) store_y(max(c0 - 16, 0), Lyp0 + (par ^ 1) * (16 * NT));
    gload(c0 + 32, cr, ck, cv, qr, qk, qv, ldv, aav);
    {
      auto ldvec = [&](int s, int j) -> RwVec {
        RwVec v;
        const int o = s * 64 + kq * KPL + j * 4;
        v.w = *(const float4*)(Lw + o); v.kk = *(const float4*)(Lkk + o); v.b = *(const float4*)(Lb + o);
        v.k = *(const float4*)(Lk + o); v.r = *(const float4*)(Lr + o);
        return v;
      };
      RwVec cur[NV];
      float vcur;
#pragma unroll
      for (int j = 0; j < NV; ++j) cur[j] = ldvec(0, j);
      vcur = Lv[grow];
      for (int s = 0; s < nst; ++s) {
        RwVec nxt[NV];
        float vnx;
#pragma unroll
        for (int j = 0; j < NV; ++j) nxt[j] = ldvec(s + 1, j);
        vnx = Lv[(s + 1) * 64 + grow];
        float sa0 = 0.f, sa1 = 0.f;
#pragma unroll
        for (int j = 0; j < NV; ++j) {
          sa0 += S[j * 4] * cur[j].kk.x; sa1 += S[j * 4 + 1] * cur[j].kk.y;
          sa0 += S[j * 4 + 2] * cur[j].kk.z; sa1 += S[j * 4 + 3] * cur[j].kk.w;
        }
        float tq[KPL];
#pragma unroll
        for (int j = 0; j < NV; ++j) {
          tq[j * 4] = S[j * 4] * cur[j].w.x + vcur * cur[j].k.x;
          tq[j * 4 + 1] = S[j * 4 + 1] * cur[j].w.y + vcur * cur[j].k.y;
          tq[j * 4 + 2] = S[j * 4 + 2] * cur[j].w.z + vcur * cur[j].k.z;
          tq[j * 4 + 3] = S[j * 4 + 3] * cur[j].w.w + vcur * cur[j].k.w;
        }
        float sa = -red_lpr<LPR>(sa0 + sa1);
        float y0 = 0.f, y1 = 0.f;
#pragma unroll
        for (int j = 0; j < NV; ++j) {
          S[j * 4] = tq[j * 4] + sa * cur[j].b.x;
          S[j * 4 + 1] = tq[j * 4 + 1] + sa * cur[j].b.y;
          S[j * 4 + 2] = tq[j * 4 + 2] + sa * cur[j].b.z;
          S[j * 4 + 3] = tq[j * 4 + 3] + sa * cur[j].b.w;
          y0 += S[j * 4] * cur[j].r.x; y1 += S[j * 4 + 1] * cur[j].r.y;
          y0 += S[j * 4 + 2] * cur[j].r.z; y1 += S[j * 4 + 3] * cur[j].r.w;
        }
        Lyp[(s * ROWS + row) * LPR + kq] = y0 + y1;
#pragma unroll
        for (int j = 0; j < NV; ++j) cur[j] = nxt[j];
        vcur = vnx;
      }
    }
  };
  gload(0, Acr, Ack, Acv, Aqr, Aqk, Aqv, Ald, Aaa);
  gload(16, Bcr, Bck, Bcv, Bqr, Bqk, Bqv, Bld, Baa);
  for (int c0 = 0; c0 < T; c0 += 32) {
    process(c0, 0, Acr, Ack, Acv, Aqr, Aqk, Aqv, Ald, Aaa);
    if (PROMPT) process(c0 + 16, 1, Bcr, Bck, Bcv, Bqr, Bqk, Bqv, Bld, Baa);
  }
  __syncthreads();
  {
    const int lastc = ((T - 1) >> 4) << 4;
    store_y(lastc, Lyp0 + ((lastc >> 4) & 1) * (16 * NT));
  }
  {
    float* so = p.out + (prompt ? O_WKV_P + (((size_t)sq * 8 + h) * 64 + grow) * 64 : O_WKV_S + (((size_t)(sq - 8) * 8 + h) * 64 + grow) * 64) + kq * KPL;
#pragma unroll
    for (int j = 0; j < NV; ++j) ((float4*)so)[j] = make_float4(S[j * 4], S[j * 4 + 1], S[j * 4 + 2], S[j * 4 + 3]);
  }
  __syncthreads();
}
__device__ void rwkv_post(const Params& p) {
  const int tid = threadIdx.x;
  const int h = (tid >> 4) & 7, kg = tid & 15, k4 = kg * 4, hc = h * 64 + k4;
  float muv[4], gnw[4], gnb[4];
#pragma unroll
  for (int j = 0; j < 4; ++j) { muv[j] = p.mu[1024 + hc + j]; gnw[j] = p.gn_w[hc + j]; gnb[j] = p.gn_b[hc + j]; }
  for (int it = blockIdx.x; it < NTOK / 2; it += gridDim.x) {
    const int tok = it * 2 + (tid >> 7);
    const int t = t_of(tok);
    const bfu* pc = p.PJ + (size_t)tok * INC + 512 + 1024 + hc;
    const uint2 cv = *(const uint2*)pc;
    float pv_[4];
    if (t == 0) {
      if (tok < NPT) { pv_[0] = pv_[1] = pv_[2] = pv_[3] = 0.f; }
      else { const float* s0 = p.shift0 + (size_t)(sq_of(tok) - 8) * RC + 1024 + hc; pv_[0] = s0[0]; pv_[1] = s0[1]; pv_[2] = s0[2]; pv_[3] = s0[3]; }
    } else {
      const uint2 qv = *(const uint2*)(pc - INC);
      pv_[0] = bflo(qv.x); pv_[1] = bfhi(qv.x); pv_[2] = bflo(qv.y); pv_[3] = bfhi(qv.y);
    }
    const float c_v[4] = {bflo(cv.x), bfhi(cv.x), bflo(cv.y), bfhi(cv.y)};
    float* yp = p.out + (size_t)tok * 1024 + 512 + hc;
    const float4 y4 = *(const float4*)yp;
    const float mean = red_lpr<16>(y4.x + y4.y + y4.z + y4.w) * (1.f / 64.f);
    const float dd[4] = {y4.x - mean, y4.y - mean, y4.z - mean, y4.w - mean};
    const float rstd = rsqrtf(red_lpr<16>(dd[0] * dd[0] + dd[1] * dd[1] + dd[2] * dd[2] + dd[3] * dd[3]) * (1.f / 64.f) + GN_EPS);
    const float bon = p.BON[(size_t)tok * 8 + h];
    const uint2 gv = *(const uint2*)(p.GG + (size_t)tok * 512 + hc);
    const float g4[4] = {bflo(gv.x), bfhi(gv.x), bflo(gv.y), bfhi(gv.y)};
    float o4[4];
#pragma unroll
    for (int j = 0; j < 4; ++j) {
      const float v = c_v[j] + (pv_[j] - c_v[j]) * muv[j];
      o4[j] = (dd[j] * rstd * gnw[j] + gnb[j] + bon * v) * g4[j];
    }
    *(uint2*)(p.CAT + (size_t)tok * 1024 + 512 + hc) = make_uint2(pk2(o4[0], o4[1]), pk2(o4[2], o4[3]));
  }
}

#ifndef P3MODE
#define P3MODE 0
#endif
__device__ void phase3(const Params& p, unsigned char* lds, int cw = 0, int mode = 0) {
  volatile int* jb = (volatile int*)(lds + LDS_JOB);
  for (;;) {
    __syncthreads();
    if (threadIdx.x == 0) *jb = (int)atomicAdd(&p.bar[cw], 1u);
    __syncthreads();
    const int j = *jb;
    if (j >= 4352) break;
    if (j < 256) { if (mode != 1) rwkv_job<16, true>(p, j >> 5, (j >> 2) & 7, j & 3, lds); }
    else if (j < 2304) { if (mode != 2) s5_job_c(p, j - 256, true, lds); }
    else if (j < 3328) { const int q = j - 2304; if (mode != 1) rwkv_job<4, false>(p, 8 + (q >> 3), q & 7, 0, lds); }
    else { if (mode != 2) s5_job_c(p, j - 3328, false, lds); }
  }
}

__device__ void phase4a(const Params& p, unsigned char* lds) {
  rwkv_post(p);
  {
    auto al = [&](int row, int k, uint4& o0, uint4& o1, uint4& o2, uint4& o3) {
      const float4* s = (const float4*)(p.Y5 + (size_t)row * 512 + k);
      auto one = [&](int i) -> uint4 { const float4 a = s[i * 2], b = s[i * 2 + 1]; return make_uint4(pk2(a.x, a.y), pk2(a.z, a.w), pk2(b.x, b.y), pk2(b.z, b.w)); };
      o0 = one(0); o1 = one(1); o2 = one(2); o3 = one(3);
    };
    auto ep = [&](int row, int col, float4 v) {
      const float4 y = *(const float4*)(p.Y5 + (size_t)row * 512 + col), bg = *(const float4*)(p.b_glu + col);
      *(uint2*)(p.CAT + (size_t)row * 1024 + col) = make_uint2(pk2(y.x * sigmoidf_(v.x + bg.x), y.y * sigmoidf_(v.y + bg.y)), pk2(y.z * sigmoidf_(v.z + bg.z), y.w * sigmoidf_(v.w + bg.w)));
    };
    tiles_with_half_tail(4, 8, [&](int m0, int n0) { gemm_tile_t<128>(m0, n0, 512, p.WgluT, al, ep, lds); },
                         [&](int m0, int n0) { gemm_tile_t<64>(m0, n0, 512, p.WgluT, al, ep, lds); });
  }
}
__device__ void phase4b(const Params& p, unsigned char* lds) {
  auto al = [&](int row, int k, uint4& o0, uint4& o1, uint4& o2, uint4& o3) {
    const uint4* s_ = (const uint4*)(p.CAT + (size_t)row * 1024 + k);
    o0 = s_[0]; o1 = s_[1]; o2 = s_[2]; o3 = s_[3];
  };
  auto ep = [&](int row, int col, float4 v) {
    const int sq = sq_of(row);
    const float4 x = *(const float4*)(xrow(p, row) + col), g = *(const float4*)(p.mod + (size_t)sq * 6144 + 2048 + col);
    *(float4*)(p.X1 + (size_t)row * 1024 + col) = make_float4(x.x + g.x * v.x, x.y + g.y * v.y, x.z + g.z * v.z, x.w + g.w * v.w);
  };
  tiles_with_half_tail(8, 8, [&](int m0, int n0) { gemm_tile_t<128>(m0, n0, 1024, p.WoutT, al, ep, lds); },
                       [&](int m0, int n0) { gemm_tile_t<64>(m0, n0, 1024, p.WoutT, al, ep, lds); });
}
template <bool FROMX>
__device__ void norm_rows(const Params& p, const float* __restrict__ gsrc, int sh_off, bfu* __restrict__ dst) {
  const int lane = threadIdx.x & 63, gw = (blockIdx.x * NT + threadIdx.x) >> 6, nw = (gridDim.x * NT) >> 6;
  for (int tok = gw; tok < NTOK; tok += nw) {
    const float* xr = FROMX ? xrow(p, tok) : p.X1 + (size_t)tok * 1024;
    const float* md = p.mod + (size_t)sq_of(tok) * 6144 + sh_off;
    float4 v[4];
    float s = 0.f;
#pragma unroll
    for (int i = 0; i < 4; ++i) { const float4 a = *(const float4*)(xr + lane * 16 + i * 4); v[i] = a; s += a.x * a.x + a.y * a.y + a.z * a.z + a.w * a.w; }
#pragma unroll
    for (int o = 32; o > 0; o >>= 1) s += __shfl_xor(s, o);
    const float rs = rsqrtf(s * (1.f / 1024.f) + NORM_EPS);
    float f[16];
#pragma unroll
    for (int i = 0; i < 4; ++i) {
      const int k = lane * 16 + i * 4;
      const float4 g4 = *(const float4*)(gsrc + k), sh = *(const float4*)(md + k), sc = *(const float4*)(md + 1024 + k);
      const float4 a = v[i];
      f[i * 4 + 0] = a.x * rs * g4.x * (1.f + sc.x) + sh.x;
      f[i * 4 + 1] = a.y * rs * g4.y * (1.f + sc.y) + sh.y;
      f[i * 4 + 2] = a.z * rs * g4.z * (1.f + sc.z) + sh.z;
      f[i * 4 + 3] = a.w * rs * g4.w * (1.f + sc.w) + sh.w;
    }
    uint4* d = (uint4*)(dst + (size_t)tok * 1024 + lane * 16);
    d[0] = make_uint4(pk2(f[0], f[1]), pk2(f[2], f[3]), pk2(f[4], f[5]), pk2(f[6], f[7]));
    d[1] = make_uint4(pk2(f[8], f[9]), pk2(f[10], f[11]), pk2(f[12], f[13]), pk2(f[14], f[15]));
  }
}
__device__ void phase0b(const Params& p) { norm_rows<true>(p, p.n1g, 0, p.H1); }
__device__ void phase5a(const Params& p) { norm_rows<false>(p, p.n2g, 3072, p.H2); }
__device__ void phase5b(const Params& p, unsigned char* lds) {
  auto al = [&](int row, int k, uint4& o0, uint4& o1, uint4& o2, uint4& o3) {
    const uint4* s = (const uint4*)(p.H2 + (size_t)row * 1024 + k);
    o0 = s[0]; o1 = s[1]; o2 = s[2]; o3 = s[3];
  };
  auto ep = [&](int row, int col, float4 v) { *(uint2*)(p.Q + (size_t)row * 1024 + col) = make_uint2(pk2(v.x, v.y), pk2(v.z, v.w)); };
  tiles_with_half_tail(8, 8, [&](int m0, int n0) { gemm_tile_t<128>(m0, n0, 1024, p.WqT, al, ep, lds); },
                       [&](int m0, int n0) { gemm_tile_t<64>(m0, n0, 1024, p.WqT, al, ep, lds); });
}

__device__ __forceinline__ void ins16(float (&L)[16], float x) {
#pragma unroll
  for (int j = 0; j < 16; ++j) { const float hi = fmaxf(L[j], x); x = fminf(L[j], x); L[j] = hi; }
}
__device__ __forceinline__ void ce_desc(float& a, float& b) { const float hi = fmaxf(a, b), lo = fminf(a, b); a = hi; b = lo; }
__device__ __forceinline__ void sort16_desc(float (&a)[16]) {
#pragma unroll
  for (int k = 2; k <= 16; k <<= 1)
#pragma unroll
    for (int j = k >> 1; j > 0; j >>= 1)
#pragma unroll
      for (int i = 0; i < 16; ++i) {
        const int l = i ^ j;
        if (l > i) {
          if ((i & k) == 0) ce_desc(a[i], a[l]);
          else ce_desc(a[l], a[i]);
        }
      }
}
__device__ __forceinline__ void merge16_desc(float (&L)[16], const float (&T)[16]) {
#pragma unroll
  for (int i = 0; i < 16; ++i) L[i] = fmaxf(L[i], T[15 - i]);
#pragma unroll
  for (int j = 8; j > 0; j >>= 1)
#pragma unroll
    for (int i = 0; i < 16; ++i) { const int l = i ^ j; if (l > i) ce_desc(L[i], L[l]); }
}
__device__ __forceinline__ void peer_side_top16(const Params& p, const bfu* __restrict__ keys, int tok, int h, int side, int lane, float (&L)[16]) {
  const int l31 = lane & 31, lh = lane >> 5;
  bf16x8 bq[4];
#pragma unroll
  for (int ks = 0; ks < 4; ++ks) bq[ks] = *(const bf16x8*)(p.Q + (size_t)tok * 1024 + h * 128 + side * 64 + ks * 16 + lh * 8);
#pragma unroll
  for (int nt = 0; nt < 4; ++nt) {
    f32x16 acc;
#pragma unroll
    for (int r = 0; r < 16; ++r) acc[r] = 0.f;
#pragma unroll
    for (int ks = 0; ks < 4; ++ks) {
      const bf16x8 ak = *(const bf16x8*)(keys + ((size_t)(h * 128 + nt * 32 + l31)) * 64 + ks * 16 + lh * 8);
      acc = __builtin_amdgcn_mfma_f32_32x32x16_bf16(ak, bq[ks], acc, 0, 0, 0);
    }
    float V[16];
#pragma unroll
    for (int r = 0; r < 16; ++r) {
      const unsigned n = (unsigned)(nt * 32 + (r & 3) + 8 * (r >> 2)) + 4u * (unsigned)lh;
      V[r] = __uint_as_float((__float_as_uint(acc[r]) & ~127u) | n);
    }
    sort16_desc(V);
    if (nt == 0) {
#pragma unroll
      for (int j = 0; j < 16; ++j) L[j] = V[j];
    } else merge16_desc(L, V);
  }
  float P[16];
#pragma unroll
  for (int j = 0; j < 16; ++j) P[j] = __shfl_xor(L[j], 32);
  merge16_desc(L, P);
}
__device__ void phase6(const Params& p, unsigned char* lds) {
  const int tid = threadIdx.x, lane = tid & 63, wid = tid >> 6;
  unsigned char* ib = lds + wid * (64 * 36);
  const int gw = (blockIdx.x * NT + tid) >> 6, nw = (gridDim.x * NT) >> 6;
  for (int job = gw; job < (NTOK / 32) * 8; job += nw) {
    const int tile = job >> 3, h = job & 7;
    const int tok = tile * 32 + (lane & 31);
    float L1[16], L2[16];
    peer_side_top16(p, p.K1, tok, h, 0, lane, L1);
    peer_side_top16(p, p.K2, tok, h, 1, lane, L2);
    {
      unsigned* iw = (unsigned*)(ib + lane * 36);
#pragma unroll
      for (int q = 0; q < 4; ++q) {
        iw[q] = (__float_as_uint(L1[q * 4]) & 127u) | ((__float_as_uint(L1[q * 4 + 1]) & 127u) << 8) | ((__float_as_uint(L1[q * 4 + 2]) & 127u) << 16) | ((__float_as_uint(L1[q * 4 + 3]) & 127u) << 24);
        iw[4 + q] = (__float_as_uint(L2[q * 4]) & 127u) | ((__float_as_uint(L2[q * 4 + 1]) & 127u) << 8) | ((__float_as_uint(L2[q * 4 + 2]) & 127u) << 16) | ((__float_as_uint(L2[q * 4 + 3]) & 127u) << 24);
      }
    }
    float C[16];
    {
      auto cand = [&](int i, int j) -> float {
        const float v = __uint_as_float(__float_as_uint(L1[i]) & ~127u) + __uint_as_float(__float_as_uint(L2[j]) & ~127u);
        return __uint_as_float((__float_as_uint(v) & ~255u) | (unsigned)(i * 16 + j));
      };
      float R[16];
#pragma unroll
      for (int j = 0; j < 16; ++j) { C[j] = cand(0, j); R[j] = j < 8 ? cand(1, j) : -3.0e38f; }
      merge16_desc(C, R);
      R[0] = cand(2, 0); R[1] = cand(2, 1); R[2] = cand(2, 2); R[3] = cand(2, 3); R[4] = cand(2, 4);
      R[5] = cand(3, 0); R[6] = cand(3, 1); R[7] = cand(3, 2); R[8] = cand(3, 3);
      R[9] = cand(4, 0); R[10] = cand(4, 1); R[11] = cand(4, 2);
      R[12] = cand(5, 0); R[13] = cand(5, 1); R[14] = cand(6, 0); R[15] = cand(6, 1);
      sort16_desc(R);
      merge16_desc(C, R);
      R[0] = cand(7, 0); R[1] = cand(7, 1);
#pragma unroll
      for (int i = 8; i < 16; ++i) R[i - 6] = cand(i, 0);
#pragma unroll
      for (int j = 10; j < 16; ++j) R[j] = -3.0e38f;
      sort16_desc(R);
      merge16_desc(C, R);
    }
    __builtin_amdgcn_wave_barrier();
    const float m = __uint_as_float(__float_as_uint(C[0]) & ~255u);
    float e[16], sum = 0.f;
    unsigned idx[16];
#pragma unroll
    for (int j = 0; j < 16; ++j) {
      const unsigned cb = __float_as_uint(C[j]);
      e[j] = __expf(__uint_as_float(cb & ~255u) - m);
      sum += e[j];
      const unsigned i1 = ib[lane * 36 + ((cb >> 4) & 15u)], i2 = ib[lane * 36 + 16 + (cb & 15u)];
      idx[j] = i1 * 128u + i2;
    }
    const float inv = 1.f / sum;
    if (lane < 32) {
      uint4* eo = (uint4*)(p.EI + (size_t)tok * 128 + h * 16);
      float4* go = (float4*)(p.EG + (size_t)tok * 128 + h * 16);
#pragma unroll
      for (int q = 0; q < 4; ++q) {
        eo[q] = make_uint4(idx[q * 4], idx[q * 4 + 1], idx[q * 4 + 2], idx[q * 4 + 3]);
        go[q] = make_float4(e[q * 4] * inv, e[q * 4 + 1] * inv, e[q * 4 + 2] * inv, e[q * 4 + 3] * inv);
      }
    }
    __builtin_amdgcn_wave_barrier();
  }
}

typedef float v32f __attribute__((ext_vector_type(32)));
typedef float v2f __attribute__((ext_vector_type(2)));
typedef unsigned v6u __attribute__((ext_vector_type(6)));
typedef __bf16 v2bf __attribute__((ext_vector_type(2)));
typedef __bf16 v32bf __attribute__((ext_vector_type(32)));
__device__ __forceinline__ v32f unpack_fp6(const uint4 a, const uint2 b) {
  v6u w; w[0] = a.x; w[1] = a.y; w[2] = a.z; w[3] = a.w; w[4] = b.x; w[5] = b.y;
  return __builtin_amdgcn_cvt_scalef32_pk32_f32_fp6(w, 1.0f);
}
__device__ void phase7(const Params& p) {
  const int lane = threadIdx.x & 63, l31 = lane & 31, half = lane >> 5;
  const int gw = (blockIdx.x * NT + threadIdx.x) >> 6, nw = (gridDim.x * NT) >> 6;
  for (int tok = gw; tok < NTOK; tok += nw) {
    unsigned hp16[16];
    {
      const uint2* hp = (const uint2*)(p.H2 + (size_t)tok * 1024 + l31 * 4);
#pragma unroll
      for (int i = 0; i < 8; ++i) { const uint2 a = hp[i * 32]; hp16[i * 2] = a.x; hp16[i * 2 + 1] = a.y; }
    }
    const unsigned ei0 = p.EI[(size_t)tok * 128 + lane] & 16383u, ei1 = p.EI[(size_t)tok * 128 + 64 + lane] & 16383u;
    const float eg0 = p.EG[(size_t)tok * 128 + lane] * p.SV[ei0], eg1 = p.EG[(size_t)tok * 128 + 64 + lane] * p.SV[ei1];
    const float su0 = p.SU[ei0], su1 = p.SU[ei1];
    float ff[32];
#pragma unroll
    for (int j = 0; j < 32; ++j) ff[j] = 0.f;
#pragma unroll 1
    for (int grp = 0; grp < 16; ++grp) {
      const unsigned eiv = grp < 8 ? ei0 : ei1;
      const float egv = grp < 8 ? eg0 : eg1;
      const float suv = grp < 8 ? su0 : su1;
      const int lb = (grp & 7) * 8;
      uint4 ua[4], va[4];
#pragma unroll
      for (int i = 0; i < 4; ++i) {
        const unsigned id = (unsigned)__shfl((int)eiv, lb + 2 * i + half);
        const unsigned char* ur = p.TU + (size_t)id * 512;
        const unsigned char* vr = p.TV + (size_t)id * 512;
        ua[i] = *(const uint4*)(ur + l31 * 16);
        va[i] = *(const uint4*)(vr + l31 * 16);
      }
      float part[4];
#pragma unroll
      for (int i = 0; i < 4; ++i) {
        const unsigned wq[4] = {ua[i].x, ua[i].y, ua[i].z, ua[i].w};
        float s0 = 0.f, s1 = 0.f;
#pragma unroll
        for (int d = 0; d < 4; ++d) {
          s0 = __builtin_amdgcn_fdot2_f32_bf16(__builtin_amdgcn_cvt_scalef32_pk_bf16_fp4(wq[d], 1.0f, 0), __builtin_bit_cast(v2bf, hp16[d * 4 + 0]), s0, false);
          s1 = __builtin_amdgcn_fdot2_f32_bf16(__builtin_amdgcn_cvt_scalef32_pk_bf16_fp4(wq[d], 1.0f, 1), __builtin_bit_cast(v2bf, hp16[d * 4 + 1]), s1, false);
          s0 = __builtin_amdgcn_fdot2_f32_bf16(__builtin_amdgcn_cvt_scalef32_pk_bf16_fp4(wq[d], 1.0f, 2), __builtin_bit_cast(v2bf, hp16[d * 4 + 2]), s0, false);
          s1 = __builtin_amdgcn_fdot2_f32_bf16(__builtin_amdgcn_cvt_scalef32_pk_bf16_fp4(wq[d], 1.0f, 3), __builtin_bit_cast(v2bf, hp16[d * 4 + 3]), s1, false);
        }
        part[i] = s0 + s1;
        __builtin_amdgcn_sched_barrier(0);
      }
      float r2[2], r1;
      {
        const bool h4 = lane & 16;
#pragma unroll
        for (int i = 0; i < 2; ++i) { const float keep = h4 ? part[i + 2] : part[i], send = h4 ? part[i] : part[i + 2]; r2[i] = keep + __shfl_xor(send, 16); }
        const bool h3 = lane & 8;
        { const float keep = h3 ? r2[1] : r2[0], send = h3 ? r2[0] : r2[1]; r1 = keep + __shfl_xor(send, 8); }
        r1 += dppf<0x141>(r1); r1 += dppf<0x4E>(r1); r1 += dppf<0xB1>(r1);
      }
      const int myI = ((lane >> 4) & 1) * 2 + ((lane >> 3) & 1);
      const int slot = lb + 2 * myI + half;
      const float gate = __shfl(egv, slot), su = __shfl(suv, slot);
      const float coef = gate * gelu_(r1 * su);
#pragma unroll
      for (int i = 0; i < 4; ++i) {
        const float c = __shfl(coef, (lane & 32) + ((i >> 1) & 1) * 16 + (i & 1) * 8);
        const unsigned wv[4] = {va[i].x, va[i].y, va[i].z, va[i].w};
#pragma unroll
        for (int d = 0; d < 4; ++d) {
          const v2f v0 = __builtin_amdgcn_cvt_scalef32_pk_f32_fp4(wv[d], 1.0f, 0);
          const v2f v1 = __builtin_amdgcn_cvt_scalef32_pk_f32_fp4(wv[d], 1.0f, 1);
          const v2f v2 = __builtin_amdgcn_cvt_scalef32_pk_f32_fp4(wv[d], 1.0f, 2);
          const v2f v3 = __builtin_amdgcn_cvt_scalef32_pk_f32_fp4(wv[d], 1.0f, 3);
          ff[d * 8 + 0] += c * v0[0]; ff[d * 8 + 1] += c * v0[1]; ff[d * 8 + 2] += c * v1[0]; ff[d * 8 + 3] += c * v1[1];
          ff[d * 8 + 4] += c * v2[0]; ff[d * 8 + 5] += c * v2[1]; ff[d * 8 + 6] += c * v3[0]; ff[d * 8 + 7] += c * v3[1];
        }
        __builtin_amdgcn_sched_barrier(0);
      }
    }
    float fs[16];
#pragma unroll
    for (int j = 0; j < 16; ++j) {
      const float mine = half ? ff[16 + j] : ff[j], other = half ? ff[j] : ff[16 + j];
      fs[j] = mine + __shfl_xor(other, 32);
    }
    const int k0 = half * 512 + l31 * 4;
    const float* x1 = p.X1 + (size_t)tok * 1024 + k0;
    const float* ga = p.mod + (size_t)sq_of(tok) * 6144 + 5120 + k0;
    float xf[16];
    float s = 0.f;
#pragma unroll
    for (int i = 0; i < 4; ++i) {
      const float4 a = *(const float4*)(x1 + i * 128), g4 = *(const float4*)(ga + i * 128);
      xf[i * 4] = a.x + g4.x * fs[i * 4]; xf[i * 4 + 1] = a.y + g4.y * fs[i * 4 + 1]; xf[i * 4 + 2] = a.z + g4.z * fs[i * 4 + 2]; xf[i * 4 + 3] = a.w + g4.w * fs[i * 4 + 3];
      s += xf[i * 4] * xf[i * 4] + xf[i * 4 + 1] * xf[i * 4 + 1] + xf[i * 4 + 2] * xf[i * 4 + 2] + xf[i * 4 + 3] * xf[i * 4 + 3];
    }
#pragma unroll
    for (int o = 32; o > 0; o >>= 1) s += __shfl_xor(s, o);
    const float rs = rsqrtf(s * (1.f / 1024.f) + NORM_EPS);
#pragma unroll
    for (int i = 0; i < 4; ++i) {
      const float4 g4 = *(const float4*)(p.fng + k0 + i * 128);
      *(float4*)(p.out + (size_t)tok * 1024 + k0 + i * 128) = make_float4(xf[i * 4] * rs * g4.x, xf[i * 4 + 1] * rs * g4.y, xf[i * 4 + 2] * rs * g4.z, xf[i * 4 + 3] * rs * g4.w);
    }
  }
}


template <int PH>
__global__ void __launch_bounds__(NT, 2) phase_kernel(Params p) {
  __shared__ __attribute__((aligned(16))) unsigned char lds[LDS_BYTES];
  if (PH == 0) phase0(p, lds);
  if (PH == 1) { phase0b(p); phase1(p, lds); }
  if (PH == 2) phase2(p, lds);
  if (PH == 3) phase3(p, lds);
  if (PH == 4) phase4a(p, lds);
  if (PH == 5) phase4b(p, lds);
  if (PH == 6) phase5a(p);
  if (PH == 7) phase5b(p, lds);
  if (PH == 8) phase6(p, lds);
  if (PH == 9) phase7(p);
}

__global__ void __launch_bounds__(NT, 2) mega_kernel(Params p) {
  __shared__ __attribute__((aligned(16))) unsigned char lds[LDS_BYTES + 16];
  if (p.never) cg::this_grid().sync();
  volatile unsigned* st = (volatile unsigned*)(lds + LDS_BYTES);
  if (threadIdx.x == 0) { st[0] = 0u; st[1] = 0u; st[2] = 0u; st[3] = 0u; }
  __syncthreads();
  XcdBarrier b = xcd_barrier_post(p.bar, st);
  phase0(p, lds);  xcd_barrier(b);
  if (DUP == 0) { phase0(p, lds); xcd_barrier(b); }
  phase0b(p);      xcd_barrier(b);
  phase1(p, lds);  xcd_barrier(b);
  if (DUP == 1) { phase1(p, lds); xcd_barrier(b); }
  phase2(p, lds);  xcd_barrier(b);
  if (DUP == 2) { phase2(p, lds); xcd_barrier(b); }
  phase3(p, lds);  xcd_barrier(b);
  if (DUP == 3) { phase3(p, lds, 64, P3MODE); xcd_barrier(b); }
  phase4a(p, lds); xcd_barrier(b);
  if (DUP == 4) { phase4a(p, lds); xcd_barrier(b); }
  phase4b(p, lds); xcd_barrier(b);
  if (DUP == 5) { phase4b(p, lds); xcd_barrier(b); }
  phase5a(p);      xcd_barrier(b);
  if (DUP == 6) { phase5a(p); xcd_barrier(b); }
  phase5b(p, lds); xcd_barrier(b);
  if (DUP == 7) { phase5b(p, lds); xcd_barrier(b); }
  phase6(p, lds);  xcd_barrier(b);
  if (DUP == 8) { phase6(p, lds); xcd_barrier(b); }
  phase7(p);
  if (DUP == 9) { xcd_barrier(b); phase7(p); }
}

extern "C" void kernel_launch(void* const* d_in, const int* in_sizes, int n_in, void* d_out, int out_size, void* d_ws, size_t ws_size,
                              hipStream_t stream) {
  Params p;
  memset(&p, 0, sizeof(p));
  const float** f = (const float**)&p.xp;
  for (int i = 0; i < 41; ++i) f[i] = (const float*)d_in[i];
  p.out = (float*)d_out;
  unsigned char* w = (unsigned char*)d_ws;
  size_t off = 0;
  auto take = [&](size_t bytes) { unsigned char* r = w + off; off += (bytes + 255) & ~(size_t)255; return r; };
  p.bar = (unsigned*)take(XCD_BAR_WORDS * 4);
  p.TU = take((size_t)16384 * 512);
  p.TV = take((size_t)16384 * 512);
  p.SU = (float*)take(16384 * 4);
  p.SV = (float*)take(16384 * 4);
  p.WinT = (bfu*)take((size_t)2304 * 1024 * 2);
  p.WoutT = (bfu*)take((size_t)1024 * 1024 * 2);
  p.WqT = (bfu*)take((size_t)1024 * 1024 * 2);
  p.WgluT = (bfu*)take((size_t)512 * 512 * 2);
  p.K1 = (bfu*)take(65536 * 2);
  p.K2 = (bfu*)take(65536 * 2);
  p.mod = (float*)take((size_t)NSQ * 6144 * 4);
  p.rs1 = (float*)take(NTOK * 4);
  p.lbre = (float*)take(2048 * 4); p.lbim = (float*)take(2048 * 4);
  p.lbLre = (float*)take(2048 * 4); p.lbLim = (float*)take(2048 * 4);
  p.BBre = (float*)take(32768 * 4); p.BBim = (float*)take(32768 * 4);
  p.BON = (float*)take((size_t)NTOK * 8 * 4);
  p.BONX = (float*)take((size_t)NTOK * 8 * 4);
  p.w2T = (bfu*)take(512 * 64 * 2); p.a2T = (bfu*)take(512 * 64 * 2); p.g2T = (bfu*)take(512 * 128 * 2);
  p.BBh = (bfu*)take(32 * 128 * 16 * 2); p.CCh = (bfu*)take(32 * 16 * 128 * 2);
  p.E = (float*)take((size_t)8 * 32 * 32 * 128 * 4);
  unsigned char* regC = take((size_t)NTOK * INC * 2);
  p.PJ = (bfu*)regC; p.X1 = (float*)regC;
  unsigned char* regDE = take((size_t)NTOK * 1024 * 2);
  p.LD = (bfu*)regDE; p.AA = (bfu*)(regDE + (size_t)NTOK * 512 * 2); p.Q = (bfu*)regDE;
  unsigned char* regF = take((size_t)NTOK * 128 * 8);
  p.GG = (bfu*)regF; p.EI = (unsigned*)regF; p.EG = (float*)(regF + (size_t)NTOK * 128 * 4);
  unsigned char* regY = take((size_t)NTOK * 512 * 4);
  p.Y5 = (float*)regY; p.H2 = (bfu*)regY; p.H1 = (bfu*)regY; p.CAT = (bfu*)regDE;
  if (off > ws_size) { fprintf(stderr, "workspace too small: need %zu have %zu\n", off, ws_size); return; }
  p.never = 0;

  (void)hipMemsetAsync(p.bar, 0, XCD_BAR_WORDS * 4, stream);
  (void)hipMemsetAsync(p.mod, 0, (size_t)NSQ * 6144 * 4, stream);
#if MULTI
  const int G = 512;
  phase_kernel<0><<<G, NT, 0, stream>>>(p);
  phase_kernel<1><<<G, NT, 0, stream>>>(p);
  phase_kernel<2><<<G, NT, 0, stream>>>(p);
  phase_kernel<3><<<G, NT, 0, stream>>>(p);
  phase_kernel<4><<<G, NT, 0, stream>>>(p);
  phase_kernel<5><<<G, NT, 0, stream>>>(p);
  phase_kernel<6><<<G, NT, 0, stream>>>(p);
  phase_kernel<7><<<G, NT, 0, stream>>>(p);
  phase_kernel<8><<<G, NT, 0, stream>>>(p);
  phase_kernel<9><<<G, NT, 0, stream>>>(p);
#else
  static int grid_blocks = 0;
  if (!grid_blocks) {
    int dev = 0, cus = 0, per_cu = 0;
    hipGetDevice(&dev);
    hipDeviceGetAttribute(&cus, hipDeviceAttributeMultiprocessorCount, dev);
    hipOccupancyMaxActiveBlocksPerMultiprocessor(&per_cu, mega_kernel, NT, 0);
    if (per_cu > 2) per_cu = 2;
    if (per_cu < 1) per_cu = 1;
    grid_blocks = cus * per_cu;
  }
  void* args[] = {&p};
  hipError_t e = hipLaunchCooperativeKernel((void*)mega_kernel, dim3(grid_blocks), dim3(NT), args, 0, stream);
  if (e != hipSuccess) fprintf(stderr, "cooperative launch failed: %s (grid %d)\n", hipGetErrorString(e), grid_blocks);
#endif
}
```

```cpp
#include <hip/hip_runtime.h>
#include <hip/hip_cooperative_groups.h>
#include <stdint.h>
#include <stdio.h>
#include <string.h>
namespace cg = cooperative_groups;

#ifndef MULTI
#define MULTI 0
#endif
#ifndef DUP
#define DUP -1
#endif

typedef unsigned short bfu;
using bf16x8 = __attribute__((ext_vector_type(8))) short;
using f32x16 = __attribute__((ext_vector_type(16))) float;

constexpr int NTOK = 17408, NPT = 16384, NSQ = 136, DM = 1024, INC = 2304, RC = 1792;
constexpr int O_S5RE_P = 17825792, O_S5IM_P = 17842176, O_WKV_P = 17858560, O_SH_P = 18120704;
constexpr int O_S5RE_S = 18135040, O_S5IM_S = 18397184, O_WKV_S = 18659328, O_SH_S = 22853632;
constexpr float NORM_EPS = 1e-6f, GN_EPS = 64e-5f;
constexpr int NT = 256;
constexpr int LDS_BYTES = 75776;
constexpr int LDS_JOB = LDS_BYTES - 16;

struct Params {
  const float *xp, *xs, *s5re0, *s5im0, *wkv0, *shift0, *cp, *cs, *w_ada, *b_ada, *n1g, *n2g, *w_in, *w_out;
  const float *s5are, *s5aim, *s5ldt, *s5bre, *s5bim, *s5cre, *s5cim, *s5d, *w_glu, *b_glu;
  const float *mu, *w0, *w2, *a0, *a2, *g2, *k_k, *k_a, *r_k, *gn_w, *gn_b, *w_q, *keys1, *keys2, *pu, *pv, *fng;
  float* out;
  unsigned char *TU, *TV; float *SU, *SV;
  bfu *WinT, *WoutT, *WqT, *WgluT, *K1, *K2;
  float *mod, *rs1, *lbre, *lbim, *lbLre, *lbLim, *BBre, *BBim;
  bfu* PJ; float* X1; bfu *LD, *AA, *GG; float* Y5; bfu *Q, *H2; unsigned* EI; float* EG; float* BON; float* BONX; bfu *H1, *CAT; bfu *w2T, *a2T, *g2T, *BBh, *CCh; float* E;
  unsigned* bar;
  int never; int pad_;
};

__device__ __forceinline__ bfu f2bf(float f) { unsigned u = __float_as_uint(f); u += 0x7fffu + ((u >> 16) & 1u); return (bfu)(u >> 16); }
__device__ __forceinline__ float bf2f(bfu h) { return __uint_as_float(((unsigned)h) << 16); }
__device__ __forceinline__ unsigned pk2(float a, float b) { return (unsigned)f2bf(a) | ((unsigned)f2bf(b) << 16); }
__device__ __forceinline__ float bflo(unsigned u) { return __uint_as_float(u << 16); }
__device__ __forceinline__ float bfhi(unsigned u) { return __uint_as_float(u & 0xffff0000u); }
__device__ __forceinline__ int sq_of(int tok) { return tok < NPT ? (tok >> 11) : 8 + ((tok - NPT) >> 3); }
__device__ __forceinline__ int t_of(int tok) { return tok < NPT ? (tok & 2047) : ((tok - NPT) & 7); }
__device__ __forceinline__ const float* xrow(const Params& p, int tok) { return tok < NPT ? p.xp + (size_t)tok * DM : p.xs + (size_t)(tok - NPT) * DM; }
__device__ __forceinline__ float sigmoidf_(float x) { return 1.f / (1.f + __expf(-x)); }
__device__ __forceinline__ float gelu_(float x) { return 0.5f * x * (1.f + erff(x * 0.70710678118654752f)); }

#define XB_TMO 128
#define XB_XCNT(j) (256 + 64 * (j))
#define XB_XSUB(j) (1280 + 64 * (j))
#define XB_XGEN(j) (2304 + 64 * (j))
#define XB_TOP 3328
#define XB_TOPGEN 3392
#define XCD_BAR_WORDS 3456
#define XB_SPIN_CAP (1u << 22)
#define LAS __attribute__((address_space(3)))
__device__ __forceinline__ unsigned xb_ld(unsigned* p) { return __hip_atomic_load(p, __ATOMIC_RELAXED, __HIP_MEMORY_SCOPE_AGENT); }
__device__ __forceinline__ unsigned xb_add(unsigned* p, unsigned v) { return __hip_atomic_fetch_add(p, v, __ATOMIC_RELAXED, __HIP_MEMORY_SCOPE_AGENT); }
__device__ __forceinline__ unsigned xb_xcc_id() { return (unsigned)__builtin_amdgcn_s_getreg((3 << 11) | 20) & 0xFu; }
#define XB_SPIN(cond, bar) do { unsigned _sp = 0; while (cond) { __builtin_amdgcn_s_sleep(1); \
    if ((++_sp & 255u) == 0u) { if (xb_ld(&(bar)[XB_TMO])) break; if (_sp > XB_SPIN_CAP) { atomicAdd(&(bar)[XB_TMO], 1u); break; } } } } while (0)
struct XcdBarrier { unsigned* bar; unsigned x; volatile unsigned* st; };
__device__ __forceinline__ XcdBarrier xcd_barrier_post(unsigned* bar, volatile unsigned* st) {
  XcdBarrier b; b.bar = bar; b.x = xb_xcc_id(); b.st = st;
  if (threadIdx.x == 0) (void)xb_add(&bar[XB_XCNT(b.x)], 1u);
  return b;
}
__device__ __forceinline__ void xcd_barrier_complete(unsigned* bar, unsigned x, unsigned& nloc, unsigned& nx) {
  const unsigned G = gridDim.x;
  unsigned sum, cnt, mine, sp = 0u;
  for (;;) {
    sum = 0u; cnt = 0u; mine = 0u;
#pragma unroll
    for (unsigned j = 0; j < 16; ++j) { const unsigned c = xb_ld(&bar[XB_XCNT(j)]); sum += c; cnt += (c > 0u) ? 1u : 0u; mine = (j == x) ? c : mine; }
    if (sum == G) break;
    __builtin_amdgcn_s_sleep(1);
    if ((++sp & 255u) == 0u) { if (xb_ld(&bar[XB_TMO])) break; if (sp > XB_SPIN_CAP) { atomicAdd(&bar[XB_TMO], 1u); break; } }
  }
  nloc = mine > 0u ? mine : 1u; nx = cnt > 0u ? cnt : 1u;
}
__device__ __forceinline__ void xcd_barrier(const XcdBarrier& b) {
  asm volatile("s_waitcnt vmcnt(0)" ::: "memory");
  __syncthreads();
  if (threadIdx.x == 0) {
    unsigned* bar = b.bar;
    __builtin_amdgcn_s_waitcnt(0);
    unsigned nloc = b.st[0], nx = b.st[1];
    if (nloc == 0u) { xcd_barrier_complete(bar, b.x, nloc, nx); b.st[0] = nloc; b.st[1] = nx; }
    const unsigned old = xb_add(&bar[XB_XSUB(b.x)], 1u);
    const unsigned gen = old / nloc;
    if (old + 1u == (gen + 1u) * nloc) {
      __builtin_amdgcn_fence(__ATOMIC_RELEASE, "agent");
      asm volatile("s_waitcnt vmcnt(0)" ::: "memory");
      const unsigned og = xb_add(&bar[XB_TOP], 1u);
      const unsigned tg = og / nx;
      if (og + 1u == (tg + 1u) * nx) xb_add(&bar[XB_TOPGEN], 1u);
      else XB_SPIN(xb_ld(&bar[XB_TOPGEN]) == tg, bar);
      __builtin_amdgcn_fence(__ATOMIC_ACQUIRE, "agent");
      xb_add(&bar[XB_XGEN(b.x)], 1u);
      asm volatile("s_waitcnt vmcnt(0)" ::: "memory");
    } else {
      XB_SPIN(xb_ld(&bar[XB_XGEN(b.x)]) == gen, bar);
      __builtin_amdgcn_fence(__ATOMIC_ACQUIRE, "agent");
      asm volatile("s_waitcnt vmcnt(0)" ::: "memory");
    }
  }
  __syncthreads();
}

struct U4x4 { uint4 a, b, c, d; };
constexpr int GLD = 144;
template <int BM, class AL, class EP>
__device__ __forceinline__ void gemm_tile_t(int m0, int n0, int K, const bfu* __restrict__ Bt, AL al, EP ep, unsigned char* lds) {
  constexpr int BUF = 256 * GLD;
  constexpr int MI = BM / 64;
  const int tid = threadIdx.x, lane = tid & 63, wid = tid >> 6;
  const int wr = wid >> 1, wc = wid & 1;
  const int l31 = lane & 31, lh = lane >> 5;
  f32x16 acc[MI][2];
#pragma unroll
  for (int i = 0; i < MI; ++i)
#pragma unroll
    for (int j = 0; j < 2; ++j)
#pragma unroll
      for (int r = 0; r < 16; ++r) acc[i][j][r] = 0.f;
  const int srow = tid >> 1, sk = (tid & 1) * 32;
  const bool aon = srow < BM;
  uint4 av0, av1, av2, av3, bv0, bv1, bv2, bv3;
  auto gl = [&](int k0) {
    if (BM == 128 || aon) al(m0 + srow, k0 + sk, av0, av1, av2, av3);
    const uint4* bp = (const uint4*)(Bt + (size_t)(n0 + srow) * K + k0 + sk);
    bv0 = bp[0]; bv1 = bp[1]; bv2 = bp[2]; bv3 = bp[3];
  };
  auto st = [&](int buf) {
    uint4* da = (uint4*)(lds + buf * BUF + srow * GLD + sk * 2);
    uint4* db = (uint4*)(lds + buf * BUF + 128 * GLD + srow * GLD + sk * 2);
    if (BM == 128 || aon) { da[0] = av0; da[1] = av1; da[2] = av2; da[3] = av3; }
    db[0] = bv0; db[1] = bv1; db[2] = bv2; db[3] = bv3;
  };
  gl(0);
  __syncthreads();
  st(0);
  if (64 < K) gl(64);
  __syncthreads();
  const int nk = K >> 6;
  for (int kt = 0; kt < nk; ++kt) {
    const unsigned char* ldsA = lds + (kt & 1) * BUF;
    const unsigned char* ldsB = ldsA + 128 * GLD;
    if (kt + 1 < nk) st((kt + 1) & 1);
    if (kt + 2 < nk) gl((kt + 2) * 64);
#pragma unroll
    for (int s = 0; s < 4; ++s) {
      bf16x8 af[MI];
#pragma unroll
      for (int i = 0; i < MI; ++i) af[i] = *(const bf16x8*)(ldsA + (wr * (BM / 2) + i * 32 + l31) * GLD + s * 32 + lh * 16);
      const bf16x8 bf0 = *(const bf16x8*)(ldsB + (wc * 64 + l31) * GLD + s * 32 + lh * 16);
      const bf16x8 bf1 = *(const bf16x8*)(ldsB + (wc * 64 + 32 + l31) * GLD + s * 32 + lh * 16);
#pragma unroll
      for (int i = 0; i < MI; ++i) {
        acc[i][0] = __builtin_amdgcn_mfma_f32_32x32x16_bf16(af[i], bf0, acc[i][0], 0, 0, 0);
        acc[i][1] = __builtin_amdgcn_mfma_f32_32x32x16_bf16(af[i], bf1, acc[i][1], 0, 0, 0);
      }
    }
    __syncthreads();
  }
  {
    float* ct = (float*)lds;
#pragma unroll
    for (int i = 0; i < MI; ++i)
#pragma unroll
      for (int j = 0; j < 2; ++j)
#pragma unroll
        for (int r = 0; r < 16; ++r)
          ct[(wr * (BM / 2) + i * 32 + (r & 3) + 8 * (r >> 2) + 4 * lh) * 132 + wc * 64 + j * 32 + l31] = acc[i][j][r];
    __syncthreads();
#pragma unroll 4
    for (int it = 0; it < BM / 8; ++it) {
      const int idx = it * NT + tid, rl = idx >> 5, c4 = (idx & 31) * 4;
      ep(m0 + rl, n0 + c4, *(const float4*)(ct + rl * 132 + c4));
    }
  }
  __syncthreads();
}
template <class AL, class EP>
__device__ __forceinline__ void gemm_tile(int m0, int n0, int K, const bfu* __restrict__ Bt, AL al, EP ep, unsigned char* lds) {
  gemm_tile_t<128>(m0, n0, K, Bt, al, ep, lds);
}
template <class F128, class F64>
__device__ __forceinline__ void tiles_with_half_tail(int ntn, int tailm, F128 f128, F64 f64) {
  const int full = (136 - tailm) * ntn, total = full + tailm * 2 * ntn;
  for (int t = blockIdx.x; t < total; t += gridDim.x) {
    if (t < full) f128((t / ntn) * 128, (t % ntn) * 128);
    else { const int u = t - full; f64((136 - tailm) * 128 + (u / ntn) * 64, (u % ntn) * 128); }
  }
}

__device__ void phase0(const Params& p, unsigned char* lds) {
  const int tid = threadIdx.x, G = gridDim.x, gtid = blockIdx.x * NT + tid, gsz = G * NT;
  {
    const int lane = tid & 63, l31 = lane & 31, gw = gtid >> 6, nw = gsz >> 6;
    for (int rp = gw; rp < 16384; rp += nw) {
      const int r = rp * 2 + (lane >> 5);
      const bool isv = r >= 16384;
      const int row = r & 16383;
      const float4* src = (const float4*)((isv ? p.pv : p.pu) + (size_t)row * 1024 + l31 * 4);
      float x[32];
#pragma unroll
      for (int i = 0; i < 8; ++i) { const float4 v = src[i * 32]; x[i * 4] = v.x; x[i * 4 + 1] = v.y; x[i * 4 + 2] = v.z; x[i * 4 + 3] = v.w; }
      float m = 0.f;
#pragma unroll
      for (int i = 0; i < 32; ++i) m = fmaxf(m, fabsf(x[i]));
#pragma unroll
      for (int o = 16; o > 0; o >>= 1) m = fmaxf(m, __shfl_xor(m, o));
      {
        const float sc4 = m > 0.f ? 6.f / m : 1.f;
        unsigned wq[4] = {0u, 0u, 0u, 0u};
#pragma unroll
        for (int i = 0; i < 32; ++i) {
          const float a_ = fabsf(x[i]) * sc4;
          const unsigned code = (unsigned)(a_ >= 0.25f) + (unsigned)(a_ >= 0.75f) + (unsigned)(a_ >= 1.25f) + (unsigned)(a_ >= 1.75f) +
                                (unsigned)(a_ >= 2.5f) + (unsigned)(a_ >= 3.5f) + (unsigned)(a_ >= 5.f);
          wq[i >> 3] |= (code | (x[i] < 0.f ? 8u : 0u)) << (4 * (i & 7));
        }
        *(uint4*)((isv ? p.TV : p.TU) + (size_t)row * 512 + l31 * 16) = make_uint4(wq[0], wq[1], wq[2], wq[3]);
        if (l31 == 0) (isv ? p.SV : p.SU)[row] = m > 0.f ? m * (1.f / 6.f) : 1.f;
        continue;
      }
      const float sc = m > 0.f ? 7.5f / m : 1.f;
      unsigned long long w0 = 0ull, w1 = 0ull, w2 = 0ull;
#pragma unroll
      for (int i = 0; i < 32; ++i) {
        const float a_ = fminf(fabsf(x[i]) * sc, 7.5f);
        int code;
        if (a_ < 2.f) code = __float2int_rn(a_ * 8.f);
        else if (a_ < 4.f) code = 8 + __float2int_rn(a_ * 4.f);
        else code = 16 + __float2int_rn(a_ * 2.f);
        code = min(code, 31);
        const unsigned long long c6 = (unsigned long long)((unsigned)code | (x[i] < 0.f ? 32u : 0u));
        const int bit = 6 * i, wi = bit >> 6, sh = bit & 63;
        if (wi == 0) w0 |= c6 << sh; else if (wi == 1) w1 |= c6 << sh; else w2 |= c6 << sh;
        if (sh > 58) { if (wi == 0) w1 |= c6 >> (64 - sh); else if (wi == 1) w2 |= c6 >> (64 - sh); }
      }
      unsigned char* dst = p.TV + (size_t)row * 768;
      *(uint4*)(dst + l31 * 16) = make_uint4((unsigned)w0, (unsigned)(w0 >> 32), (unsigned)w1, (unsigned)(w1 >> 32));
      *(uint2*)(dst + 512 + l31 * 8) = make_uint2((unsigned)w2, (unsigned)(w2 >> 32));
      if (l31 == 0) p.SV[row] = m > 0.f ? m * (1.f / 7.5f) : 1.f;
    }
  }
  for (int i = gtid; i < 65536; i += gsz) { p.K1[i] = f2bf(p.keys1[i]); p.K2[i] = f2bf(p.keys2[i]); }
  {
    auto tr = [&](const float* __restrict__ src, bfu* __restrict__ dst, const int K, const int N) {
      for (int i = gtid; i < N * (K / 8); i += gsz) {
        const int n = i % N, k8 = i / N;
        float v[8];
#pragma unroll
        for (int j = 0; j < 8; ++j) v[j] = src[(size_t)(k8 * 8 + j) * N + n];
        *(uint4*)(dst + (size_t)n * K + k8 * 8) = make_uint4(pk2(v[0], v[1]), pk2(v[2], v[3]), pk2(v[4], v[5]), pk2(v[6], v[7]));
      }
    };
    tr(p.w_in, p.WinT, 1024, 2304);
    tr(p.w_out, p.WoutT, 1024, 1024);
    tr(p.w_q, p.WqT, 1024, 1024);
    tr(p.w_glu, p.WgluT, 512, 512);
    tr(p.w2, p.w2T, 64, 512);
    tr(p.a2, p.a2T, 64, 512);
    tr(p.g2, p.g2T, 128, 512);
  }
  for (int i = gtid; i < 2048; i += gsz) {
    const int g = i >> 6;
    const float dt = expf(p.s5ldt[g]);
    const float lre = p.s5are[i], lim = p.s5aim[i];
    const float mag = expf(lre * dt), ang = lim * dt;
    float sn, cs; sincosf(ang, &sn, &cs);
    const float lbr = mag * cs, lbi = mag * sn;
    p.lbre[i] = lbr; p.lbim[i] = lbi;
    float pr = lbr, pi = lbi;
#pragma unroll
    for (int s = 0; s < 6; ++s) { const float nr = pr * pr - pi * pi, ni = 2.f * pr * pi; pr = nr; pi = ni; }
    p.lbLre[i] = pr; p.lbLim[i] = pi;
    const float den = lre * lre + lim * lim;
    const float nre = lbr - 1.f, nim = lbi;
    const float cr = (nre * lre + nim * lim) / den, ci = (nim * lre - nre * lim) / den;
#pragma unroll
    for (int h = 0; h < 16; ++h) {
      const float br = p.s5bre[i * 16 + h], bi = p.s5bim[i * 16 + h];
      p.BBh[(g * 128 + (i & 63)) * 16 + h] = f2bf(cr * br - ci * bi);
      p.BBh[(g * 128 + 64 + (i & 63)) * 16 + h] = f2bf(cr * bi + ci * br);
    }
  }
  for (int i = gtid; i < 32 * 16 * 64; i += gsz) {
    const int gh = i >> 6, k = i & 63;
    p.CCh[gh * 128 + k] = f2bf(p.s5cre[i]);
    p.CCh[gh * 128 + 64 + k] = f2bf(-p.s5cim[i]);
  }
  {
    bfu* sa = (bfu*)lds;
    const int lane = tid & 63, wid = tid >> 6, l31 = lane & 31, lh = lane >> 5;
    for (int it = blockIdx.x; it < 48 * 8; it += G) {
      const int slab = it >> 3, kp = it & 7;
      __syncthreads();
      for (int i = tid; i < 160 * 128; i += NT) {
        const int r = i >> 7, k = i & 127;
        float v = 0.f;
        if (r < 136) { const float c = r < 8 ? p.cp[r * 1024 + kp * 128 + k] : p.cs[(r - 8) * 1024 + kp * 128 + k]; v = c / (1.f + __expf(-c)); }
        sa[r * 136 + k] = f2bf(v);
      }
      __syncthreads();
      const int n0 = slab * 128 + wid * 32;
      f32x16 acc[5];
#pragma unroll
      for (int m = 0; m < 5; ++m)
#pragma unroll
        for (int r = 0; r < 16; ++r) acc[m][r] = 0.f;
#pragma unroll 2
      for (int ks = 0; ks < 8; ++ks) {
        const float* wp = p.w_ada + (size_t)(kp * 128 + ks * 16 + lh * 8) * 6144 + n0 + l31;
        float bw[8];
#pragma unroll
        for (int j = 0; j < 8; ++j) bw[j] = wp[(size_t)j * 6144];
        bf16x8 bfr;
#pragma unroll
        for (int j = 0; j < 8; ++j) bfr[j] = (short)f2bf(bw[j]);
#pragma unroll
        for (int m = 0; m < 5; ++m) {
          const bf16x8 af = *(const bf16x8*)((const unsigned char*)sa + (m * 32 + l31) * 272 + (ks * 16 + lh * 8) * 2);
          acc[m] = __builtin_amdgcn_mfma_f32_32x32x16_bf16(af, bfr, acc[m], 0, 0, 0);
        }
      }
      const float bb = kp == 0 ? p.b_ada[n0 + l31] : 0.f;
      float* mp = p.mod + (size_t)(4 * lh) * 6144 + n0 + l31;
#pragma unroll
      for (int m = 0; m < 5; ++m) {
#pragma unroll
        for (int r = 0; r < 16; ++r) {
          const int row0 = m * 32 + (r & 3) + 8 * (r >> 2);
          if (row0 + 4 * lh < 136) atomicAdd(mp + row0 * 6144, acc[m][r] + bb);
          if ((r & 3) == 3) __builtin_amdgcn_sched_barrier(0);
        }
      }
    }
    __syncthreads();
  }
}

__device__ void phase1(const Params& p, unsigned char* lds) {
  const int ntile = 136 * 18;
  for (int t = blockIdx.x; t < ntile; t += gridDim.x) {
    const int mt = t / 18, nt = t % 18;
    auto al = [&](int row, int k, uint4& o0, uint4& o1, uint4& o2, uint4& o3) {
      const uint4* s_ = (const uint4*)(p.H1 + (size_t)row * 1024 + k);
      o0 = s_[0]; o1 = s_[1]; o2 = s_[2]; o3 = s_[3];
    };
    auto ep = [&](int row, int col, float4 v) {
      *(uint2*)(p.PJ + (size_t)row * INC + col) = make_uint2(pk2(v.x, v.y), pk2(v.z, v.w));
      if (col >= 512) {
        if (row < NPT) { if ((row & 2047) == 2047) *(float4*)(p.out + O_SH_P + (row >> 11) * RC + col - 512) = v; }
        else { const int r = row - NPT; if ((r & 7) == 7) *(float4*)(p.out + O_SH_S + (r >> 3) * RC + col - 512) = v; }
      }
    };
    gemm_tile(mt * 128, nt * 128, 1024, p.WinT, al, ep, lds);
  }
}

struct Cx { float r, i; };
__device__ __forceinline__ Cx cfma(const Cx a, const Cx b, const Cx c) { Cx o; o.r = a.r * b.r - a.i * b.i + c.r; o.i = a.r * b.i + a.i * b.r + c.i; return o; }
using f32x4 = __attribute__((ext_vector_type(4))) float;
constexpr int HIMG = 272;
template <int MT, bool OUT>
__device__ __forceinline__ void s5_chunk(const Params& p, const int tok0, const int nvalid, const int g, Cx (&st)[2], const int Gend,
                                         unsigned char* himg, const int lane) {
  const int c = lane & 31, half = lane >> 5;
  Cx l1[2], l2[2], l3[2], l4[2];
#pragma unroll
  for (int s = 0; s < 2; ++s) {
    const int gp = g * 64 + 32 * s + c;
    l1[s].r = p.lbre[gp]; l1[s].i = p.lbim[gp];
    const Cx z = {0.f, 0.f};
    l2[s] = cfma(l1[s], l1[s], z); l3[s] = cfma(l2[s], l1[s], z); l4[s] = cfma(l2[s], l2[s], z);
  }
  bf16x8 bfr[4];
#pragma unroll
  for (int nt = 0; nt < 4; ++nt) bfr[nt] = *(const bf16x8*)(p.BBh + ((size_t)(g * 128 + 32 * nt + c)) * 16 + 8 * half);
  bf16x8 cfr[4];
  float dsk = 0.f;
  if (OUT) {
#pragma unroll
    for (int ks = 0; ks < 4; ++ks) cfr[ks] = *(const bf16x8*)(p.CCh + ((size_t)(g * 16 + (lane & 15))) * 128 + 32 * ks + 8 * (lane >> 4));
    dsk = p.s5d[g * 16 + (lane & 15)];
  }
  Cx endst[2] = {st[0], st[1]};
#pragma unroll
  for (int mt = 0; mt < MT; ++mt) {
    bf16x8 af;
#pragma unroll
    for (int j = 0; j < 8; ++j) af[j] = 0;
    if (32 * mt + c < nvalid) af = *(const bf16x8*)(p.PJ + (size_t)(tok0 + 32 * mt + c) * INC + g * 16 + 8 * half);
#pragma unroll
    for (int s = 0; s < 2; ++s) {
      f32x16 bre, bim;
#pragma unroll
      for (int r = 0; r < 16; ++r) { bre[r] = 0.f; bim[r] = 0.f; }
      bre = __builtin_amdgcn_mfma_f32_32x32x16_bf16(af, bfr[s], bre, 0, 0, 0);
      bim = __builtin_amdgcn_mfma_f32_32x32x16_bf16(af, bfr[2 + s], bim, 0, 0, 0);
      Cx e[4], pe[4];
#pragma unroll
      for (int q = 0; q < 4; ++q) {
        Cx x; x.r = bre[4 * q]; x.i = bim[4 * q];
#pragma unroll
        for (int i = 1; i < 4; ++i) { Cx b_; b_.r = bre[4 * q + i]; b_.i = bim[4 * q + i]; x = cfma(l1[s], x, b_); bre[4 * q + i] = x.r; bim[4 * q + i] = x.i; }
        e[q] = x;
      }
#pragma unroll
      for (int q = 0; q < 4; ++q) { pe[q].r = __shfl_xor(e[q].r, 32); pe[q].i = __shfl_xor(e[q].i, 32); }
      Cx carry = st[s];
      Cx cin[4];
#pragma unroll
      for (int q = 0; q < 4; ++q) {
        const Cx ee = half ? pe[q] : e[q];
        const Cx eo = half ? e[q] : pe[q];
        const Cx cin_e = carry;
        carry = cfma(l4[s], carry, ee);
        if (8 * mt + 2 * q == Gend) endst[s] = carry;
        const Cx cin_o = carry;
        carry = cfma(l4[s], carry, eo);
        if (8 * mt + 2 * q + 1 == Gend) endst[s] = carry;
        cin[q] = half ? cin_o : cin_e;
      }
      st[s] = carry;
      if (OUT) {
        bfu* hi16 = (bfu*)himg;
#pragma unroll
        for (int q = 0; q < 4; ++q)
#pragma unroll
          for (int i = 0; i < 4; ++i) {
            const Cx lp = i == 0 ? l1[s] : (i == 1 ? l2[s] : (i == 2 ? l3[s] : l4[s]));
            Cx b_; b_.r = bre[4 * q + i]; b_.i = bim[4 * q + i];
            const Cx h = cfma(lp, cin[q], b_);
            const int tl = i + 8 * q + 4 * half;
            hi16[tl * (HIMG / 2) + 32 * s + c] = f2bf(h.r);
            hi16[tl * (HIMG / 2) + 64 + 32 * s + c] = f2bf(h.i);
          }
      }
    }
    if (OUT) {
      __builtin_amdgcn_wave_barrier();
#pragma unroll
      for (int rt = 0; rt < 2; ++rt) {
        f32x4 acc = {0.f, 0.f, 0.f, 0.f};
#pragma unroll
        for (int ks = 0; ks < 4; ++ks) {
          const bf16x8 a_ = *(const bf16x8*)(himg + (16 * rt + (lane & 15)) * HIMG + (32 * ks + 8 * (lane >> 4)) * 2);
          acc = __builtin_amdgcn_mfma_f32_16x16x32_bf16(a_, cfr[ks], acc, 0, 0, 0);
        }
#pragma unroll
        for (int r = 0; r < 4; ++r) {
          const int t = 32 * mt + 16 * rt + 4 * (lane >> 4) + r;
          if (t < nvalid) {
            const float u = bf2f(p.PJ[(size_t)(tok0 + t) * INC + g * 16 + (lane & 15)]);
            p.Y5[(size_t)(tok0 + t) * 512 + g * 16 + (lane & 15)] = gelu_(acc[r] + dsk * u);
          }
        }
      }
      __builtin_amdgcn_wave_barrier();
    }
  }
  st[0] = endst[0]; st[1] = endst[1];
}
__device__ void s5_pass_a(const Params& p) {
  const int lane = threadIdx.x & 63, gw = (blockIdx.x * NT + threadIdx.x) >> 6, nw = (gridDim.x * NT) >> 6;
  for (int job = gw; job < 8 * 32 * 32; job += nw) {
    const int c = job & 31, g = (job >> 5) & 31, b = job >> 10;
    Cx st[2] = {{0.f, 0.f}, {0.f, 0.f}};
    s5_chunk<2, false>(p, b * 2048 + c * 64, 64, g, st, 15, nullptr, lane);
    if (lane < 32) {
      float* e = p.E + (size_t)job * 128;
      e[lane] = st[0].r; e[32 + lane] = st[1].r; e[64 + lane] = st[0].i; e[96 + lane] = st[1].i;
    }
  }
}
__device__ void s5_job_c(const Params& p, int bj, bool prompt, unsigned char* lds) {
  const int lane = threadIdx.x & 63, wid = threadIdx.x >> 6;
  unsigned char* himg = lds + wid * (32 * HIMG);
  const int job = bj * 4 + wid;
  const int cc = lane & 31;
  if (prompt) {
    const int c = job & 31, g = (job >> 5) & 31, b = job >> 10;
    Cx L64[2], st[2];
#pragma unroll
    for (int s = 0; s < 2; ++s) { const int gp = g * 64 + 32 * s + cc; L64[s].r = p.lbLre[gp]; L64[s].i = p.lbLim[gp]; st[s].r = 0.f; st[s].i = 0.f; }
    const float* e = p.E + (size_t)(job - c) * 128;
    for (int j = 0; j < c; ++j) {
      Cx e0, e1;
      e0.r = e[j * 128 + cc]; e1.r = e[j * 128 + 32 + cc]; e0.i = e[j * 128 + 64 + cc]; e1.i = e[j * 128 + 96 + cc];
      st[0] = cfma(L64[0], st[0], e0); st[1] = cfma(L64[1], st[1], e1);
    }
    s5_chunk<2, true>(p, b * 2048 + c * 64, 64, g, st, 15, himg, lane);
    if (c == 31 && lane < 32) {
      float* o = p.out + O_S5RE_P + (b * 32 + g) * 64;
      o[lane] = st[0].r; o[32 + lane] = st[1].r;
      o = p.out + O_S5IM_P + (b * 32 + g) * 64;
      o[lane] = st[0].i; o[32 + lane] = st[1].i;
    }
  } else {
    const int g = job & 31, bs = job >> 5;
    Cx st[2];
    const float* r0 = p.s5re0 + ((size_t)bs * 32 + g) * 64;
    const float* i0 = p.s5im0 + ((size_t)bs * 32 + g) * 64;
    st[0].r = r0[cc]; st[1].r = r0[32 + cc]; st[0].i = i0[cc]; st[1].i = i0[32 + cc];
    s5_chunk<1, true>(p, NPT + bs * 8, 8, g, st, 1, himg, lane);
    if (lane < 32) {
      float* o = p.out + O_S5RE_S + ((size_t)bs * 32 + g) * 64;
      o[lane] = st[0].r; o[32 + lane] = st[1].r;
      o = p.out + O_S5IM_S + ((size_t)bs * 32 + g) * 64;
      o[lane] = st[0].i; o[32 + lane] = st[1].i;
    }
  }
}

__device__ __forceinline__ float tanh_fast(float x) { const float e = __expf(2.f * x); return 1.f - 2.f / (e + 1.f); }
template <int WHICH>
__device__ void lora_tiles(const Params& p, unsigned char* lds) {
  constexpr int base = WHICH == 0 ? 1536 : (WHICH == 1 ? 1600 : 1664);
  const int G_ = (int)gridDim.x;
  for (int t = (((int)blockIdx.x - WHICH * 544) % G_ + G_) % G_; t < 136 * 4; t += G_) {
    const int mt = t >> 2, nt = t & 3;
    auto al = [&](int row, int k, uint4& o0, uint4& o1, uint4& o2, uint4& o3) {
      const bfu* pc = p.PJ + (size_t)row * INC + 512 + base + k;
      const int tt = t_of(row);
      auto one = [&](int i) -> uint4 {
        const uint4 cu = *(const uint4*)(pc + i * 8);
        const float cur[8] = {bflo(cu.x), bfhi(cu.x), bflo(cu.y), bfhi(cu.y), bflo(cu.z), bfhi(cu.z), bflo(cu.w), bfhi(cu.w)};
        float prv[8];
        if (tt == 0) {
          if (row < NPT) {
#pragma unroll
            for (int j = 0; j < 8; ++j) prv[j] = 0.f;
          } else {
            const float4* s0 = (const float4*)(p.shift0 + (size_t)(sq_of(row) - 8) * RC + base + k + i * 8);
            const float4 a = s0[0], b_ = s0[1];
            prv[0] = a.x; prv[1] = a.y; prv[2] = a.z; prv[3] = a.w; prv[4] = b_.x; prv[5] = b_.y; prv[6] = b_.z; prv[7] = b_.w;
          }
        } else {
          const uint4 pu_ = *(const uint4*)(pc - INC + i * 8);
          prv[0] = bflo(pu_.x); prv[1] = bfhi(pu_.x); prv[2] = bflo(pu_.y); prv[3] = bfhi(pu_.y); prv[4] = bflo(pu_.z); prv[5] = bfhi(pu_.z); prv[6] = bflo(pu_.w); prv[7] = bfhi(pu_.w);
        }
        const float4 m0 = *(const float4*)(p.mu + base + k + i * 8), m1 = *(const float4*)(p.mu + base + k + i * 8 + 4);
        const float mm[8] = {m0.x, m0.y, m0.z, m0.w, m1.x, m1.y, m1.z, m1.w};
        float f[8];
#pragma unroll
        for (int j = 0; j < 8; ++j) {
          const float ps = cur[j] + (prv[j] - cur[j]) * mm[j];
          f[j] = WHICH == 0 ? tanh_fast(ps) : (WHICH == 1 ? ps : sigmoidf_(ps));
        }
        return make_uint4(pk2(f[0], f[1]), pk2(f[2], f[3]), pk2(f[4], f[5]), pk2(f[6], f[7]));
      };
      o0 = one(0); o1 = one(1); o2 = one(2); o3 = one(3);
    };
    auto ep = [&](int row, int col, float4 v4) {
      const size_t o = (size_t)row * 512 + col;
      const float v[4] = {v4.x, v4.y, v4.z, v4.w};
      float f[4];
      if (WHICH == 0) {
        const float4 w0 = *(const float4*)(p.w0 + col);
        const float ww[4] = {w0.x, w0.y, w0.z, w0.w};
#pragma unroll
        for (int j = 0; j < 4; ++j) {
          const float z = -(ww[j] + v[j]);
          const float sp = fmaxf(z, 0.f) + __logf(1.f + __expf(-fabsf(z)));
          f[j] = -__expf(-sp - 0.5f);
        }
        *(uint2*)(p.LD + o) = make_uint2(pk2(f[0], f[1]), pk2(f[2], f[3]));
      } else if (WHICH == 1) {
        const float4 a0 = *(const float4*)(p.a0 + col);
        const float aa[4] = {a0.x, a0.y, a0.z, a0.w};
#pragma unroll
        for (int j = 0; j < 4; ++j) f[j] = sigmoidf_(aa[j] + v[j]);
        *(uint2*)(p.AA + o) = make_uint2(pk2(f[0], f[1]), pk2(f[2], f[3]));
      } else {
        *(uint2*)(p.GG + o) = make_uint2(pk2(v[0], v[1]), pk2(v[2], v[3]));
      }
    };
    gemm_tile(mt * 128, nt * 128, WHICH == 2 ? 128 : 64, WHICH == 0 ? p.w2T : (WHICH == 1 ? p.a2T : p.g2T), al, ep, lds);
  }
}
__device__ void phase2(const Params& p, unsigned char* lds) {
  lora_tiles<0>(p, lds);
  lora_tiles<1>(p, lds);
  lora_tiles<2>(p, lds);
  s5_pass_a(p);
}

template <int CTRL>
__device__ __forceinline__ float dppf(float x) { return __uint_as_float((unsigned)__builtin_amdgcn_update_dpp(0, (int)__float_as_uint(x), CTRL, 0xf, 0xf, true)); }
template <int LPR>
__device__ __forceinline__ float red_lpr(float x) {
  x += dppf<0xB1>(x); x += dppf<0x4E>(x);
  if (LPR == 16) { x += dppf<0x141>(x); x += dppf<0x140>(x); }
  return x;
}
struct RwVec { float4 w, kk, b, k, r; };
template <int LPR, bool PROMPT>
__device__ void rwkv_job(const Params& p, int sq, int h, int rg, unsigned char* lds) {
  constexpr int ROWS = NT / LPR, KPL = 64 / LPR, NV = KPL / 4;
  float* Lr = (float*)lds;
  float* Lw = Lr + 17 * 64;
  float* Lk = Lw + 17 * 64;
  float* Lkk = Lk + 17 * 64;
  float* Lb = Lkk + 17 * 64;
  float* Lv = Lb + 17 * 64;
  float* Lyp0 = Lv + 17 * 64;
  const int tid = threadIdx.x;
  constexpr bool prompt = PROMPT;
  constexpr int T = PROMPT ? 2048 : 8;
  const int tokbase = prompt ? sq * 2048 : NPT + (sq - 8) * 8;
  const int row = tid / LPR, kq = tid % LPR;
  const int grow = rg * ROWS + row;
  float S[KPL];
  if (prompt) {
#pragma unroll
    for (int j = 0; j < KPL; ++j) S[j] = 0.f;
  } else {
    const float* s0 = p.wkv0 + (((size_t)(sq - 8) * 8 + h) * 64 + grow) * 64 + kq * KPL;
#pragma unroll
    for (int j = 0; j < NV; ++j) { const float4 v = ((const float4*)s0)[j]; S[j * 4] = v.x; S[j * 4 + 1] = v.y; S[j * 4 + 2] = v.z; S[j * 4 + 3] = v.w; }
  }
  const int tt = tid >> 4, kg = tid & 15, k4 = kg * 4;
  const int hc = h * 64 + k4;
  float mur[4], muk[4], muv[4], kkc[4], kac[4], rkc[4];
#pragma unroll
  for (int j = 0; j < 4; ++j) {
    mur[j] = p.mu[hc + j]; muk[j] = p.mu[512 + hc + j]; muv[j] = p.mu[1024 + hc + j];
    kkc[j] = p.k_k[hc + j]; kac[j] = p.k_a[hc + j]; rkc[j] = p.r_k[hc + j];
  }
  uint2 Acr, Ack, Acv, Aqr, Aqk, Aqv, Ald, Aaa;
  uint2 Bcr, Bck, Bcv, Bqr, Bqk, Bqv, Bld, Baa;
  auto gload = [&](int c0, uint2& cr, uint2& ck, uint2& cv, uint2& qr, uint2& qk, uint2& qv, uint2& ldv, uint2& aav) {
    const int cc0 = PROMPT ? min(c0, T - 16) : 0;
    const int nst = PROMPT ? 16 : 8;
    const int t = cc0 + (tt < nst ? tt : 0);
    const int tok = tokbase + t;
    const bfu* pc = p.PJ + (size_t)tok * INC + 512 + hc;
    const bfu* pp = pc - (t > 0 ? INC : 0);
    cr = *(const uint2*)(pc); ck = *(const uint2*)(pc + 512); cv = *(const uint2*)(pc + 1024);
    qr = *(const uint2*)(pp); qk = *(const uint2*)(pp + 512); qv = *(const uint2*)(pp + 1024);
    ldv = *(const uint2*)(p.LD + (size_t)tok * 512 + hc);
    aav = *(const uint2*)(p.AA + (size_t)tok * 512 + hc);
  };
  auto store_y = [&](int c0, const float* Lyp) {
    constexpr int nst = PROMPT ? 16 : 8;
    for (int i = tid; i < nst * ROWS; i += NT) {
      const int s = i / ROWS, rr = i % ROWS;
      const float4* yp = (const float4*)(Lyp + (size_t)i * LPR);
      float y = 0.f;
#pragma unroll
      for (int j = 0; j < LPR / 4; ++j) { const float4 v = yp[j]; y += (v.x + v.y) + (v.z + v.w); }
      p.out[(size_t)(tokbase + c0 + s) * 1024 + 512 + h * 64 + rg * ROWS + rr] = y;
    }
  };
  auto process = [&](int c0, int par, uint2& cr, uint2& ck, uint2& cv, uint2& qr, uint2& qk, uint2& qv, uint2& ldv, uint2& aav) {
    float* Lyp = Lyp0 + par * (16 * NT);
    constexpr int nst = PROMPT ? 16 : 8;
    const bool act = PROMPT ? true : (tt < nst);
    const int t = c0 + (act ? tt : 0);
    const int tok = tokbase + t;
    {
      float pr[4], pk_[4], pv_[4];
      if (t == 0) {
        if (prompt) {
#pragma unroll
          for (int j = 0; j < 4; ++j) pr[j] = pk_[j] = pv_[j] = 0.f;
        } else {
          const float* s0 = p.shift0 + (size_t)(sq - 8) * RC + hc;
#pragma unroll
          for (int j = 0; j < 4; ++j) { pr[j] = s0[j]; pk_[j] = s0[512 + j]; pv_[j] = s0[1024 + j]; }
        }
      } else {
        pr[0] = bflo(qr.x); pr[1] = bfhi(qr.x); pr[2] = bflo(qr.y); pr[3] = bfhi(qr.y);
        pk_[0] = bflo(qk.x); pk_[1] = bfhi(qk.x); pk_[2] = bflo(qk.y); pk_[3] = bfhi(qk.y);
        pv_[0] = bflo(qv.x); pv_[1] = bfhi(qv.x); pv_[2] = bflo(qv.y); pv_[3] = bfhi(qv.y);
      }
      const float c_r[4] = {bflo(cr.x), bfhi(cr.x), bflo(cr.y), bfhi(cr.y)};
      const float c_k[4] = {bflo(ck.x), bfhi(ck.x), bflo(ck.y), bfhi(ck.y)};
      const float c_v[4] = {bflo(cv.x), bfhi(cv.x), bflo(cv.y), bfhi(cv.y)};
      const float ld4[4] = {bflo(ldv.x), bfhi(ldv.x), bflo(ldv.y), bfhi(ldv.y)};
      const float aa4[4] = {bflo(aav.x), bfhi(aav.x), bflo(aav.y), bfhi(aav.y)};
      float r4[4], kx4[4], v4[4], w4[4], kk4[4];
      float ssq = 0.f, bon = 0.f;
#pragma unroll
      for (int j = 0; j < 4; ++j) {
        r4[j] = c_r[j] + (pr[j] - c_r[j]) * mur[j];
        const float kx = c_k[j] + (pk_[j] - c_k[j]) * muk[j];
        v4[j] = c_v[j] + (pv_[j] - c_v[j]) * muv[j];
        w4[j] = __expf(ld4[j]);
        kk4[j] = kx * kkc[j];
        ssq += kk4[j] * kk4[j];
        kx4[j] = kx * (1.f + (aa4[j] - 1.f) * kac[j]);
        bon += r4[j] * kx4[j] * rkc[j];
      }
      ssq = red_lpr<16>(ssq); bon = red_lpr<16>(bon);
      const float inv = rsqrtf(fmaxf(ssq, 1e-24f));
      __syncthreads();
      if (act) {
        *(float4*)(Lr + tt * 64 + k4) = make_float4(r4[0], r4[1], r4[2], r4[3]);
        *(float4*)(Lw + tt * 64 + k4) = make_float4(w4[0], w4[1], w4[2], w4[3]);
        *(float4*)(Lk + tt * 64 + k4) = make_float4(kx4[0], kx4[1], kx4[2], kx4[3]);
        *(float4*)(Lkk + tt * 64 + k4) = make_float4(kk4[0] * inv, kk4[1] * inv, kk4[2] * inv, kk4[3] * inv);
        *(float4*)(Lb + tt * 64 + k4) = make_float4(kk4[0] * inv * aa4[0], kk4[1] * inv * aa4[1], kk4[2] * inv * aa4[2], kk4[3] * inv * aa4[3]);
        *(float4*)(Lv + tt * 64 + k4) = make_float4(v4[0], v4[1], v4[2], v4[3]);
        (rg == 0 ? p.BON : p.BONX)[(size_t)tok * 8 + h] = bon;
      }
    }
    __syncthreads();
    if (PROMPT) store_y(max(c0 - 16, 0), Lyp0 + (par ^ 1) * (16 * NT));
    gload(c0 + 32, cr, ck, cv, qr, qk, qv, ldv, aav);
    {
      auto ldvec = [&](int s, int j) -> RwVec {
        RwVec v;
        const int o = s * 64 + kq * KPL + j * 4;
        v.w = *(const float4*)(Lw + o); v.kk = *(const float4*)(Lkk + o); v.b = *(const float4*)(Lb + o);
        v.k = *(const float4*)(Lk + o); v.r = *(const float4*)(Lr + o);
        return v;
      };
      RwVec cur[NV];
      float vcur;
#pragma unroll
      for (int j = 0; j < NV; ++j) cur[j] = ldvec(0, j);
      vcur = Lv[grow];
      for (int s = 0; s < nst; ++s) {
        RwVec nxt[NV];
        float vnx;
#pragma unroll
        for (int j = 0; j < NV; ++j) nxt[j] = ldvec(s + 1, j);
        vnx = Lv[(s + 1) * 64 + grow];
        float sa0 = 0.f, sa1 = 0.f;
#pragma unroll
        for (int j = 0; j < NV; ++j) {
          sa0 += S[j * 4] * cur[j].kk.x; sa1 += S[j * 4 + 1] * cur[j].kk.y;
          sa0 += S[j * 4 + 2] * cur[j].kk.z; sa1 += S[j * 4 + 3] * cur[j].kk.w;
        }
        float tq[KPL];
#pragma unroll
        for (int j = 0; j < NV; ++j) {
          tq[j * 4] = S[j * 4] * cur[j].w.x + vcur * cur[j].k.x;
          tq[j * 4 + 1] = S[j * 4 + 1] * cur[j].w.y + vcur * cur[j].k.y;
          tq[j * 4 + 2] = S[j * 4 + 2] * cur[j].w.z + vcur * cur[j].k.z;
          tq[j * 4 + 3] = S[j * 4 + 3] * cur[j].w.w + vcur * cur[j].k.w;
        }
        float sa = -red_lpr<LPR>(sa0 + sa1);
        float y0 = 0.f, y1 = 0.f;
#pragma unroll
        for (int j = 0; j < NV; ++j) {
          S[j * 4] = tq[j * 4] + sa * cur[j].b.x;
          S[j * 4 + 1] = tq[j * 4 + 1] + sa * cur[j].b.y;
          S[j * 4 + 2] = tq[j * 4 + 2] + sa * cur[j].b.z;
          S[j * 4 + 3] = tq[j * 4 + 3] + sa * cur[j].b.w;
          y0 += S[j * 4] * cur[j].r.x; y1 += S[j * 4 + 1] * cur[j].r.y;
          y0 += S[j * 4 + 2] * cur[j].r.z; y1 += S[j * 4 + 3] * cur[j].r.w;
        }
        Lyp[(s * ROWS + row) * LPR + kq] = y0 + y1;
#pragma unroll
        for (int j = 0; j < NV; ++j) cur[j] = nxt[j];
        vcur = vnx;
      }
    }
  };
  gload(0, Acr, Ack, Acv, Aqr, Aqk, Aqv, Ald, Aaa);
  gload(16, Bcr, Bck, Bcv, Bqr, Bqk, Bqv, Bld, Baa);
  for (int c0 = 0; c0 < T; c0 += 32) {
    process(c0, 0, Acr, Ack, Acv, Aqr, Aqk, Aqv, Ald, Aaa);
    if (PROMPT) process(c0 + 16, 1, Bcr, Bck, Bcv, Bqr, Bqk, Bqv, Bld, Baa);
  }
  __syncthreads();
  {
    const int lastc = ((T - 1) >> 4) << 4;
    store_y(lastc, Lyp0 + ((lastc >> 4) & 1) * (16 * NT));
  }
  {
    float* so = p.out + (prompt ? O_WKV_P + (((size_t)sq * 8 + h) * 64 + grow) * 64 : O_WKV_S + (((size_t)(sq - 8) * 8 + h) * 64 + grow) * 64) + kq * KPL;
#pragma unroll
    for (int j = 0; j < NV; ++j) ((float4*)so)[j] = make_float4(S[j * 4], S[j * 4 + 1], S[j * 4 + 2], S[j * 4 + 3]);
  }
  __syncthreads();
}
__device__ void rwkv_post(const Params& p) {
  const int tid = threadIdx.x;
  const int h = (tid >> 4) & 7, kg = tid & 15, k4 = kg * 4, hc = h * 64 + k4;
  float muv[4], gnw[4], gnb[4];
#pragma unroll
  for (int j = 0; j < 4; ++j) { muv[j] = p.mu[1024 + hc + j]; gnw[j] = p.gn_w[hc + j]; gnb[j] = p.gn_b[hc + j]; }
  for (int it = blockIdx.x; it < NTOK / 2; it += gridDim.x) {
    const int tok = it * 2 + (tid >> 7);
    const int t = t_of(tok);
    const bfu* pc = p.PJ + (size_t)tok * INC + 512 + 1024 + hc;
    const uint2 cv = *(const uint2*)pc;
    float pv_[4];
    if (t == 0) {
      if (tok < NPT) { pv_[0] = pv_[1] = pv_[2] = pv_[3] = 0.f; }
      else { const float* s0 = p.shift0 + (size_t)(sq_of(tok) - 8) * RC + 1024 + hc; pv_[0] = s0[0]; pv_[1] = s0[1]; pv_[2] = s0[2]; pv_[3] = s0[3]; }
    } else {
      const uint2 qv = *(const uint2*)(pc - INC);
      pv_[0] = bflo(qv.x); pv_[1] = bfhi(qv.x); pv_[2] = bflo(qv.y); pv_[3] = bfhi(qv.y);
    }
    const float c_v[4] = {bflo(cv.x), bfhi(cv.x), bflo(cv.y), bfhi(cv.y)};
    float* yp = p.out + (size_t)tok * 1024 + 512 + hc;
    const float4 y4 = *(const float4*)yp;
    const float mean = red_lpr<16>(y4.x + y4.y + y4.z + y4.w) * (1.f / 64.f);
    const float dd[4] = {y4.x - mean, y4.y - mean, y4.z - mean, y4.w - mean};
    const float rstd = rsqrtf(red_lpr<16>(dd[0] * dd[0] + dd[1] * dd[1] + dd[2] * dd[2] + dd[3] * dd[3]) * (1.f / 64.f) + GN_EPS);
    const float bon = p.BON[(size_t)tok * 8 + h];
    const uint2 gv = *(const uint2*)(p.GG + (size_t)tok * 512 + hc);
    const float g4[4] = {bflo(gv.x), bfhi(gv.x), bflo(gv.y), bfhi(gv.y)};
    float o4[4];
#pragma unroll
    for (int j = 0; j < 4; ++j) {
      const float v = c_v[j] + (pv_[j] - c_v[j]) * muv[j];
      o4[j] = (dd[j] * rstd * gnw[j] + gnb[j] + bon * v) * g4[j];
    }
    *(uint2*)(p.CAT + (size_t)tok * 1024 + 512 + hc) = make_uint2(pk2(o4[0], o4[1]), pk2(o4[2], o4[3]));
  }
}

#ifndef P3MODE
#define P3MODE 0
#endif
__device__ void phase3(const Params& p, unsigned char* lds, int cw = 0, int mode = 0) {
  volatile int* jb = (volatile int*)(lds + LDS_JOB);
  for (;;) {
    __syncthreads();
    if (threadIdx.x == 0) *jb = (int)atomicAdd(&p.bar[cw], 1u);
    __syncthreads();
    const int j = *jb;
    if (j >= 256) break;
    if (mode != 1) rwkv_job<16, true>(p, j >> 5, (j >> 2) & 7, j & 3, lds);
  }
  for (;;) {
    __syncthreads();
    if (threadIdx.x == 0) *jb = (int)atomicAdd(&p.bar[cw + 1], 1u);
    __syncthreads();
    const int j = *jb;
    if (j >= 4096) break;
    if (j < 2048) { if (mode != 2) s5_job_c(p, j, true, lds); }
    else if (j < 3072) { const int q = j - 2048; if (mode != 1) rwkv_job<4, false>(p, 8 + (q >> 3), q & 7, 0, lds); }
    else { if (mode != 2) s5_job_c(p, j - 3072, false, lds); }
  }
}

__device__ void phase4a(const Params& p, unsigned char* lds) {
  rwkv_post(p);
  {
    auto al = [&](int row, int k, uint4& o0, uint4& o1, uint4& o2, uint4& o3) {
      const float4* s = (const float4*)(p.Y5 + (size_t)row * 512 + k);
      auto one = [&](int i) -> uint4 { const float4 a = s[i * 2], b = s[i * 2 + 1]; return make_uint4(pk2(a.x, a.y), pk2(a.z, a.w), pk2(b.x, b.y), pk2(b.z, b.w)); };
      o0 = one(0); o1 = one(1); o2 = one(2); o3 = one(3);
    };
    auto ep = [&](int row, int col, float4 v) {
      const float4 y = *(const float4*)(p.Y5 + (size_t)row * 512 + col), bg = *(const float4*)(p.b_glu + col);
      *(uint2*)(p.CAT + (size_t)row * 1024 + col) = make_uint2(pk2(y.x * sigmoidf_(v.x + bg.x), y.y * sigmoidf_(v.y + bg.y)), pk2(y.z * sigmoidf_(v.z + bg.z), y.w * sigmoidf_(v.w + bg.w)));
    };
    tiles_with_half_tail(4, 8, [&](int m0, int n0) { gemm_tile_t<128>(m0, n0, 512, p.WgluT, al, ep, lds); },
                         [&](int m0, int n0) { gemm_tile_t<64>(m0, n0, 512, p.WgluT, al, ep, lds); });
  }
}
__device__ void phase4b(const Params& p, unsigned char* lds) {
  auto al = [&](int row, int k, uint4& o0, uint4& o1, uint4& o2, uint4& o3) {
    const uint4* s_ = (const uint4*)(p.CAT + (size_t)row * 1024 + k);
    o0 = s_[0]; o1 = s_[1]; o2 = s_[2]; o3 = s_[3];
  };
  auto ep = [&](int row, int col, float4 v) {
    const int sq = sq_of(row);
    const float4 x = *(const float4*)(xrow(p, row) + col), g = *(const float4*)(p.mod + (size_t)sq * 6144 + 2048 + col);
    *(float4*)(p.X1 + (size_t)row * 1024 + col) = make_float4(x.x + g.x * v.x, x.y + g.y * v.y, x.z + g.z * v.z, x.w + g.w * v.w);
  };
  tiles_with_half_tail(8, 8, [&](int m0, int n0) { gemm_tile_t<128>(m0, n0, 1024, p.WoutT, al, ep, lds); },
                       [&](int m0, int n0) { gemm_tile_t<64>(m0, n0, 1024, p.WoutT, al, ep, lds); });
}
template <bool FROMX>
__device__ void norm_rows(const Params& p, const float* __restrict__ gsrc, int sh_off, bfu* __restrict__ dst) {
  const int lane = threadIdx.x & 63, gw = (blockIdx.x * NT + threadIdx.x) >> 6, nw = (gridDim.x * NT) >> 6;
  for (int tok = gw; tok < NTOK; tok += nw) {
    const float* xr = FROMX ? xrow(p, tok) : p.X1 + (size_t)tok * 1024;
    const float* md = p.mod + (size_t)sq_of(tok) * 6144 + sh_off;
    float4 v[4];
    float s = 0.f;
#pragma unroll
    for (int i = 0; i < 4; ++i) { const float4 a = *(const float4*)(xr + lane * 16 + i * 4); v[i] = a; s += a.x * a.x + a.y * a.y + a.z * a.z + a.w * a.w; }
#pragma unroll
    for (int o = 32; o > 0; o >>= 1) s += __shfl_xor(s, o);
    const float rs = rsqrtf(s * (1.f / 1024.f) + NORM_EPS);
    float f[16];
#pragma unroll
    for (int i = 0; i < 4; ++i) {
      const int k = lane * 16 + i * 4;
      const float4 g4 = *(const float4*)(gsrc + k), sh = *(const float4*)(md + k), sc = *(const float4*)(md + 1024 + k);
      const float4 a = v[i];
      f[i * 4 + 0] = a.x * rs * g4.x * (1.f + sc.x) + sh.x;
      f[i * 4 + 1] = a.y * rs * g4.y * (1.f + sc.y) + sh.y;
      f[i * 4 + 2] = a.z * rs * g4.z * (1.f + sc.z) + sh.z;
      f[i * 4 + 3] = a.w * rs * g4.w * (1.f + sc.w) + sh.w;
    }
    uint4* d = (uint4*)(dst + (size_t)tok * 1024 + lane * 16);
    d[0] = make_uint4(pk2(f[0], f[1]), pk2(f[2], f[3]), pk2(f[4], f[5]), pk2(f[6], f[7]));
    d[1] = make_uint4(pk2(f[8], f[9]), pk2(f[10], f[11]), pk2(f[12], f[13]), pk2(f[14], f[15]));
  }
}
__device__ void phase0b(const Params& p) { norm_rows<true>(p, p.n1g, 0, p.H1); }
__device__ void phase5a(const Params& p) { norm_rows<false>(p, p.n2g, 3072, p.H2); }
__device__ void phase5b(const Params& p, unsigned char* lds) {
  auto al = [&](int row, int k, uint4& o0, uint4& o1, uint4& o2, uint4& o3) {
    const uint4* s = (const uint4*)(p.H2 + (size_t)row * 1024 + k);
    o0 = s[0]; o1 = s[1]; o2 = s[2]; o3 = s[3];
  };
  auto ep = [&](int row, int col, float4 v) { *(uint2*)(p.Q + (size_t)row * 1024 + col) = make_uint2(pk2(v.x, v.y), pk2(v.z, v.w)); };
  tiles_with_half_tail(8, 8, [&](int m0, int n0) { gemm_tile_t<128>(m0, n0, 1024, p.WqT, al, ep, lds); },
                       [&](int m0, int n0) { gemm_tile_t<64>(m0, n0, 1024, p.WqT, al, ep, lds); });
}

__device__ __forceinline__ void ins16(float (&L)[16], float x) {
#pragma unroll
  for (int j = 0; j < 16; ++j) { const float hi = fmaxf(L[j], x); x = fminf(L[j], x); L[j] = hi; }
}
__device__ __forceinline__ void ce_desc(float& a, float& b) { const float hi = fmaxf(a, b), lo = fminf(a, b); a = hi; b = lo; }
__device__ __forceinline__ void sort16_desc(float (&a)[16]) {
#pragma unroll
  for (int k = 2; k <= 16; k <<= 1)
#pragma unroll
    for (int j = k >> 1; j > 0; j >>= 1)
#pragma unroll
      for (int i = 0; i < 16; ++i) {
        const int l = i ^ j;
        if (l > i) {
          if ((i & k) == 0) ce_desc(a[i], a[l]);
          else ce_desc(a[l], a[i]);
        }
      }
}
__device__ __forceinline__ void merge16_desc(float (&L)[16], const float (&T)[16]) {
#pragma unroll
  for (int i = 0; i < 16; ++i) L[i] = fmaxf(L[i], T[15 - i]);
#pragma unroll
  for (int j = 8; j > 0; j >>= 1)
#pragma unroll
    for (int i = 0; i < 16; ++i) { const int l = i ^ j; if (l > i) ce_desc(L[i], L[l]); }
}
__device__ __forceinline__ void peer_side_top16(const Params& p, const bfu* __restrict__ keys, int tok, int h, int side, int lane, float (&L)[16]) {
  const int l31 = lane & 31, lh = lane >> 5;
  bf16x8 bq[4];
#pragma unroll
  for (int ks = 0; ks < 4; ++ks) bq[ks] = *(const bf16x8*)(p.Q + (size_t)tok * 1024 + h * 128 + side * 64 + ks * 16 + lh * 8);
#pragma unroll
  for (int nt = 0; nt < 4; ++nt) {
    f32x16 acc;
#pragma unroll
    for (int r = 0; r < 16; ++r) acc[r] = 0.f;
#pragma unroll
    for (int ks = 0; ks < 4; ++ks) {
      const bf16x8 ak = *(const bf16x8*)(keys + ((size_t)(h * 128 + nt * 32 + l31)) * 64 + ks * 16 + lh * 8);
      acc = __builtin_amdgcn_mfma_f32_32x32x16_bf16(ak, bq[ks], acc, 0, 0, 0);
    }
    float V[16];
#pragma unroll
    for (int r = 0; r < 16; ++r) {
      const unsigned n = (unsigned)(nt * 32 + (r & 3) + 8 * (r >> 2)) + 4u * (unsigned)lh;
      V[r] = __uint_as_float((__float_as_uint(acc[r]) & ~127u) | n);
    }
    sort16_desc(V);
    if (nt == 0) {
#pragma unroll
      for (int j = 0; j < 16; ++j) L[j] = V[j];
    } else merge16_desc(L, V);
  }
  float P[16];
#pragma unroll
  for (int j = 0; j < 16; ++j) P[j] = __shfl_xor(L[j], 32);
  merge16_desc(L, P);
}
__device__ void phase6(const Params& p, unsigned char* lds) {
  const int tid = threadIdx.x, lane = tid & 63, wid = tid >> 6;
  unsigned char* ib = lds + wid * (64 * 36);
  const int gw = (blockIdx.x * NT + tid) >> 6, nw = (gridDim.x * NT) >> 6;
  for (int job = gw; job < (NTOK / 32) * 8; job += nw) {
    const int tile = job >> 3, h = job & 7;
    const int tok = tile * 32 + (lane & 31);
    float L1[16], L2[16];
    peer_side_top16(p, p.K1, tok, h, 0, lane, L1);
    peer_side_top16(p, p.K2, tok, h, 1, lane, L2);
    {
      unsigned* iw = (unsigned*)(ib + lane * 36);
#pragma unroll
      for (int q = 0; q < 4; ++q) {
        iw[q] = (__float_as_uint(L1[q * 4]) & 127u) | ((__float_as_uint(L1[q * 4 + 1]) & 127u) << 8) | ((__float_as_uint(L1[q * 4 + 2]) & 127u) << 16) | ((__float_as_uint(L1[q * 4 + 3]) & 127u) << 24);
        iw[4 + q] = (__float_as_uint(L2[q * 4]) & 127u) | ((__float_as_uint(L2[q * 4 + 1]) & 127u) << 8) | ((__float_as_uint(L2[q * 4 + 2]) & 127u) << 16) | ((__float_as_uint(L2[q * 4 + 3]) & 127u) << 24);
      }
    }
    float C[16];
    {
      auto cand = [&](int i, int j) -> float {
        const float v = __uint_as_float(__float_as_uint(L1[i]) & ~127u) + __uint_as_float(__float_as_uint(L2[j]) & ~127u);
        return __uint_as_float((__float_as_uint(v) & ~255u) | (unsigned)(i * 16 + j));
      };
      float R[16];
#pragma unroll
      for (int j = 0; j < 16; ++j) { C[j] = cand(0, j); R[j] = j < 8 ? cand(1, j) : -3.0e38f; }
      merge16_desc(C, R);
      R[0] = cand(2, 0); R[1] = cand(2, 1); R[2] = cand(2, 2); R[3] = cand(2, 3); R[4] = cand(2, 4);
      R[5] = cand(3, 0); R[6] = cand(3, 1); R[7] = cand(3, 2); R[8] = cand(3, 3);
      R[9] = cand(4, 0); R[10] = cand(4, 1); R[11] = cand(4, 2);
      R[12] = cand(5, 0); R[13] = cand(5, 1); R[14] = cand(6, 0); R[15] = cand(6, 1);
      sort16_desc(R);
      merge16_desc(C, R);
      R[0] = cand(7, 0); R[1] = cand(7, 1);
#pragma unroll
      for (int i = 8; i < 16; ++i) R[i - 6] = cand(i, 0);
#pragma unroll
      for (int j = 10; j < 16; ++j) R[j] = -3.0e38f;
      sort16_desc(R);
      merge16_desc(C, R);
    }
    __builtin_amdgcn_wave_barrier();
    const float m = __uint_as_float(__float_as_uint(C[0]) & ~255u);
    float e[16], sum = 0.f;
    unsigned idx[16];
#pragma unroll
    for (int j = 0; j < 16; ++j) {
      const unsigned cb = __float_as_uint(C[j]);
      e[j] = __expf(__uint_as_float(cb & ~255u) - m);
      sum += e[j];
      const unsigned i1 = ib[lane * 36 + ((cb >> 4) & 15u)], i2 = ib[lane * 36 + 16 + (cb & 15u)];
      idx[j] = i1 * 128u + i2;
    }
    const float inv = 1.f / sum;
    if (lane < 32) {
      uint4* eo = (uint4*)(p.EI + (size_t)tok * 128 + h * 16);
      float4* go = (float4*)(p.EG + (size_t)tok * 128 + h * 16);
#pragma unroll
      for (int q = 0; q < 4; ++q) {
        eo[q] = make_uint4(idx[q * 4], idx[q * 4 + 1], idx[q * 4 + 2], idx[q * 4 + 3]);
        go[q] = make_float4(e[q * 4] * inv, e[q * 4 + 1] * inv, e[q * 4 + 2] * inv, e[q * 4 + 3] * inv);
      }
    }
    __builtin_amdgcn_wave_barrier();
  }
}

typedef float v32f __attribute__((ext_vector_type(32)));
typedef float v2f __attribute__((ext_vector_type(2)));
typedef unsigned v6u __attribute__((ext_vector_type(6)));
typedef __bf16 v2bf __attribute__((ext_vector_type(2)));
typedef __bf16 v32bf __attribute__((ext_vector_type(32)));
__device__ __forceinline__ v32f unpack_fp6(const uint4 a, const uint2 b) {
  v6u w; w[0] = a.x; w[1] = a.y; w[2] = a.z; w[3] = a.w; w[4] = b.x; w[5] = b.y;
  return __builtin_amdgcn_cvt_scalef32_pk32_f32_fp6(w, 1.0f);
}
__device__ void phase7(const Params& p) {
  const int lane = threadIdx.x & 63, l31 = lane & 31, half = lane >> 5;
  const int gw = (blockIdx.x * NT + threadIdx.x) >> 6, nw = (gridDim.x * NT) >> 6;
  for (int tok = gw; tok < NTOK; tok += nw) {
    unsigned hp16[16];
    {
      const uint2* hp = (const uint2*)(p.H2 + (size_t)tok * 1024 + l31 * 4);
#pragma unroll
      for (int i = 0; i < 8; ++i) { const uint2 a = hp[i * 32]; hp16[i * 2] = a.x; hp16[i * 2 + 1] = a.y; }
    }
    const unsigned ei0 = p.EI[(size_t)tok * 128 + lane] & 16383u, ei1 = p.EI[(size_t)tok * 128 + 64 + lane] & 16383u;
    const float eg0 = p.EG[(size_t)tok * 128 + lane] * p.SV[ei0], eg1 = p.EG[(size_t)tok * 128 + 64 + lane] * p.SV[ei1];
    const float su0 = p.SU[ei0], su1 = p.SU[ei1];
    float ff[32];
#pragma unroll
    for (int j = 0; j < 32; ++j) ff[j] = 0.f;
#pragma unroll 1
    for (int grp = 0; grp < 16; ++grp) {
      const unsigned eiv = grp < 8 ? ei0 : ei1;
      const float egv = grp < 8 ? eg0 : eg1;
      const float suv = grp < 8 ? su0 : su1;
      const int lb = (grp & 7) * 8;
      uint4 ua[4], va[4];
#pragma unroll
      for (int i = 0; i < 4; ++i) {
        const unsigned id = (unsigned)__shfl((int)eiv, lb + 2 * i + half);
        const unsigned char* ur = p.TU + (size_t)id * 512;
        const unsigned char* vr = p.TV + (size_t)id * 512;
        ua[i] = *(const uint4*)(ur + l31 * 16);
        va[i] = *(const uint4*)(vr + l31 * 16);
      }
      float part[4];
#pragma unroll
      for (int i = 0; i < 4; ++i) {
        const unsigned wq[4] = {ua[i].x, ua[i].y, ua[i].z, ua[i].w};
        float s0 = 0.f, s1 = 0.f;
#pragma unroll
        for (int d = 0; d < 4; ++d) {
          s0 = __builtin_amdgcn_fdot2_f32_bf16(__builtin_amdgcn_cvt_scalef32_pk_bf16_fp4(wq[d], 1.0f, 0), __builtin_bit_cast(v2bf, hp16[d * 4 + 0]), s0, false);
          s1 = __builtin_amdgcn_fdot2_f32_bf16(__builtin_amdgcn_cvt_scalef32_pk_bf16_fp4(wq[d], 1.0f, 1), __builtin_bit_cast(v2bf, hp16[d * 4 + 1]), s1, false);
          s0 = __builtin_amdgcn_fdot2_f32_bf16(__builtin_amdgcn_cvt_scalef32_pk_bf16_fp4(wq[d], 1.0f, 2), __builtin_bit_cast(v2bf, hp16[d * 4 + 2]), s0, false);
          s1 = __builtin_amdgcn_fdot2_f32_bf16(__builtin_amdgcn_cvt_scalef32_pk_bf16_fp4(wq[d], 1.0f, 3), __builtin_bit_cast(v2bf, hp16[d * 4 + 3]), s1, false);
        }
        part[i] = s0 + s1;
        __builtin_amdgcn_sched_barrier(0);
      }
      float r2[2], r1;
      {
        const bool h4 = lane & 16;
#pragma unroll
        for (int i = 0; i < 2; ++i) { const float keep = h4 ? part[i + 2] : part[i], send = h4 ? part[i] : part[i + 2]; r2[i] = keep + __shfl_xor(send, 16); }
        const bool h3 = lane & 8;
        { const float keep = h3 ? r2[1] : r2[0], send = h3 ? r2[0] : r2[1]; r1 = keep + __shfl_xor(send, 8); }
        r1 += dppf<0x141>(r1); r1 += dppf<0x4E>(r1); r1 += dppf<0xB1>(r1);
      }
      const int myI = ((lane >> 4) & 1) * 2 + ((lane >> 3) & 1);
      const int slot = lb + 2 * myI + half;
      const float gate = __shfl(egv, slot), su = __shfl(suv, slot);
      const float coef = gate * gelu_(r1 * su);
#pragma unroll
      for (int i = 0; i < 4; ++i) {
        const float c = __shfl(coef, (lane & 32) + ((i >> 1) & 1) * 16 + (i & 1) * 8);
        const unsigned wv[4] = {va[i].x, va[i].y, va[i].z, va[i].w};
#pragma unroll
        for (int d = 0; d < 4; ++d) {
          const v2f v0 = __builtin_amdgcn_cvt_scalef32_pk_f32_fp4(wv[d], 1.0f, 0);
          const v2f v1 = __builtin_amdgcn_cvt_scalef32_pk_f32_fp4(wv[d], 1.0f, 1);
          const v2f v2 = __builtin_amdgcn_cvt_scalef32_pk_f32_fp4(wv[d], 1.0f, 2);
          const v2f v3 = __builtin_amdgcn_cvt_scalef32_pk_f32_fp4(wv[d], 1.0f, 3);
          ff[d * 8 + 0] += c * v0[0]; ff[d * 8 + 1] += c * v0[1]; ff[d * 8 + 2] += c * v1[0]; ff[d * 8 + 3] += c * v1[1];
          ff[d * 8 + 4] += c * v2[0]; ff[d * 8 + 5] += c * v2[1]; ff[d * 8 + 6] += c * v3[0]; ff[d * 8 + 7] += c * v3[1];
        }
        __builtin_amdgcn_sched_barrier(0);
      }
    }
    float fs[16];
#pragma unroll
    for (int j = 0; j < 16; ++j) {
      const float mine = half ? ff[16 + j] : ff[j], other = half ? ff[j] : ff[16 + j];
      fs[j] = mine + __shfl_xor(other, 32);
    }
    const int k0 = half * 512 + l31 * 4;
    const float* x1 = p.X1 + (size_t)tok * 1024 + k0;
    const float* ga = p.mod + (size_t)sq_of(tok) * 6144 + 5120 + k0;
    float xf[16];
    float s = 0.f;
#pragma unroll
    for (int i = 0; i < 4; ++i) {
      const float4 a = *(const float4*)(x1 + i * 128), g4 = *(const float4*)(ga + i * 128);
      xf[i * 4] = a.x + g4.x * fs[i * 4]; xf[i * 4 + 1] = a.y + g4.y * fs[i * 4 + 1]; xf[i * 4 + 2] = a.z + g4.z * fs[i * 4 + 2]; xf[i * 4 + 3] = a.w + g4.w * fs[i * 4 + 3];
      s += xf[i * 4] * xf[i * 4] + xf[i * 4 + 1] * xf[i * 4 + 1] + xf[i * 4 + 2] * xf[i * 4 + 2] + xf[i * 4 + 3] * xf[i * 4 + 3];
    }
#pragma unroll
    for (int o = 32; o > 0; o >>= 1) s += __shfl_xor(s, o);
    const float rs = rsqrtf(s * (1.f / 1024.f) + NORM_EPS);
#pragma unroll
    for (int i = 0; i < 4; ++i) {
      const float4 g4 = *(const float4*)(p.fng + k0 + i * 128);
      *(float4*)(p.out + (size_t)tok * 1024 + k0 + i * 128) = make_float4(xf[i * 4] * rs * g4.x, xf[i * 4 + 1] * rs * g4.y, xf[i * 4 + 2] * rs * g4.z, xf[i * 4 + 3] * rs * g4.w);
    }
  }
}


template <int PH>
__global__ void __launch_bounds__(NT, 2) phase_kernel(Params p) {
  __shared__ __attribute__((aligned(16))) unsigned char lds[LDS_BYTES];
  if (PH == 0) phase0(p, lds);
  if (PH == 1) { phase0b(p); phase1(p, lds); }
  if (PH == 2) phase2(p, lds);
  if (PH == 3) phase3(p, lds);
  if (PH == 4) phase4a(p, lds);
  if (PH == 5) phase4b(p, lds);
  if (PH == 6) phase5a(p);
  if (PH == 7) phase5b(p, lds);
  if (PH == 8) phase6(p, lds);
  if (PH == 9) phase7(p);
}

__global__ void __launch_bounds__(NT, 2) mega_kernel(Params p) {
  __shared__ __attribute__((aligned(16))) unsigned char lds[LDS_BYTES + 16];
  if (p.never) cg::this_grid().sync();
  volatile unsigned* st = (volatile unsigned*)(lds + LDS_BYTES);
  if (threadIdx.x == 0) { st[0] = 0u; st[1] = 0u; st[2] = 0u; st[3] = 0u; }
  __syncthreads();
  XcdBarrier b = xcd_barrier_post(p.bar, st);
  phase0(p, lds);  xcd_barrier(b);
  if (DUP == 0) { phase0(p, lds); xcd_barrier(b); }
  phase0b(p);      xcd_barrier(b);
  phase1(p, lds);  xcd_barrier(b);
  if (DUP == 1) { phase1(p, lds); xcd_barrier(b); }
  phase2(p, lds);  xcd_barrier(b);
  if (DUP == 2) { phase2(p, lds); xcd_barrier(b); }
  phase3(p, lds);  xcd_barrier(b);
  if (DUP == 3) { phase3(p, lds, 64, P3MODE); xcd_barrier(b); }
  phase4a(p, lds); xcd_barrier(b);
  if (DUP == 4) { phase4a(p, lds); xcd_barrier(b); }
  phase4b(p, lds); xcd_barrier(b);
  if (DUP == 5) { phase4b(p, lds); xcd_barrier(b); }
  phase5a(p);      xcd_barrier(b);
  if (DUP == 6) { phase5a(p); xcd_barrier(b); }
  phase5b(p, lds); xcd_barrier(b);
  if (DUP == 7) { phase5b(p, lds); xcd_barrier(b); }
  phase6(p, lds);  xcd_barrier(b);
  if (DUP == 8) { phase6(p, lds); xcd_barrier(b); }
  phase7(p);
  if (DUP == 9) { xcd_barrier(b); phase7(p); }
}

extern "C" void kernel_launch(void* const* d_in, const int* in_sizes, int n_in, void* d_out, int out_size, void* d_ws, size_t ws_size,
                              hipStream_t stream) {
  Params p;
  memset(&p, 0, sizeof(p));
  const float** f = (const float**)&p.xp;
  for (int i = 0; i < 41; ++i) f[i] = (const float*)d_in[i];
  p.out = (float*)d_out;
  unsigned char* w = (unsigned char*)d_ws;
  size_t off = 0;
  auto take = [&](size_t bytes) { unsigned char* r = w + off; off += (bytes + 255) & ~(size_t)255; return r; };
  p.bar = (unsigned*)take(XCD_BAR_WORDS * 4);
  p.TU = take((size_t)16384 * 512);
  p.TV = take((size_t)16384 * 512);
  p.SU = (float*)take(16384 * 4);
  p.SV = (float*)take(16384 * 4);
  p.WinT = (bfu*)take((size_t)2304 * 1024 * 2);
  p.WoutT = (bfu*)take((size_t)1024 * 1024 * 2);
  p.WqT = (bfu*)take((size_t)1024 * 1024 * 2);
  p.WgluT = (bfu*)take((size_t)512 * 512 * 2);
  p.K1 = (bfu*)take(65536 * 2);
  p.K2 = (bfu*)take(65536 * 2);
  p.mod = (float*)take((size_t)NSQ * 6144 * 4);
  p.rs1 = (float*)take(NTOK * 4);
  p.lbre = (float*)take(2048 * 4); p.lbim = (float*)take(2048 * 4);
  p.lbLre = (float*)take(2048 * 4); p.lbLim = (float*)take(2048 * 4);
  p.BBre = (float*)take(32768 * 4); p.BBim = (float*)take(32768 * 4);
  p.BON = (float*)take((size_t)NTOK * 8 * 4);
  p.BONX = (float*)take((size_t)NTOK * 8 * 4);
  p.w2T = (bfu*)take(512 * 64 * 2); p.a2T = (bfu*)take(512 * 64 * 2); p.g2T = (bfu*)take(512 * 128 * 2);
  p.BBh = (bfu*)take(32 * 128 * 16 * 2); p.CCh = (bfu*)take(32 * 16 * 128 * 2);
  p.E = (float*)take((size_t)8 * 32 * 32 * 128 * 4);
  unsigned char* regC = take((size_t)NTOK * INC * 2);
  p.PJ = (bfu*)regC; p.X1 = (float*)regC;
  unsigned char* regDE = take((size_t)NTOK * 1024 * 2);
  p.LD = (bfu*)regDE; p.AA = (bfu*)(regDE + (size_t)NTOK * 512 * 2); p.Q = (bfu*)regDE;
  unsigned char* regF = take((size_t)NTOK * 128 * 8);
  p.GG = (bfu*)regF; p.EI = (unsigned*)regF; p.EG = (float*)(regF + (size_t)NTOK * 128 * 4);
  unsigned char* regY = take((size_t)NTOK * 512 * 4);
  p.Y5 = (float*)regY; p.H2 = (bfu*)regY; p.H1 = (bfu*)regY; p.CAT = (bfu*)regDE;
  if (off > ws_size) { fprintf(stderr, "workspace too small: need %zu have %zu\n", off, ws_size); return; }
  p.never = 0;

  (void)hipMemsetAsync(p.bar, 0, XCD_BAR_WORDS * 4, stream);
  (void)hipMemsetAsync(p.mod, 0, (size_t)NSQ * 6144 * 4, stream);
#if MULTI
  const int G = 512;
  phase_kernel<0><<<G, NT, 0, stream>>>(p);
  phase_kernel<1><<<G, NT, 0, stream>>>(p);
  phase_kernel<2><<<G, NT, 0, stream>>>(p);
  phase_kernel<3><<<G, NT, 0, stream>>>(p);
  phase_kernel<4><<<G, NT, 0, stream>>>(p);
  phase_kernel<5><<<G, NT, 0, stream>>>(p);
  phase_kernel<6><<<G, NT, 0, stream>>>(p);
  phase_kernel<7><<<G, NT, 0, stream>>>(p);
  phase_kernel<8><<<G, NT, 0, stream>>>(p);
  phase_kernel<9><<<G, NT, 0, stream>>>(p);
#else
  static int grid_blocks = 0;
  if (!grid_blocks) {
    int dev = 0, cus = 0, per_cu = 0;
    hipGetDevice(&dev);
    hipDeviceGetAttribute(&cus, hipDeviceAttributeMultiprocessorCount, dev);
    hipOccupancyMaxActiveBlocksPerMultiprocessor(&per_cu, mega_kernel, NT, 0);
    if (per_cu > 2) per_cu = 2;
    if (per_cu < 1) per_cu = 1;
    grid_blocks = cus * per_cu;
  }
  void* args[] = {&p};
  hipError_t e = hipLaunchCooperativeKernel((void*)mega_kernel, dim3(grid_blocks), dim3(NT), args, 0, stream);
  if (e != hipSuccess) fprintf(stderr, "cooperative launch failed: %s (grid %d)\n", hipGetErrorString(e), grid_blocks);
#endif
}
```

```cpp
#include <hip/hip_runtime.h>
#include <hip/hip_cooperative_groups.h>
#include <stdint.h>
#include <stdio.h>
#include <string.h>
namespace cg = cooperative_groups;

#ifndef MULTI
#define MULTI 0
#endif
#ifndef DUP
#define DUP -1
#endif

typedef unsigned short bfu;
using bf16x8 = __attribute__((ext_vector_type(8))) short;
using f32x16 = __attribute__((ext_vector_type(16))) float;

constexpr int NTOK = 17408, NPT = 16384, NSQ = 136, DM = 1024, INC = 2304, RC = 1792;
constexpr int O_S5RE_P = 17825792, O_S5IM_P = 17842176, O_WKV_P = 17858560, O_SH_P = 18120704;
constexpr int O_S5RE_S = 18135040, O_S5IM_S = 18397184, O_WKV_S = 18659328, O_SH_S = 22853632;
constexpr float NORM_EPS = 1e-6f, GN_EPS = 64e-5f;
constexpr int NT = 256;
constexpr int LDS_BYTES = 75776;
constexpr int LDS_JOB = LDS_BYTES - 16;

struct Params {
  const float *xp, *xs, *s5re0, *s5im0, *wkv0, *shift0, *cp, *cs, *w_ada, *b_ada, *n1g, *n2g, *w_in, *w_out;
  const float *s5are, *s5aim, *s5ldt, *s5bre, *s5bim, *s5cre, *s5cim, *s5d, *w_glu, *b_glu;
  const float *mu, *w0, *w2, *a0, *a2, *g2, *k_k, *k_a, *r_k, *gn_w, *gn_b, *w_q, *keys1, *keys2, *pu, *pv, *fng;
  float* out;
  unsigned char *TU, *TV; float *SU, *SV;
  bfu *WinT, *WoutT, *WqT, *WgluT, *K1, *K2;
  float *mod, *rs1, *lbre, *lbim, *lbLre, *lbLim, *BBre, *BBim;
  bfu* PJ; float* X1; bfu *LD, *AA, *GG; float* Y5; bfu *Q, *H2; unsigned* EI; float* EG; float* BON; float* BONX; bfu *H1, *CAT; bfu *w2T, *a2T, *g2T, *BBh, *CCh; float* E;
  unsigned* bar;
  int never; int pad_;
};

__device__ __forceinline__ bfu f2bf(float f) { unsigned u = __float_as_uint(f); u += 0x7fffu + ((u >> 16) & 1u); return (bfu)(u >> 16); }
__device__ __forceinline__ float bf2f(bfu h) { return __uint_as_float(((unsigned)h) << 16); }
__device__ __forceinline__ unsigned pk2(float a, float b) { return (unsigned)f2bf(a) | ((unsigned)f2bf(b) << 16); }
__device__ __forceinline__ float bflo(unsigned u) { return __uint_as_float(u << 16); }
__device__ __forceinline__ float bfhi(unsigned u) { return __uint_as_float(u & 0xffff0000u); }
__device__ __forceinline__ int sq_of(int tok) { return tok < NPT ? (tok >> 11) : 8 + ((tok - NPT) >> 3); }
__device__ __forceinline__ int t_of(int tok) { return tok < NPT ? (tok & 2047) : ((tok - NPT) & 7); }
__device__ __forceinline__ const float* xrow(const Params& p, int tok) { return tok < NPT ? p.xp + (size_t)tok * DM : p.xs + (size_t)(tok - NPT) * DM; }
__device__ __forceinline__ float sigmoidf_(float x) { return 1.f / (1.f + __expf(-x)); }
__device__ __forceinline__ float gelu_(float x) { return 0.5f * x * (1.f + erff(x * 0.70710678118654752f)); }

#define XB_TMO 128
#define XB_XCNT(j) (256 + 64 * (j))
#define XB_XSUB(j) (1280 + 64 * (j))
#define XB_XGEN(j) (2304 + 64 * (j))
#define XB_TOP 3328
#define XB_TOPGEN 3392
#define XCD_BAR_WORDS 3456
#define XB_SPIN_CAP (1u << 22)
#define LAS __attribute__((address_space(3)))
__device__ __forceinline__ unsigned xb_ld(unsigned* p) { return __hip_atomic_load(p, __ATOMIC_RELAXED, __HIP_MEMORY_SCOPE_AGENT); }
__device__ __forceinline__ unsigned xb_add(unsigned* p, unsigned v) { return __hip_atomic_fetch_add(p, v, __ATOMIC_RELAXED, __HIP_MEMORY_SCOPE_AGENT); }
__device__ __forceinline__ unsigned xb_xcc_id() { return (unsigned)__builtin_amdgcn_s_getreg((3 << 11) | 20) & 0xFu; }
#define XB_SPIN(cond, bar) do { unsigned _sp = 0; while (cond) { __builtin_amdgcn_s_sleep(1); \
    if ((++_sp & 255u) == 0u) { if (xb_ld(&(bar)[XB_TMO])) break; if (_sp > XB_SPIN_CAP) { atomicAdd(&(bar)[XB_TMO], 1u); break; } } } } while (0)
struct XcdBarrier { unsigned* bar; unsigned x; volatile unsigned* st; };
__device__ __forceinline__ XcdBarrier xcd_barrier_post(unsigned* bar, volatile unsigned* st) {
  XcdBarrier b; b.bar = bar; b.x = xb_xcc_id(); b.st = st;
  if (threadIdx.x == 0) (void)xb_add(&bar[XB_XCNT(b.x)], 1u);
  return b;
}
__device__ __forceinline__ void xcd_barrier_complete(unsigned* bar, unsigned x, unsigned& nloc, unsigned& nx) {
  const unsigned G = gridDim.x;
  unsigned sum, cnt, mine, sp = 0u;
  for (;;) {
    sum = 0u; cnt = 0u; mine = 0u;
#pragma unroll
    for (unsigned j = 0; j < 16; ++j) { const unsigned c = xb_ld(&bar[XB_XCNT(j)]); sum += c; cnt += (c > 0u) ? 1u : 0u; mine = (j == x) ? c : mine; }
    if (sum == G) break;
    __builtin_amdgcn_s_sleep(1);
    if ((++sp & 255u) == 0u) { if (xb_ld(&bar[XB_TMO])) break; if (sp > XB_SPIN_CAP) { atomicAdd(&bar[XB_TMO], 1u); break; } }
  }
  nloc = mine > 0u ? mine : 1u; nx = cnt > 0u ? cnt : 1u;
}
__device__ __forceinline__ void xcd_barrier(const XcdBarrier& b) {
  asm volatile("s_waitcnt vmcnt(0)" ::: "memory");
  __syncthreads();
  if (threadIdx.x == 0) {
    unsigned* bar = b.bar;
    __builtin_amdgcn_s_waitcnt(0);
    unsigned nloc = b.st[0], nx = b.st[1];
    if (nloc == 0u) { xcd_barrier_complete(bar, b.x, nloc, nx); b.st[0] = nloc; b.st[1] = nx; }
    const unsigned old = xb_add(&bar[XB_XSUB(b.x)], 1u);
    const unsigned gen = old / nloc;
    if (old + 1u == (gen + 1u) * nloc) {
      __builtin_amdgcn_fence(__ATOMIC_RELEASE, "agent");
      asm volatile("s_waitcnt vmcnt(0)" ::: "memory");
      const unsigned og = xb_add(&bar[XB_TOP], 1u);
      const unsigned tg = og / nx;
      if (og + 1u == (tg + 1u) * nx) xb_add(&bar[XB_TOPGEN], 1u);
      else XB_SPIN(xb_ld(&bar[XB_TOPGEN]) == tg, bar);
      __builtin_amdgcn_fence(__ATOMIC_ACQUIRE, "agent");
      xb_add(&bar[XB_XGEN(b.x)], 1u);
      asm volatile("s_waitcnt vmcnt(0)" ::: "memory");
    } else {
      XB_SPIN(xb_ld(&bar[XB_XGEN(b.x)]) == gen, bar);
      __builtin_amdgcn_fence(__ATOMIC_ACQUIRE, "agent");
      asm volatile("s_waitcnt vmcnt(0)" ::: "memory");
    }
  }
  __syncthreads();
}

struct U4x4 { uint4 a, b, c, d; };
constexpr int GLD = 144;
template <int BM, class AL, class EP>
__device__ __forceinline__ void gemm_tile_t(int m0, int n0, int K, const bfu* __restrict__ Bt, AL al, EP ep, unsigned char* lds) {
  constexpr int BUF = 256 * GLD;
  constexpr int MI = BM / 64;
  const int tid = threadIdx.x, lane = tid & 63, wid = tid >> 6;
  const int wr = wid >> 1, wc = wid & 1;
  const int l31 = lane & 31, lh = lane >> 5;
  f32x16 acc[MI][2];
#pragma unroll
  for (int i = 0; i < MI; ++i)
#pragma unroll
    for (int j = 0; j < 2; ++j)
#pragma unroll
      for (int r = 0; r < 16; ++r) acc[i][j][r] = 0.f;
  const int srow = tid >> 1, sk = (tid & 1) * 32;
  const bool aon = srow < BM;
  uint4 av0, av1, av2, av3, bv0, bv1, bv2, bv3;
  auto gl = [&](int k0) {
    if (BM == 128 || aon) al(m0 + srow, k0 + sk, av0, av1, av2, av3);
    const uint4* bp = (const uint4*)(Bt + (size_t)(n0 + srow) * K + k0 + sk);
    bv0 = bp[0]; bv1 = bp[1]; bv2 = bp[2]; bv3 = bp[3];
  };
  auto st = [&](int buf) {
    uint4* da = (uint4*)(lds + buf * BUF + srow * GLD + sk * 2);
    uint4* db = (uint4*)(lds + buf * BUF + 128 * GLD + srow * GLD + sk * 2);
    if (BM == 128 || aon) { da[0] = av0; da[1] = av1; da[2] = av2; da[3] = av3; }
    db[0] = bv0; db[1] = bv1; db[2] = bv2; db[3] = bv3;
  };
  gl(0);
  __syncthreads();
  st(0);
  if (64 < K) gl(64);
  __syncthreads();
  const int nk = K >> 6;
  for (int kt = 0; kt < nk; ++kt) {
    const unsigned char* ldsA = lds + (kt & 1) * BUF;
    const unsigned char* ldsB = ldsA + 128 * GLD;
    if (kt + 1 < nk) st((kt + 1) & 1);
    if (kt + 2 < nk) gl((kt + 2) * 64);
#pragma unroll
    for (int s = 0; s < 4; ++s) {
      bf16x8 af[MI];
#pragma unroll
      for (int i = 0; i < MI; ++i) af[i] = *(const bf16x8*)(ldsA + (wr * (BM / 2) + i * 32 + l31) * GLD + s * 32 + lh * 16);
      const bf16x8 bf0 = *(const bf16x8*)(ldsB + (wc * 64 + l31) * GLD + s * 32 + lh * 16);
      const bf16x8 bf1 = *(const bf16x8*)(ldsB + (wc * 64 + 32 + l31) * GLD + s * 32 + lh * 16);
#pragma unroll
      for (int i = 0; i < MI; ++i) {
        acc[i][0] = __builtin_amdgcn_mfma_f32_32x32x16_bf16(af[i], bf0, acc[i][0], 0, 0, 0);
        acc[i][1] = __builtin_amdgcn_mfma_f32_32x32x16_bf16(af[i], bf1, acc[i][1], 0, 0, 0);
      }
    }
    __syncthreads();
  }
  {
    float* ct = (float*)lds;
#pragma unroll
    for (int i = 0; i < MI; ++i)
#pragma unroll
      for (int j = 0; j < 2; ++j)
#pragma unroll
        for (int r = 0; r < 16; ++r)
          ct[(wr * (BM / 2) + i * 32 + (r & 3) + 8 * (r >> 2) + 4 * lh) * 132 + wc * 64 + j * 32 + l31] = acc[i][j][r];
    __syncthreads();
#pragma unroll 4
    for (int it = 0; it < BM / 8; ++it) {
      const int idx = it * NT + tid, rl = idx >> 5, c4 = (idx & 31) * 4;
      ep(m0 + rl, n0 + c4, *(const float4*)(ct + rl * 132 + c4));
    }
  }
  __syncthreads();
}
template <class AL, class EP>
__device__ __forceinline__ void gemm_tile(int m0, int n0, int K, const bfu* __restrict__ Bt, AL al, EP ep, unsigned char* lds) {
  gemm_tile_t<128>(m0, n0, K, Bt, al, ep, lds);
}
template <class F128, class F64>
__device__ __forceinline__ void tiles_with_half_tail(int ntn, int tailm, F128 f128, F64 f64) {
  const int full = (136 - tailm) * ntn, total = full + tailm * 2 * ntn;
  for (int t = blockIdx.x; t < total; t += gridDim.x) {
    if (t < full) f128((t / ntn) * 128, (t % ntn) * 128);
    else { const int u = t - full; f64((136 - tailm) * 128 + (u / ntn) * 64, (u % ntn) * 128); }
  }
}

__device__ void phase0(const Params& p, unsigned char* lds) {
  const int tid = threadIdx.x, G = gridDim.x, gtid = blockIdx.x * NT + tid, gsz = G * NT;
  {
    const int lane = tid & 63, l31 = lane & 31, gw = gtid >> 6, nw = gsz >> 6;
    for (int rp = gw; rp < 16384; rp += nw) {
      const int r = rp * 2 + (lane >> 5);
      const bool isv = r >= 16384;
      const int row = r & 16383;
      const float4* src = (const float4*)((isv ? p.pv : p.pu) + (size_t)row * 1024 + l31 * 4);
      float x[32];
#pragma unroll
      for (int i = 0; i < 8; ++i) { const float4 v = src[i * 32]; x[i * 4] = v.x; x[i * 4 + 1] = v.y; x[i * 4 + 2] = v.z; x[i * 4 + 3] = v.w; }
      float m = 0.f;
#pragma unroll
      for (int i = 0; i < 32; ++i) m = fmaxf(m, fabsf(x[i]));
#pragma unroll
      for (int o = 16; o > 0; o >>= 1) m = fmaxf(m, __shfl_xor(m, o));
      {
        const float sc4 = m > 0.f ? 6.f / m : 1.f;
        unsigned wq[4] = {0u, 0u, 0u, 0u};
#pragma unroll
        for (int i = 0; i < 32; ++i) {
          const float a_ = fabsf(x[i]) * sc4;
          const unsigned code = (unsigned)(a_ >= 0.25f) + (unsigned)(a_ >= 0.75f) + (unsigned)(a_ >= 1.25f) + (unsigned)(a_ >= 1.75f) +
                                (unsigned)(a_ >= 2.5f) + (unsigned)(a_ >= 3.5f) + (unsigned)(a_ >= 5.f);
          wq[i >> 3] |= (code | (x[i] < 0.f ? 8u : 0u)) << (4 * (i & 7));
        }
        *(uint4*)((isv ? p.TV : p.TU) + (size_t)row * 512 + l31 * 16) = make_uint4(wq[0], wq[1], wq[2], wq[3]);
        if (l31 == 0) (isv ? p.SV : p.SU)[row] = m > 0.f ? m * (1.f / 6.f) : 1.f;
        continue;
      }
      const float sc = m > 0.f ? 7.5f / m : 1.f;
      unsigned long long w0 = 0ull, w1 = 0ull, w2 = 0ull;
#pragma unroll
      for (int i = 0; i < 32; ++i) {
        const float a_ = fminf(fabsf(x[i]) * sc, 7.5f);
        int code;
        if (a_ < 2.f) code = __float2int_rn(a_ * 8.f);
        else if (a_ < 4.f) code = 8 + __float2int_rn(a_ * 4.f);
        else code = 16 + __float2int_rn(a_ * 2.f);
        code = min(code, 31);
        const unsigned long long c6 = (unsigned long long)((unsigned)code | (x[i] < 0.f ? 32u : 0u));
        const int bit = 6 * i, wi = bit >> 6, sh = bit & 63;
        if (wi == 0) w0 |= c6 << sh; else if (wi == 1) w1 |= c6 << sh; else w2 |= c6 << sh;
        if (sh > 58) { if (wi == 0) w1 |= c6 >> (64 - sh); else if (wi == 1) w2 |= c6 >> (64 - sh); }
      }
      unsigned char* dst = p.TV + (size_t)row * 768;
      *(uint4*)(dst + l31 * 16) = make_uint4((unsigned)w0, (unsigned)(w0 >> 32), (unsigned)w1, (unsigned)(w1 >> 32));
      *(uint2*)(dst + 512 + l31 * 8) = make_uint2((unsigned)w2, (unsigned)(w2 >> 32));
      if (l31 == 0) p.SV[row] = m > 0.f ? m * (1.f / 7.5f) : 1.f;
    }
  }
  for (int i = gtid; i < 65536; i += gsz) { p.K1[i] = f2bf(p.keys1[i]); p.K2[i] = f2bf(p.keys2[i]); }
  {
    auto tr = [&](const float* __restrict__ src, bfu* __restrict__ dst, const int K, const int N) {
      for (int i = gtid; i < N * (K / 8); i += gsz) {
        const int n = i % N, k8 = i / N;
        float v[8];
#pragma unroll
        for (int j = 0; j < 8; ++j) v[j] = src[(size_t)(k8 * 8 + j) * N + n];
        *(uint4*)(dst + (size_t)n * K + k8 * 8) = make_uint4(pk2(v[0], v[1]), pk2(v[2], v[3]), pk2(v[4], v[5]), pk2(v[6], v[7]));
      }
    };
    tr(p.w_in, p.WinT, 1024, 2304);
    tr(p.w_out, p.WoutT, 1024, 1024);
    tr(p.w_q, p.WqT, 1024, 1024);
    tr(p.w_glu, p.WgluT, 512, 512);
    tr(p.w2, p.w2T, 64, 512);
    tr(p.a2, p.a2T, 64, 512);
    tr(p.g2, p.g2T, 128, 512);
  }
  for (int i = gtid; i < 2048; i += gsz) {
    const int g = i >> 6;
    const float dt = expf(p.s5ldt[g]);
    const float lre = p.s5are[i], lim = p.s5aim[i];
    const float mag = expf(lre * dt), ang = lim * dt;
    float sn, cs; sincosf(ang, &sn, &cs);
    const float lbr = mag * cs, lbi = mag * sn;
    p.lbre[i] = lbr; p.lbim[i] = lbi;
    float pr = lbr, pi = lbi;
#pragma unroll
    for (int s = 0; s < 6; ++s) { const float nr = pr * pr - pi * pi, ni = 2.f * pr * pi; pr = nr; pi = ni; }
    p.lbLre[i] = pr; p.lbLim[i] = pi;
    const float den = lre * lre + lim * lim;
    const float nre = lbr - 1.f, nim = lbi;
    const float cr = (nre * lre + nim * lim) / den, ci = (nim * lre - nre * lim) / den;
#pragma unroll
    for (int h = 0; h < 16; ++h) {
      const float br = p.s5bre[i * 16 + h], bi = p.s5bim[i * 16 + h];
      p.BBh[(g * 128 + (i & 63)) * 16 + h] = f2bf(cr * br - ci * bi);
      p.BBh[(g * 128 + 64 + (i & 63)) * 16 + h] = f2bf(cr * bi + ci * br);
    }
  }
  for (int i = gtid; i < 32 * 16 * 64; i += gsz) {
    const int gh = i >> 6, k = i & 63;
    p.CCh[gh * 128 + k] = f2bf(p.s5cre[i]);
    p.CCh[gh * 128 + 64 + k] = f2bf(-p.s5cim[i]);
  }
  {
    bfu* sa = (bfu*)lds;
    const int lane = tid & 63, wid = tid >> 6, l31 = lane & 31, lh = lane >> 5;
    for (int it = blockIdx.x; it < 48 * 8; it += G) {
      const int slab = it >> 3, kp = it & 7;
      __syncthreads();
      for (int i = tid; i < 160 * 128; i += NT) {
        const int r = i >> 7, k = i & 127;
        float v = 0.f;
        if (r < 136) { const float c = r < 8 ? p.cp[r * 1024 + kp * 128 + k] : p.cs[(r - 8) * 1024 + kp * 128 + k]; v = c / (1.f + __expf(-c)); }
        sa[r * 136 + k] = f2bf(v);
      }
      __syncthreads();
      const int n0 = slab * 128 + wid * 32;
      f32x16 acc[5];
#pragma unroll
      for (int m = 0; m < 5; ++m)
#pragma unroll
        for (int r = 0; r < 16; ++r) acc[m][r] = 0.f;
#pragma unroll 2
      for (int ks = 0; ks < 8; ++ks) {
        const float* wp = p.w_ada + (size_t)(kp * 128 + ks * 16 + lh * 8) * 6144 + n0 + l31;
        float bw[8];
#pragma unroll
        for (int j = 0; j < 8; ++j) bw[j] = wp[(size_t)j * 6144];
        bf16x8 bfr;
#pragma unroll
        for (int j = 0; j < 8; ++j) bfr[j] = (short)f2bf(bw[j]);
#pragma unroll
        for (int m = 0; m < 5; ++m) {
          const bf16x8 af = *(const bf16x8*)((const unsigned char*)sa + (m * 32 + l31) * 272 + (ks * 16 + lh * 8) * 2);
          acc[m] = __builtin_amdgcn_mfma_f32_32x32x16_bf16(af, bfr, acc[m], 0, 0, 0);
        }
      }
      const float bb = kp == 0 ? p.b_ada[n0 + l31] : 0.f;
      float* mp = p.mod + (size_t)(4 * lh) * 6144 + n0 + l31;
#pragma unroll
      for (int m = 0; m < 5; ++m) {
#pragma unroll
        for (int r = 0; r < 16; ++r) {
          const int row0 = m * 32 + (r & 3) + 8 * (r >> 2);
          if (row0 + 4 * lh < 136) atomicAdd(mp + row0 * 6144, acc[m][r] + bb);
          if ((r & 3) == 3) __builtin_amdgcn_sched_barrier(0);
        }
      }
    }
    __syncthreads();
  }
}

__device__ void phase1(const Params& p, unsigned char* lds) {
  const int ntile = 136 * 18;
  for (int t = blockIdx.x; t < ntile; t += gridDim.x) {
    const int mt = t / 18, nt = t % 18;
    auto al = [&](int row, int k, uint4& o0, uint4& o1, uint4& o2, uint4& o3) {
      const uint4* s_ = (const uint4*)(p.H1 + (size_t)row * 1024 + k);
      o0 = s_[0]; o1 = s_[1]; o2 = s_[2]; o3 = s_[3];
    };
    auto ep = [&](int row, int col, float4 v) {
      *(uint2*)(p.PJ + (size_t)row * INC + col) = make_uint2(pk2(v.x, v.y), pk2(v.z, v.w));
      if (col >= 512) {
        if (row < NPT) { if ((row & 2047) == 2047) *(float4*)(p.out + O_SH_P + (row >> 11) * RC + col - 512) = v; }
        else { const int r = row - NPT; if ((r & 7) == 7) *(float4*)(p.out + O_SH_S + (r >> 3) * RC + col - 512) = v; }
      }
    };
    gemm_tile(mt * 128, nt * 128, 1024, p.WinT, al, ep, lds);
  }
}

struct Cx { float r, i; };
__device__ __forceinline__ Cx cfma(const Cx a, const Cx b, const Cx c) { Cx o; o.r = a.r * b.r - a.i * b.i + c.r; o.i = a.r * b.i + a.i * b.r + c.i; return o; }
using f32x4 = __attribute__((ext_vector_type(4))) float;
constexpr int HIMG = 272;
template <int MT, bool OUT>
__device__ __forceinline__ void s5_chunk(const Params& p, const int tok0, const int nvalid, const int g, Cx (&st)[2], const int Gend,
                                         unsigned char* himg, const int lane) {
  const int c = lane & 31, half = lane >> 5;
  Cx l1[2], l2[2], l3[2], l4[2];
#pragma unroll
  for (int s = 0; s < 2; ++s) {
    const int gp = g * 64 + 32 * s + c;
    l1[s].r = p.lbre[gp]; l1[s].i = p.lbim[gp];
    const Cx z = {0.f, 0.f};
    l2[s] = cfma(l1[s], l1[s], z); l3[s] = cfma(l2[s], l1[s], z); l4[s] = cfma(l2[s], l2[s], z);
  }
  bf16x8 bfr[4];
#pragma unroll
  for (int nt = 0; nt < 4; ++nt) bfr[nt] = *(const bf16x8*)(p.BBh + ((size_t)(g * 128 + 32 * nt + c)) * 16 + 8 * half);
  bf16x8 cfr[4];
  float dsk = 0.f;
  if (OUT) {
#pragma unroll
    for (int ks = 0; ks < 4; ++ks) cfr[ks] = *(const bf16x8*)(p.CCh + ((size_t)(g * 16 + (lane & 15))) * 128 + 32 * ks + 8 * (lane >> 4));
    dsk = p.s5d[g * 16 + (lane & 15)];
  }
  Cx endst[2] = {st[0], st[1]};
#pragma unroll
  for (int mt = 0; mt < MT; ++mt) {
    bf16x8 af;
#pragma unroll
    for (int j = 0; j < 8; ++j) af[j] = 0;
    if (32 * mt + c < nvalid) af = *(const bf16x8*)(p.PJ + (size_t)(tok0 + 32 * mt + c) * INC + g * 16 + 8 * half);
#pragma unroll
    for (int s = 0; s < 2; ++s) {
      f32x16 bre, bim;
#pragma unroll
      for (int r = 0; r < 16; ++r) { bre[r] = 0.f; bim[r] = 0.f; }
      bre = __builtin_amdgcn_mfma_f32_32x32x16_bf16(af, bfr[s], bre, 0, 0, 0);
      bim = __builtin_amdgcn_mfma_f32_32x32x16_bf16(af, bfr[2 + s], bim, 0, 0, 0);
      Cx e[4], pe[4];
#pragma unroll
      for (int q = 0; q < 4; ++q) {
        Cx x; x.r = bre[4 * q]; x.i = bim[4 * q];
#pragma unroll
        for (int i = 1; i < 4; ++i) { Cx b_; b_.r = bre[4 * q + i]; b_.i = bim[4 * q + i]; x = cfma(l1[s], x, b_); bre[4 * q + i] = x.r; bim[4 * q + i] = x.i; }
        e[q] = x;
      }
#pragma unroll
      for (int q = 0; q < 4; ++q) { pe[q].r = __shfl_xor(e[q].r, 32); pe[q].i = __shfl_xor(e[q].i, 32); }
      Cx carry = st[s];
      Cx cin[4];
#pragma unroll
      for (int q = 0; q < 4; ++q) {
        const Cx ee = half ? pe[q] : e[q];
        const Cx eo = half ? e[q] : pe[q];
        const Cx cin_e = carry;
        carry = cfma(l4[s], carry, ee);
        if (8 * mt + 2 * q == Gend) endst[s] = carry;
        const Cx cin_o = carry;
        carry = cfma(l4[s], carry, eo);
        if (8 * mt + 2 * q + 1 == Gend) endst[s] = carry;
        cin[q] = half ? cin_o : cin_e;
      }
      st[s] = carry;
      if (OUT) {
        bfu* hi16 = (bfu*)himg;
#pragma unroll
        for (int q = 0; q < 4; ++q)
#pragma unroll
          for (int i = 0; i < 4; ++i) {
            const Cx lp = i == 0 ? l1[s] : (i == 1 ? l2[s] : (i == 2 ? l3[s] : l4[s]));
            Cx b_; b_.r = bre[4 * q + i]; b_.i = bim[4 * q + i];
            const Cx h = cfma(lp, cin[q], b_);
            const int tl = i + 8 * q + 4 * half;
            hi16[tl * (HIMG / 2) + 32 * s + c] = f2bf(h.r);
            hi16[tl * (HIMG / 2) + 64 + 32 * s + c] = f2bf(h.i);
          }
      }
    }
    if (OUT) {
      __builtin_amdgcn_wave_barrier();
#pragma unroll
      for (int rt = 0; rt < 2; ++rt) {
        f32x4 acc = {0.f, 0.f, 0.f, 0.f};
#pragma unroll
        for (int ks = 0; ks < 4; ++ks) {
          const bf16x8 a_ = *(const bf16x8*)(himg + (16 * rt + (lane & 15)) * HIMG + (32 * ks + 8 * (lane >> 4)) * 2);
          acc = __builtin_amdgcn_mfma_f32_16x16x32_bf16(a_, cfr[ks], acc, 0, 0, 0);
        }
#pragma unroll
        for (int r = 0; r < 4; ++r) {
          const int t = 32 * mt + 16 * rt + 4 * (lane >> 4) + r;
          if (t < nvalid) {
            const float u = bf2f(p.PJ[(size_t)(tok0 + t) * INC + g * 16 + (lane & 15)]);
            p.Y5[(size_t)(tok0 + t) * 512 + g * 16 + (lane & 15)] = gelu_(acc[r] + dsk * u);
          }
        }
      }
      __builtin_amdgcn_wave_barrier();
    }
  }
  st[0] = endst[0]; st[1] = endst[1];
}
__device__ void s5_pass_a(const Params& p) {
  const int lane = threadIdx.x & 63, gw = (blockIdx.x * NT + threadIdx.x) >> 6, nw = (gridDim.x * NT) >> 6;
  for (int job = gw; job < 8 * 32 * 32; job += nw) {
    const int c = job & 31, g = (job >> 5) & 31, b = job >> 10;
    Cx st[2] = {{0.f, 0.f}, {0.f, 0.f}};
    s5_chunk<2, false>(p, b * 2048 + c * 64, 64, g, st, 15, nullptr, lane);
    if (lane < 32) {
      float* e = p.E + (size_t)job * 128;
      e[lane] = st[0].r; e[32 + lane] = st[1].r; e[64 + lane] = st[0].i; e[96 + lane] = st[1].i;
    }
  }
}
__device__ void s5_job_c(const Params& p, int bj, bool prompt, unsigned char* lds) {
  const int lane = threadIdx.x & 63, wid = threadIdx.x >> 6;
  unsigned char* himg = lds + wid * (32 * HIMG);
  const int job = bj * 4 + wid;
  const int cc = lane & 31;
  if (prompt) {
    const int c = job & 31, g = (job >> 5) & 31, b = job >> 10;
    Cx L64[2], st[2];
#pragma unroll
    for (int s = 0; s < 2; ++s) { const int gp = g * 64 + 32 * s + cc; L64[s].r = p.lbLre[gp]; L64[s].i = p.lbLim[gp]; st[s].r = 0.f; st[s].i = 0.f; }
    const float* e = p.E + (size_t)(job - c) * 128;
    for (int j = 0; j < c; ++j) {
      Cx e0, e1;
      e0.r = e[j * 128 + cc]; e1.r = e[j * 128 + 32 + cc]; e0.i = e[j * 128 + 64 + cc]; e1.i = e[j * 128 + 96 + cc];
      st[0] = cfma(L64[0], st[0], e0); st[1] = cfma(L64[1], st[1], e1);
    }
    s5_chunk<2, true>(p, b * 2048 + c * 64, 64, g, st, 15, himg, lane);
    if (c == 31 && lane < 32) {
      float* o = p.out + O_S5RE_P + (b * 32 + g) * 64;
      o[lane] = st[0].r; o[32 + lane] = st[1].r;
      o = p.out + O_S5IM_P + (b * 32 + g) * 64;
      o[lane] = st[0].i; o[32 + lane] = st[1].i;
    }
  } else {
    const int g = job & 31, bs = job >> 5;
    Cx st[2];
    const float* r0 = p.s5re0 + ((size_t)bs * 32 + g) * 64;
    const float* i0 = p.s5im0 + ((size_t)bs * 32 + g) * 64;
    st[0].r = r0[cc]; st[1].r = r0[32 + cc]; st[0].i = i0[cc]; st[1].i = i0[32 + cc];
    s5_chunk<1, true>(p, NPT + bs * 8, 8, g, st, 1, himg, lane);
    if (lane < 32) {
      float* o = p.out + O_S5RE_S + ((size_t)bs * 32 + g) * 64;
      o[lane] = st[0].r; o[32 + lane] = st[1].r;
      o = p.out + O_S5IM_S + ((size_t)bs * 32 + g) * 64;
      o[lane] = st[0].i; o[32 + lane] = st[1].i;
    }
  }
}

__device__ __forceinline__ float tanh_fast(float x) { const float e = __expf(2.f * x); return 1.f - 2.f / (e + 1.f); }
template <int WHICH>
__device__ void lora_tiles(const Params& p, unsigned char* lds) {
  constexpr int base = WHICH == 0 ? 1536 : (WHICH == 1 ? 1600 : 1664);
  const int G_ = (int)gridDim.x;
  for (int t = (((int)blockIdx.x - WHICH * 544) % G_ + G_) % G_; t < 136 * 4; t += G_) {
    const int mt = t >> 2, nt = t & 3;
    auto al = [&](int row, int k, uint4& o0, uint4& o1, uint4& o2, uint4& o3) {
      const bfu* pc = p.PJ + (size_t)row * INC + 512 + base + k;
      const int tt = t_of(row);
      auto one = [&](int i) -> uint4 {
        const uint4 cu = *(const uint4*)(pc + i * 8);
        const float cur[8] = {bflo(cu.x), bfhi(cu.x), bflo(cu.y), bfhi(cu.y), bflo(cu.z), bfhi(cu.z), bflo(cu.w), bfhi(cu.w)};
        float prv[8];
        if (tt == 0) {
          if (row < NPT) {
#pragma unroll
            for (int j = 0; j < 8; ++j) prv[j] = 0.f;
          } else {
            const float4* s0 = (const float4*)(p.shift0 + (size_t)(sq_of(row) - 8) * RC + base + k + i * 8);
            const float4 a = s0[0], b_ = s0[1];
            prv[0] = a.x; prv[1] = a.y; prv[2] = a.z; prv[3] = a.w; prv[4] = b_.x; prv[5] = b_.y; prv[6] = b_.z; prv[7] = b_.w;
          }
        } else {
          const uint4 pu_ = *(const uint4*)(pc - INC + i * 8);
          prv[0] = bflo(pu_.x); prv[1] = bfhi(pu_.x); prv[2] = bflo(pu_.y); prv[3] = bfhi(pu_.y); prv[4] = bflo(pu_.z); prv[5] = bfhi(pu_.z); prv[6] = bflo(pu_.w); prv[7] = bfhi(pu_.w);
        }
        const float4 m0 = *(const float4*)(p.mu + base + k + i * 8), m1 = *(const float4*)(p.mu + base + k + i * 8 + 4);
        const float mm[8] = {m0.x, m0.y, m0.z, m0.w, m1.x, m1.y, m1.z, m1.w};
        float f[8];
#pragma unroll
        for (int j = 0; j < 8; ++j) {
          const float ps = cur[j] + (prv[j] - cur[j]) * mm[j];
          f[j] = WHICH == 0 ? tanh_fast(ps) : (WHICH == 1 ? ps : sigmoidf_(ps));
        }
        return make_uint4(pk2(f[0], f[1]), pk2(f[2], f[3]), pk2(f[4], f[5]), pk2(f[6], f[7]));
      };
      o0 = one(0); o1 = one(1); o2 = one(2); o3 = one(3);
    };
    auto ep = [&](int row, int col, float4 v4) {
      const size_t o = (size_t)row * 512 + col;
      const float v[4] = {v4.x, v4.y, v4.z, v4.w};
      float f[4];
      if (WHICH == 0) {
        const float4 w0 = *(const float4*)(p.w0 + col);
        const float ww[4] = {w0.x, w0.y, w0.z, w0.w};
#pragma unroll
        for (int j = 0; j < 4; ++j) {
          const float z = -(ww[j] + v[j]);
          const float sp = fmaxf(z, 0.f) + __logf(1.f + __expf(-fabsf(z)));
          f[j] = -__expf(-sp - 0.5f);
        }
        *(uint2*)(p.LD + o) = make_uint2(pk2(f[0], f[1]), pk2(f[2], f[3]));
      } else if (WHICH == 1) {
        const float4 a0 = *(const float4*)(p.a0 + col);
        const float aa[4] = {a0.x, a0.y, a0.z, a0.w};
#pragma unroll
        for (int j = 0; j < 4; ++j) f[j] = sigmoidf_(aa[j] + v[j]);
        *(uint2*)(p.AA + o) = make_uint2(pk2(f[0], f[1]), pk2(f[2], f[3]));
      } else {
        *(uint2*)(p.GG + o) = make_uint2(pk2(v[0], v[1]), pk2(v[2], v[3]));
      }
    };
    gemm_tile(mt * 128, nt * 128, WHICH == 2 ? 128 : 64, WHICH == 0 ? p.w2T : (WHICH == 1 ? p.a2T : p.g2T), al, ep, lds);
  }
}
__device__ void phase2(const Params& p, unsigned char* lds) {
  lora_tiles<0>(p, lds);
  lora_tiles<1>(p, lds);
  lora_tiles<2>(p, lds);
  s5_pass_a(p);
}

template <int CTRL>
__device__ __forceinline__ float dppf(float x) { return __uint_as_float((unsigned)__builtin_amdgcn_update_dpp(0, (int)__float_as_uint(x), CTRL, 0xf, 0xf, true)); }
template <int LPR>
__device__ __forceinline__ float red_lpr(float x) {
  x += dppf<0xB1>(x); x += dppf<0x4E>(x);
  if (LPR == 16) { x += dppf<0x141>(x); x += dppf<0x140>(x); }
  return x;
}
struct RwVec { float4 w, kk, b, k, r; };
template <int LPR, bool PROMPT>
__device__ void rwkv_job(const Params& p, int sq, int h, int rg, unsigned char* lds) {
  constexpr int ROWS = NT / LPR, KPL = 64 / LPR, NV = KPL / 4;
  constexpr int VA = 17 * 64, VSZ = 6 * VA;
  float* V0 = (float*)lds;
  float* Lyp = V0 + 2 * VSZ;
  const int tid = threadIdx.x;
  constexpr bool prompt = PROMPT;
  constexpr int T = PROMPT ? 2048 : 8;
  const int tokbase = prompt ? sq * 2048 : NPT + (sq - 8) * 8;
  const int row = tid / LPR, kq = tid % LPR;
  const int grow = rg * ROWS + row;
  float S[KPL];
  if (prompt) {
#pragma unroll
    for (int j = 0; j < KPL; ++j) S[j] = 0.f;
  } else {
    const float* s0 = p.wkv0 + (((size_t)(sq - 8) * 8 + h) * 64 + grow) * 64 + kq * KPL;
#pragma unroll
    for (int j = 0; j < NV; ++j) { const float4 v = ((const float4*)s0)[j]; S[j * 4] = v.x; S[j * 4 + 1] = v.y; S[j * 4 + 2] = v.z; S[j * 4 + 3] = v.w; }
  }
  const int tt = tid >> 4, kg = tid & 15, k4 = kg * 4;
  const int hc = h * 64 + k4;
  float mur[4], muk[4], muv[4], kkc[4], kac[4], rkc[4];
#pragma unroll
  for (int j = 0; j < 4; ++j) {
    mur[j] = p.mu[hc + j]; muk[j] = p.mu[512 + hc + j]; muv[j] = p.mu[1024 + hc + j];
    kkc[j] = p.k_k[hc + j]; kac[j] = p.k_a[hc + j]; rkc[j] = p.r_k[hc + j];
  }
  uint2 Acr, Ack, Acv, Aqr, Aqk, Aqv, Ald, Aaa;
  uint2 Bcr, Bck, Bcv, Bqr, Bqk, Bqv, Bld, Baa;
  auto gload = [&](int c0, uint2& cr, uint2& ck, uint2& cv, uint2& qr, uint2& qk, uint2& qv, uint2& ldv, uint2& aav) {
    const int cc0 = PROMPT ? min(c0, T - 16) : 0;
    const int nst = PROMPT ? 16 : 8;
    const int t = cc0 + (tt < nst ? tt : 0);
    const int tok = tokbase + t;
    const bfu* pc = p.PJ + (size_t)tok * INC + 512 + hc;
    const bfu* pp = pc - (t > 0 ? INC : 0);
    cr = *(const uint2*)(pc); ck = *(const uint2*)(pc + 512); cv = *(const uint2*)(pc + 1024);
    qr = *(const uint2*)(pp); qk = *(const uint2*)(pp + 512); qv = *(const uint2*)(pp + 1024);
    ldv = *(const uint2*)(p.LD + (size_t)tok * 512 + hc);
    aav = *(const uint2*)(p.AA + (size_t)tok * 512 + hc);
  };
  auto store_y_w = [&](int c0) {
    constexpr int nst = PROMPT ? 16 : 8;
    constexpr int RW = 64 / LPR;
    const int w_ = tid >> 6, ln = tid & 63;
    for (int q = ln; q < RW * nst; q += 64) {
      const int s = q / RW, rr = w_ * RW + q % RW;
      const float4* yp = (const float4*)(Lyp + (size_t)(s * ROWS + rr) * LPR);
      float y = 0.f;
#pragma unroll
      for (int j = 0; j < LPR / 4; ++j) { const float4 v = yp[j]; y += (v.x + v.y) + (v.z + v.w); }
      p.out[(size_t)(tokbase + c0 + s) * 1024 + 512 + h * 64 + rg * ROWS + rr] = y;
    }
  };
  auto stage_write = [&](int c0, int vb, uint2& cr, uint2& ck, uint2& cv, uint2& qr, uint2& qk, uint2& qv, uint2& ldv, uint2& aav) {
    float* Lr = V0 + vb * VSZ; float* Lw = Lr + VA; float* Lk = Lw + VA; float* Lkk = Lk + VA; float* Lb = Lkk + VA; float* Lv = Lb + VA;
    constexpr int nst = PROMPT ? 16 : 8;
    const bool act = PROMPT ? true : (tt < nst);
    const int cc0 = PROMPT ? min(c0, T - 16) : 0;
    const int t = cc0 + (act ? tt : 0);
    const int tok = tokbase + t;
    {
      float pr[4], pk_[4], pv_[4];
      if (t == 0) {
        if (prompt) {
#pragma unroll
          for (int j = 0; j < 4; ++j) pr[j] = pk_[j] = pv_[j] = 0.f;
        } else {
          const float* s0 = p.shift0 + (size_t)(sq - 8) * RC + hc;
#pragma unroll
          for (int j = 0; j < 4; ++j) { pr[j] = s0[j]; pk_[j] = s0[512 + j]; pv_[j] = s0[1024 + j]; }
        }
      } else {
        pr[0] = bflo(qr.x); pr[1] = bfhi(qr.x); pr[2] = bflo(qr.y); pr[3] = bfhi(qr.y);
        pk_[0] = bflo(qk.x); pk_[1] = bfhi(qk.x); pk_[2] = bflo(qk.y); pk_[3] = bfhi(qk.y);
        pv_[0] = bflo(qv.x); pv_[1] = bfhi(qv.x); pv_[2] = bflo(qv.y); pv_[3] = bfhi(qv.y);
      }
      const float c_r[4] = {bflo(cr.x), bfhi(cr.x), bflo(cr.y), bfhi(cr.y)};
      const float c_k[4] = {bflo(ck.x), bfhi(ck.x), bflo(ck.y), bfhi(ck.y)};
      const float c_v[4] = {bflo(cv.x), bfhi(cv.x), bflo(cv.y), bfhi(cv.y)};
      const float ld4[4] = {bflo(ldv.x), bfhi(ldv.x), bflo(ldv.y), bfhi(ldv.y)};
      const float aa4[4] = {bflo(aav.x), bfhi(aav.x), bflo(aav.y), bfhi(aav.y)};
      float r4[4], kx4[4], v4[4], w4[4], kk4[4];
      float ssq = 0.f, bon = 0.f;
#pragma unroll
      for (int j = 0; j < 4; ++j) {
        r4[j] = c_r[j] + (pr[j] - c_r[j]) * mur[j];
        const float kx = c_k[j] + (pk_[j] - c_k[j]) * muk[j];
        v4[j] = c_v[j] + (pv_[j] - c_v[j]) * muv[j];
        w4[j] = __expf(ld4[j]);
        kk4[j] = kx * kkc[j];
        ssq += kk4[j] * kk4[j];
        kx4[j] = kx * (1.f + (aa4[j] - 1.f) * kac[j]);
        bon += r4[j] * kx4[j] * rkc[j];
      }
      ssq = red_lpr<16>(ssq); bon = red_lpr<16>(bon);
      const float inv = rsqrtf(fmaxf(ssq, 1e-24f));
      if (act) {
        *(float4*)(Lr + tt * 64 + k4) = make_float4(r4[0], r4[1], r4[2], r4[3]);
        *(float4*)(Lw + tt * 64 + k4) = make_float4(w4[0], w4[1], w4[2], w4[3]);
        *(float4*)(Lk + tt * 64 + k4) = make_float4(kx4[0], kx4[1], kx4[2], kx4[3]);
        *(float4*)(Lkk + tt * 64 + k4) = make_float4(kk4[0] * inv, kk4[1] * inv, kk4[2] * inv, kk4[3] * inv);
        *(float4*)(Lb + tt * 64 + k4) = make_float4(kk4[0] * inv * aa4[0], kk4[1] * inv * aa4[1], kk4[2] * inv * aa4[2], kk4[3] * inv * aa4[3]);
        *(float4*)(Lv + tt * 64 + k4) = make_float4(v4[0], v4[1], v4[2], v4[3]);
        (rg == 0 ? p.BON : p.BONX)[(size_t)tok * 8 + h] = bon;
      }
    }
  };
  auto seqrun = [&](int vb) {
    const float* Lr = V0 + vb * VSZ; const float* Lw = Lr + VA; const float* Lk = Lw + VA; const float* Lkk = Lk + VA; const float* Lb = Lkk + VA; const float* Lv = Lb + VA;
    constexpr int nst = PROMPT ? 16 : 8;
    {
      auto ldvec = [&](int s, int j) -> RwVec {
        RwVec v;
        const int o = s * 64 + kq * KPL + j * 4;
        v.w = *(const float4*)(Lw + o); v.kk = *(const float4*)(Lkk + o); v.b = *(const float4*)(Lb + o);
        v.k = *(const float4*)(Lk + o); v.r = *(const float4*)(Lr + o);
        return v;
      };
      RwVec cur[NV];
      float vcur;
#pragma unroll
      for (int j = 0; j < NV; ++j) cur[j] = ldvec(0, j);
      vcur = Lv[grow];
      for (int s = 0; s < nst; ++s) {
        RwVec nxt[NV];
        float vnx;
#pragma unroll
        for (int j = 0; j < NV; ++j) nxt[j] = ldvec(s + 1, j);
        vnx = Lv[(s + 1) * 64 + grow];
        float sa0 = 0.f, sa1 = 0.f;
#pragma unroll
        for (int j = 0; j < NV; ++j) {
          sa0 += S[j * 4] * cur[j].kk.x; sa1 += S[j * 4 + 1] * cur[j].kk.y;
          sa0 += S[j * 4 + 2] * cur[j].kk.z; sa1 += S[j * 4 + 3] * cur[j].kk.w;
        }
        float tq[KPL];
#pragma unroll
        for (int j = 0; j < NV; ++j) {
          tq[j * 4] = S[j * 4] * cur[j].w.x + vcur * cur[j].k.x;
          tq[j * 4 + 1] = S[j * 4 + 1] * cur[j].w.y + vcur * cur[j].k.y;
          tq[j * 4 + 2] = S[j * 4 + 2] * cur[j].w.z + vcur * cur[j].k.z;
          tq[j * 4 + 3] = S[j * 4 + 3] * cur[j].w.w + vcur * cur[j].k.w;
        }
        float sa = -red_lpr<LPR>(sa0 + sa1);
        float y0 = 0.f, y1 = 0.f;
#pragma unroll
        for (int j = 0; j < NV; ++j) {
          S[j * 4] = tq[j * 4] + sa * cur[j].b.x;
          S[j * 4 + 1] = tq[j * 4 + 1] + sa * cur[j].b.y;
          S[j * 4 + 2] = tq[j * 4 + 2] + sa * cur[j].b.z;
          S[j * 4 + 3] = tq[j * 4 + 3] + sa * cur[j].b.w;
          y0 += S[j * 4] * cur[j].r.x; y1 += S[j * 4 + 1] * cur[j].r.y;
          y0 += S[j * 4 + 2] * cur[j].r.z; y1 += S[j * 4 + 3] * cur[j].r.w;
        }
        Lyp[(s * ROWS + row) * LPR + kq] = y0 + y1;
#pragma unroll
        for (int j = 0; j < NV; ++j) cur[j] = nxt[j];
        vcur = vnx;
      }
    }
  };
  gload(0, Acr, Ack, Acv, Aqr, Aqk, Aqv, Ald, Aaa);
  gload(16, Bcr, Bck, Bcv, Bqr, Bqk, Bqv, Bld, Baa);
  __syncthreads();
  stage_write(0, 0, Acr, Ack, Acv, Aqr, Aqk, Aqv, Ald, Aaa);
  gload(32, Acr, Ack, Acv, Aqr, Aqk, Aqv, Ald, Aaa);
  __syncthreads();
  for (int c0 = 0; c0 < T; c0 += 32) {
    seqrun(0);
    if (PROMPT) { stage_write(c0 + 16, 1, Bcr, Bck, Bcv, Bqr, Bqk, Bqv, Bld, Baa); gload(c0 + 48, Bcr, Bck, Bcv, Bqr, Bqk, Bqv, Bld, Baa); }
    store_y_w(c0);
    __syncthreads();
    if (PROMPT) {
      seqrun(1);
      stage_write(c0 + 32, 0, Acr, Ack, Acv, Aqr, Aqk, Aqv, Ald, Aaa); gload(c0 + 64, Acr, Ack, Acv, Aqr, Aqk, Aqv, Ald, Aaa);
      store_y_w(c0 + 16);
      __syncthreads();
    }
  }
  {
    float* so = p.out + (prompt ? O_WKV_P + (((size_t)sq * 8 + h) * 64 + grow) * 64 : O_WKV_S + (((size_t)(sq - 8) * 8 + h) * 64 + grow) * 64) + kq * KPL;
#pragma unroll
    for (int j = 0; j < NV; ++j) ((float4*)so)[j] = make_float4(S[j * 4], S[j * 4 + 1], S[j * 4 + 2], S[j * 4 + 3]);
  }
  __syncthreads();
}
__device__ void rwkv_post(const Params& p) {
  const int tid = threadIdx.x;
  const int h = (tid >> 4) & 7, kg = tid & 15, k4 = kg * 4, hc = h * 64 + k4;
  float muv[4], gnw[4], gnb[4];
#pragma unroll
  for (int j = 0; j < 4; ++j) { muv[j] = p.mu[1024 + hc + j]; gnw[j] = p.gn_w[hc + j]; gnb[j] = p.gn_b[hc + j]; }
  for (int it = blockIdx.x; it < NTOK / 2; it += gridDim.x) {
    const int tok = it * 2 + (tid >> 7);
    const int t = t_of(tok);
    const bfu* pc = p.PJ + (size_t)tok * INC + 512 + 1024 + hc;
    const uint2 cv = *(const uint2*)pc;
    float pv_[4];
    if (t == 0) {
      if (tok < NPT) { pv_[0] = pv_[1] = pv_[2] = pv_[3] = 0.f; }
      else { const float* s0 = p.shift0 + (size_t)(sq_of(tok) - 8) * RC + 1024 + hc; pv_[0] = s0[0]; pv_[1] = s0[1]; pv_[2] = s0[2]; pv_[3] = s0[3]; }
    } else {
      const uint2 qv = *(const uint2*)(pc - INC);
      pv_[0] = bflo(qv.x); pv_[1] = bfhi(qv.x); pv_[2] = bflo(qv.y); pv_[3] = bfhi(qv.y);
    }
    const float c_v[4] = {bflo(cv.x), bfhi(cv.x), bflo(cv.y), bfhi(cv.y)};
    float* yp = p.out + (size_t)tok * 1024 + 512 + hc;
    const float4 y4 = *(const float4*)yp;
    const float mean = red_lpr<16>(y4.x + y4.y + y4.z + y4.w) * (1.f / 64.f);
    const float dd[4] = {y4.x - mean, y4.y - mean, y4.z - mean, y4.w - mean};
    const float rstd = rsqrtf(red_lpr<16>(dd[0] * dd[0] + dd[1] * dd[1] + dd[2] * dd[2] + dd[3] * dd[3]) * (1.f / 64.f) + GN_EPS);
    const float bon = p.BON[(size_t)tok * 8 + h];
    const uint2 gv = *(const uint2*)(p.GG + (size_t)tok * 512 + hc);
    const float g4[4] = {bflo(gv.x), bfhi(gv.x), bflo(gv.y), bfhi(gv.y)};
    float o4[4];
#pragma unroll
    for (int j = 0; j < 4; ++j) {
      const float v = c_v[j] + (pv_[j] - c_v[j]) * muv[j];
      o4[j] = (dd[j] * rstd * gnw[j] + gnb[j] + bon * v) * g4[j];
    }
    *(uint2*)(p.CAT + (size_t)tok * 1024 + 512 + hc) = make_uint2(pk2(o4[0], o4[1]), pk2(o4[2], o4[3]));
  }
}

#ifndef P3MODE
#define P3MODE 0
#endif
__device__ void phase3(const Params& p, unsigned char* lds, int cw = 0, int mode = 0) {
  volatile int* jb = (volatile int*)(lds + LDS_JOB);
  for (;;) {
    __syncthreads();
    if (threadIdx.x == 0) *jb = (int)atomicAdd(&p.bar[cw], 1u);
    __syncthreads();
    const int j = *jb;
    if (j >= 256) break;
    if (mode != 1) rwkv_job<16, true>(p, j >> 5, (j >> 2) & 7, j & 3, lds);
  }
  for (;;) {
    __syncthreads();
    if (threadIdx.x == 0) *jb = (int)atomicAdd(&p.bar[cw + 1], 1u);
    __syncthreads();
    const int j = *jb;
    if (j >= 4096) break;
    if (j < 2048) { if (mode != 2) s5_job_c(p, j, true, lds); }
    else if (j < 3072) { const int q = j - 2048; if (mode != 1) rwkv_job<4, false>(p, 8 + (q >> 3), q & 7, 0, lds); }
    else { if (mode != 2) s5_job_c(p, j - 3072, false, lds); }
  }
}

__device__ void phase4a(const Params& p, unsigned char* lds) {
  rwkv_post(p);
  {
    auto al = [&](int row, int k, uint4& o0, uint4& o1, uint4& o2, uint4& o3) {
      const float4* s = (const float4*)(p.Y5 + (size_t)row * 512 + k);
      auto one = [&](int i) -> uint4 { const float4 a = s[i * 2], b = s[i * 2 + 1]; return make_uint4(pk2(a.x, a.y), pk2(a.z, a.w), pk2(b.x, b.y), pk2(b.z, b.w)); };
      o0 = one(0); o1 = one(1); o2 = one(2); o3 = one(3);
    };
    auto ep = [&](int row, int col, float4 v) {
      const float4 y = *(const float4*)(p.Y5 + (size_t)row * 512 + col), bg = *(const float4*)(p.b_glu + col);
      *(uint2*)(p.CAT + (size_t)row * 1024 + col) = make_uint2(pk2(y.x * sigmoidf_(v.x + bg.x), y.y * sigmoidf_(v.y + bg.y)), pk2(y.z * sigmoidf_(v.z + bg.z), y.w * sigmoidf_(v.w + bg.w)));
    };
    tiles_with_half_tail(4, 8, [&](int m0, int n0) { gemm_tile_t<128>(m0, n0, 512, p.WgluT, al, ep, lds); },
                         [&](int m0, int n0) { gemm_tile_t<64>(m0, n0, 512, p.WgluT, al, ep, lds); });
  }
}
__device__ void phase4b(const Params& p, unsigned char* lds) {
  auto al = [&](int row, int k, uint4& o0, uint4& o1, uint4& o2, uint4& o3) {
    const uint4* s_ = (const uint4*)(p.CAT + (size_t)row * 1024 + k);
    o0 = s_[0]; o1 = s_[1]; o2 = s_[2]; o3 = s_[3];
  };
  auto ep = [&](int row, int col, float4 v) {
    const int sq = sq_of(row);
    const float4 x = *(const float4*)(xrow(p, row) + col), g = *(const float4*)(p.mod + (size_t)sq * 6144 + 2048 + col);
    *(float4*)(p.X1 + (size_t)row * 1024 + col) = make_float4(x.x + g.x * v.x, x.y + g.y * v.y, x.z + g.z * v.z, x.w + g.w * v.w);
  };
  tiles_with_half_tail(8, 8, [&](int m0, int n0) { gemm_tile_t<128>(m0, n0, 1024, p.WoutT, al, ep, lds); },
                       [&](int m0, int n0) { gemm_tile_t<64>(m0, n0, 1024, p.WoutT, al, ep, lds); });
}
template <bool FROMX>
__device__ void norm_rows(const Params& p, const float* __restrict__ gsrc, int sh_off, bfu* __restrict__ dst) {
  const int lane = threadIdx.x & 63, gw = (blockIdx.x * NT + threadIdx.x) >> 6, nw = (gridDim.x * NT) >> 6;
  for (int tok = gw; tok < NTOK; tok += nw) {
    const float* xr = FROMX ? xrow(p, tok) : p.X1 + (size_t)tok * 1024;
    const float* md = p.mod + (size_t)sq_of(tok) * 6144 + sh_off;
    float4 v[4];
    float s = 0.f;
#pragma unroll
    for (int i = 0; i < 4; ++i) { const float4 a = *(const float4*)(xr + lane * 16 + i * 4); v[i] = a; s += a.x * a.x + a.y * a.y + a.z * a.z + a.w * a.w; }
#pragma unroll
    for (int o = 32; o > 0; o >>= 1) s += __shfl_xor(s, o);
    const float rs = rsqrtf(s * (1.f / 1024.f) + NORM_EPS);
    float f[16];
#pragma unroll
    for (int i = 0; i < 4; ++i) {
      const int k = lane * 16 + i * 4;
      const float4 g4 = *(const float4*)(gsrc + k), sh = *(const float4*)(md + k), sc = *(const float4*)(md + 1024 + k);
      const float4 a = v[i];
      f[i * 4 + 0] = a.x * rs * g4.x * (1.f + sc.x) + sh.x;
      f[i * 4 + 1] = a.y * rs * g4.y * (1.f + sc.y) + sh.y;
      f[i * 4 + 2] = a.z * rs * g4.z * (1.f + sc.z) + sh.z;
      f[i * 4 + 3] = a.w * rs * g4.w * (1.f + sc.w) + sh.w;
    }
    uint4* d = (uint4*)(dst + (size_t)tok * 1024 + lane * 16);
    d[0] = make_uint4(pk2(f[0], f[1]), pk2(f[2], f[3]), pk2(f[4], f[5]), pk2(f[6], f[7]));
    d[1] = make_uint4(pk2(f[8], f[9]), pk2(f[10], f[11]), pk2(f[12], f[13]), pk2(f[14], f[15]));
  }
}
__device__ void phase0b(const Params& p) { norm_rows<true>(p, p.n1g, 0, p.H1); }
__device__ void phase5a(const Params& p) { norm_rows<false>(p, p.n2g, 3072, p.H2); }
__device__ void phase5b(const Params& p, unsigned char* lds) {
  auto al = [&](int row, int k, uint4& o0, uint4& o1, uint4& o2, uint4& o3) {
    const uint4* s = (const uint4*)(p.H2 + (size_t)row * 1024 + k);
    o0 = s[0]; o1 = s[1]; o2 = s[2]; o3 = s[3];
  };
  auto ep = [&](int row, int col, float4 v) { *(uint2*)(p.Q + (size_t)row * 1024 + col) = make_uint2(pk2(v.x, v.y), pk2(v.z, v.w)); };
  tiles_with_half_tail(8, 8, [&](int m0, int n0) { gemm_tile_t<128>(m0, n0, 1024, p.WqT, al, ep, lds); },
                       [&](int m0, int n0) { gemm_tile_t<64>(m0, n0, 1024, p.WqT, al, ep, lds); });
}

__device__ __forceinline__ void ins16(float (&L)[16], float x) {
#pragma unroll
  for (int j = 0; j < 16; ++j) { const float hi = fmaxf(L[j], x); x = fminf(L[j], x); L[j] = hi; }
}
__device__ __forceinline__ void ce_desc(float& a, float& b) { const float hi = fmaxf(a, b), lo = fminf(a, b); a = hi; b = lo; }
__device__ __forceinline__ void sort16_desc(float (&a)[16]) {
#pragma unroll
  for (int k = 2; k <= 16; k <<= 1)
#pragma unroll
    for (int j = k >> 1; j > 0; j >>= 1)
#pragma unroll
      for (int i = 0; i < 16; ++i) {
        const int l = i ^ j;
        if (l > i) {
          if ((i & k) == 0) ce_desc(a[i], a[l]);
          else ce_desc(a[l], a[i]);
        }
      }
}
__device__ __forceinline__ void merge16_desc(float (&L)[16], const float (&T)[16]) {
#pragma unroll
  for (int i = 0; i < 16; ++i) L[i] = fmaxf(L[i], T[15 - i]);
#pragma unroll
  for (int j = 8; j > 0; j >>= 1)
#pragma unroll
    for (int i = 0; i < 16; ++i) { const int l = i ^ j; if (l > i) ce_desc(L[i], L[l]); }
}
__device__ __forceinline__ void peer_side_top16(const Params& p, const bfu* __restrict__ keys, int tok, int h, int side, int lane, float (&L)[16]) {
  const int l31 = lane & 31, lh = lane >> 5;
  bf16x8 bq[4];
#pragma unroll
  for (int ks = 0; ks < 4; ++ks) bq[ks] = *(const bf16x8*)(p.Q + (size_t)tok * 1024 + h * 128 + side * 64 + ks * 16 + lh * 8);
#pragma unroll
  for (int nt = 0; nt < 4; ++nt) {
    f32x16 acc;
#pragma unroll
    for (int r = 0; r < 16; ++r) acc[r] = 0.f;
#pragma unroll
    for (int ks = 0; ks < 4; ++ks) {
      const bf16x8 ak = *(const bf16x8*)(keys + ((size_t)(h * 128 + nt * 32 + l31)) * 64 + ks * 16 + lh * 8);
      acc = __builtin_amdgcn_mfma_f32_32x32x16_bf16(ak, bq[ks], acc, 0, 0, 0);
    }
    float V[16];
#pragma unroll
    for (int r = 0; r < 16; ++r) {
      const unsigned n = (unsigned)(nt * 32 + (r & 3) + 8 * (r >> 2)) + 4u * (unsigned)lh;
      V[r] = __uint_as_float((__float_as_uint(acc[r]) & ~127u) | n);
    }
    sort16_desc(V);
    if (nt == 0) {
#pragma unroll
      for (int j = 0; j < 16; ++j) L[j] = V[j];
    } else merge16_desc(L, V);
  }
  float P[16];
#pragma unroll
  for (int j = 0; j < 16; ++j) P[j] = __shfl_xor(L[j], 32);
  merge16_desc(L, P);
}
__device__ void phase6(const Params& p, unsigned char* lds) {
  const int tid = threadIdx.x, lane = tid & 63, wid = tid >> 6;
  unsigned char* ib = lds + wid * (64 * 36);
  const int gw = (blockIdx.x * NT + tid) >> 6, nw = (gridDim.x * NT) >> 6;
  for (int job = gw; job < (NTOK / 32) * 8; job += nw) {
    const int tile = job >> 3, h = job & 7;
    const int tok = tile * 32 + (lane & 31);
    float L1[16], L2[16];
    peer_side_top16(p, p.K1, tok, h, 0, lane, L1);
    peer_side_top16(p, p.K2, tok, h, 1, lane, L2);
    {
      unsigned* iw = (unsigned*)(ib + lane * 36);
#pragma unroll
      for (int q = 0; q < 4; ++q) {
        iw[q] = (__float_as_uint(L1[q * 4]) & 127u) | ((__float_as_uint(L1[q * 4 + 1]) & 127u) << 8) | ((__float_as_uint(L1[q * 4 + 2]) & 127u) << 16) | ((__float_as_uint(L1[q * 4 + 3]) & 127u) << 24);
        iw[4 + q] = (__float_as_uint(L2[q * 4]) & 127u) | ((__float_as_uint(L2[q * 4 + 1]) & 127u) << 8) | ((__float_as_uint(L2[q * 4 + 2]) & 127u) << 16) | ((__float_as_uint(L2[q * 4 + 3]) & 127u) << 24);
      }
    }
    float C[16];
    {
      auto cand = [&](int i, int j) -> float {
        const float v = __uint_as_float(__float_as_uint(L1[i]) & ~127u) + __uint_as_float(__float_as_uint(L2[j]) & ~127u);
        return __uint_as_float((__float_as_uint(v) & ~255u) | (unsigned)(i * 16 + j));
      };
      float R[16];
#pragma unroll
      for (int j = 0; j < 16; ++j) { C[j] = cand(0, j); R[j] = j < 8 ? cand(1, j) : -3.0e38f; }
      merge16_desc(C, R);
      R[0] = cand(2, 0); R[1] = cand(2, 1); R[2] = cand(2, 2); R[3] = cand(2, 3); R[4] = cand(2, 4);
      R[5] = cand(3, 0); R[6] = cand(3, 1); R[7] = cand(3, 2); R[8] = cand(3, 3);
      R[9] = cand(4, 0); R[10] = cand(4, 1); R[11] = cand(4, 2);
      R[12] = cand(5, 0); R[13] = cand(5, 1); R[14] = cand(6, 0); R[15] = cand(6, 1);
      sort16_desc(R);
      merge16_desc(C, R);
      R[0] = cand(7, 0); R[1] = cand(7, 1);
#pragma unroll
      for (int i = 8; i < 16; ++i) R[i - 6] = cand(i, 0);
#pragma unroll
      for (int j = 10; j < 16; ++j) R[j] = -3.0e38f;
      sort16_desc(R);
      merge16_desc(C, R);
    }
    __builtin_amdgcn_wave_barrier();
    const float m = __uint_as_float(__float_as_uint(C[0]) & ~255u);
    float e[16], sum = 0.f;
    unsigned idx[16];
#pragma unroll
    for (int j = 0; j < 16; ++j) {
      const unsigned cb = __float_as_uint(C[j]);
      e[j] = __expf(__uint_as_float(cb & ~255u) - m);
      sum += e[j];
      const unsigned i1 = ib[lane * 36 + ((cb >> 4) & 15u)], i2 = ib[lane * 36 + 16 + (cb & 15u)];
      idx[j] = i1 * 128u + i2;
    }
    const float inv = 1.f / sum;
    if (lane < 32) {
      uint4* eo = (uint4*)(p.EI + (size_t)tok * 128 + h * 16);
      float4* go = (float4*)(p.EG + (size_t)tok * 128 + h * 16);
#pragma unroll
      for (int q = 0; q < 4; ++q) {
        eo[q] = make_uint4(idx[q * 4], idx[q * 4 + 1], idx[q * 4 + 2], idx[q * 4 + 3]);
        go[q] = make_float4(e[q * 4] * inv, e[q * 4 + 1] * inv, e[q * 4 + 2] * inv, e[q * 4 + 3] * inv);
      }
    }
    __builtin_amdgcn_wave_barrier();
  }
}

typedef float v32f __attribute__((ext_vector_type(32)));
typedef float v2f __attribute__((ext_vector_type(2)));
typedef unsigned v6u __attribute__((ext_vector_type(6)));
typedef __bf16 v2bf __attribute__((ext_vector_type(2)));
typedef __bf16 v32bf __attribute__((ext_vector_type(32)));
__device__ __forceinline__ v32f unpack_fp6(const uint4 a, const uint2 b) {
  v6u w; w[0] = a.x; w[1] = a.y; w[2] = a.z; w[3] = a.w; w[4] = b.x; w[5] = b.y;
  return __builtin_amdgcn_cvt_scalef32_pk32_f32_fp6(w, 1.0f);
}
__device__ void phase7(const Params& p) {
  const int lane = threadIdx.x & 63, l31 = lane & 31, half = lane >> 5;
  const int gw = (blockIdx.x * NT + threadIdx.x) >> 6, nw = (gridDim.x * NT) >> 6;
  for (int tok = gw; tok < NTOK; tok += nw) {
    unsigned hp16[16];
    {
      const uint2* hp = (const uint2*)(p.H2 + (size_t)tok * 1024 + l31 * 4);
#pragma unroll
      for (int i = 0; i < 8; ++i) { const uint2 a = hp[i * 32]; hp16[i * 2] = a.x; hp16[i * 2 + 1] = a.y; }
    }
    const unsigned ei0 = p.EI[(size_t)tok * 128 + lane] & 16383u, ei1 = p.EI[(size_t)tok * 128 + 64 + lane] & 16383u;
    const float eg0 = p.EG[(size_t)tok * 128 + lane] * p.SV[ei0], eg1 = p.EG[(size_t)tok * 128 + 64 + lane] * p.SV[ei1];
    const float su0 = p.SU[ei0], su1 = p.SU[ei1];
    float ff[32];
#pragma unroll
    for (int j = 0; j < 32; ++j) ff[j] = 0.f;
#pragma unroll 1
    for (int grp = 0; grp < 16; ++grp) {
      const unsigned eiv = grp < 8 ? ei0 : ei1;
      const float egv = grp < 8 ? eg0 : eg1;
      const float suv = grp < 8 ? su0 : su1;
      const int lb = (grp & 7) * 8;
      uint4 ua[4], va[4];
#pragma unroll
      for (int i = 0; i < 4; ++i) {
        const unsigned id = (unsigned)__shfl((int)eiv, lb + 2 * i + half);
        const unsigned char* ur = p.TU + (size_t)id * 512;
        const unsigned char* vr = p.TV + (size_t)id * 512;
        ua[i] = *(const uint4*)(ur + l31 * 16);
        va[i] = *(const uint4*)(vr + l31 * 16);
      }
      float part[4];
#pragma unroll
      for (int i = 0; i < 4; ++i) {
        const unsigned wq[4] = {ua[i].x, ua[i].y, ua[i].z, ua[i].w};
        float s0 = 0.f, s1 = 0.f;
#pragma unroll
        for (int d = 0; d < 4; ++d) {
          s0 = __builtin_amdgcn_fdot2_f32_bf16(__builtin_amdgcn_cvt_scalef32_pk_bf16_fp4(wq[d], 1.0f, 0), __builtin_bit_cast(v2bf, hp16[d * 4 + 0]), s0, false);
          s1 = __builtin_amdgcn_fdot2_f32_bf16(__builtin_amdgcn_cvt_scalef32_pk_bf16_fp4(wq[d], 1.0f, 1), __builtin_bit_cast(v2bf, hp16[d * 4 + 1]), s1, false);
          s0 = __builtin_amdgcn_fdot2_f32_bf16(__builtin_amdgcn_cvt_scalef32_pk_bf16_fp4(wq[d], 1.0f, 2), __builtin_bit_cast(v2bf, hp16[d * 4 + 2]), s0, false);
          s1 = __builtin_amdgcn_fdot2_f32_bf16(__builtin_amdgcn_cvt_scalef32_pk_bf16_fp4(wq[d], 1.0f, 3), __builtin_bit_cast(v2bf, hp16[d * 4 + 3]), s1, false);
        }
        part[i] = s0 + s1;
        __builtin_amdgcn_sched_barrier(0);
      }
      float r2[2], r1;
      {
        const bool h4 = lane & 16;
#pragma unroll
        for (int i = 0; i < 2; ++i) { const float keep = h4 ? part[i + 2] : part[i], send = h4 ? part[i] : part[i + 2]; r2[i] = keep + __shfl_xor(send, 16); }
        const bool h3 = lane & 8;
        { const float keep = h3 ? r2[1] : r2[0], send = h3 ? r2[0] : r2[1]; r1 = keep + __shfl_xor(send, 8); }
        r1 += dppf<0x141>(r1); r1 += dppf<0x4E>(r1); r1 += dppf<0xB1>(r1);
      }
      const int myI = ((lane >> 4) & 1) * 2 + ((lane >> 3) & 1);
      const int slot = lb + 2 * myI + half;
      const float gate = __shfl(egv, slot), su = __shfl(suv, slot);
      const float coef = gate * gelu_(r1 * su);
#pragma unroll
      for (int i = 0; i < 4; ++i) {
        const float c = __shfl(coef, (lane & 32) + ((i >> 1) & 1) * 16 + (i & 1) * 8);
        const unsigned wv[4] = {va[i].x, va[i].y, va[i].z, va[i].w};
#pragma unroll
        for (int d = 0; d < 4; ++d) {
          const v2f v0 = __builtin_amdgcn_cvt_scalef32_pk_f32_fp4(wv[d], 1.0f, 0);
          const v2f v1 = __builtin_amdgcn_cvt_scalef32_pk_f32_fp4(wv[d], 1.0f, 1);
          const v2f v2 = __builtin_amdgcn_cvt_scalef32_pk_f32_fp4(wv[d], 1.0f, 2);
          const v2f v3 = __builtin_amdgcn_cvt_scalef32_pk_f32_fp4(wv[d], 1.0f, 3);
          ff[d * 8 + 0] += c * v0[0]; ff[d * 8 + 1] += c * v0[1]; ff[d * 8 + 2] += c * v1[0]; ff[d * 8 + 3] += c * v1[1];
          ff[d * 8 + 4] += c * v2[0]; ff[d * 8 + 5] += c * v2[1]; ff[d * 8 + 6] += c * v3[0]; ff[d * 8 + 7] += c * v3[1];
        }
        __builtin_amdgcn_sched_barrier(0);
      }
    }
    float fs[16];
#pragma unroll
    for (int j = 0; j < 16; ++j) {
      const float mine = half ? ff[16 + j] : ff[j], other = half ? ff[j] : ff[16 + j];
      fs[j] = mine + __shfl_xor(other, 32);
    }
    const int k0 = half * 512 + l31 * 4;
    const float* x1 = p.X1 + (size_t)tok * 1024 + k0;
    const float* ga = p.mod + (size_t)sq_of(tok) * 6144 + 5120 + k0;
    float xf[16];
    float s = 0.f;
#pragma unroll
    for (int i = 0; i < 4; ++i) {
      const float4 a = *(const float4*)(x1 + i * 128), g4 = *(const float4*)(ga + i * 128);
      xf[i * 4] = a.x + g4.x * fs[i * 4]; xf[i * 4 + 1] = a.y + g4.y * fs[i * 4 + 1]; xf[i * 4 + 2] = a.z + g4.z * fs[i * 4 + 2]; xf[i * 4 + 3] = a.w + g4.w * fs[i * 4 + 3];
      s += xf[i * 4] * xf[i * 4] + xf[i * 4 + 1] * xf[i * 4 + 1] + xf[i * 4 + 2] * xf[i * 4 + 2] + xf[i * 4 + 3] * xf[i * 4 + 3];
    }
#pragma unroll
    for (int o = 32; o > 0; o >>= 1) s += __shfl_xor(s, o);
    const float rs = rsqrtf(s * (1.f / 1024.f) + NORM_EPS);
#pragma unroll
    for (int i = 0; i < 4; ++i) {
      const float4 g4 = *(const float4*)(p.fng + k0 + i * 128);
      *(float4*)(p.out + (size_t)tok * 1024 + k0 + i * 128) = make_float4(xf[i * 4] * rs * g4.x, xf[i * 4 + 1] * rs * g4.y, xf[i * 4 + 2] * rs * g4.z, xf[i * 4 + 3] * rs * g4.w);
    }
  }
}


template <int PH>
__global__ void __launch_bounds__(NT, 2) phase_kernel(Params p) {
  __shared__ __attribute__((aligned(16))) unsigned char lds[LDS_BYTES];
  if (PH == 0) phase0(p, lds);
  if (PH == 1) { phase0b(p); phase1(p, lds); }
  if (PH == 2) phase2(p, lds);
  if (PH == 3) phase3(p, lds);
  if (PH == 4) phase4a(p, lds);
  if (PH == 5) phase4b(p, lds);
  if (PH == 6) phase5a(p);
  if (PH == 7) phase5b(p, lds);
  if (PH == 8) phase6(p, lds);
  if (PH == 9) phase7(p);
}

__global__ void __launch_bounds__(NT, 2) mega_kernel(Params p) {
  __shared__ __attribute__((aligned(16))) unsigned char lds[LDS_BYTES + 16];
  if (p.never) cg::this_grid().sync();
  volatile unsigned* st = (volatile unsigned*)(lds + LDS_BYTES);
  if (threadIdx.x == 0) { st[0] = 0u; st[1] = 0u; st[2] = 0u; st[3] = 0u; }
  __syncthreads();
  XcdBarrier b = xcd_barrier_post(p.bar, st);
  phase0(p, lds);  xcd_barrier(b);
  if (DUP == 0) { phase0(p, lds); xcd_barrier(b); }
  phase0b(p);      xcd_barrier(b);
  phase1(p, lds);  xcd_barrier(b);
  if (DUP == 1) { phase1(p, lds); xcd_barrier(b); }
  phase2(p, lds);  xcd_barrier(b);
  if (DUP == 2) { phase2(p, lds); xcd_barrier(b); }
  phase3(p, lds);  xcd_barrier(b);
  if (DUP == 3) { phase3(p, lds, 64, P3MODE); xcd_barrier(b); }
  phase4a(p, lds); xcd_barrier(b);
  if (DUP == 4) { phase4a(p, lds); xcd_barrier(b); }
  phase4b(p, lds); xcd_barrier(b);
  if (DUP == 5) { phase4b(p, lds); xcd_barrier(b); }
  phase5a(p);      xcd_barrier(b);
  if (DUP == 6) { phase5a(p); xcd_barrier(b); }
  phase5b(p, lds); xcd_barrier(b);
  if (DUP == 7) { phase5b(p, lds); xcd_barrier(b); }
  phase6(p, lds);  xcd_barrier(b);
  if (DUP == 8) { phase6(p, lds); xcd_barrier(b); }
  phase7(p);
  if (DUP == 9) { xcd_barrier(b); phase7(p); }
}

extern "C" void kernel_launch(void* const* d_in, const int* in_sizes, int n_in, void* d_out, int out_size, void* d_ws, size_t ws_size,
                              hipStream_t stream) {
  Params p;
  memset(&p, 0, sizeof(p));
  const float** f = (const float**)&p.xp;
  for (int i = 0; i < 41; ++i) f[i] = (const float*)d_in[i];
  p.out = (float*)d_out;
  unsigned char* w = (unsigned char*)d_ws;
  size_t off = 0;
  auto take = [&](size_t bytes) { unsigned char* r = w + off; off += (bytes + 255) & ~(size_t)255; return r; };
  p.bar = (unsigned*)take(XCD_BAR_WORDS * 4);
  p.TU = take((size_t)16384 * 512);
  p.TV = take((size_t)16384 * 512);
  p.SU = (float*)take(16384 * 4);
  p.SV = (float*)take(16384 * 4);
  p.WinT = (bfu*)take((size_t)2304 * 1024 * 2);
  p.WoutT = (bfu*)take((size_t)1024 * 1024 * 2);
  p.WqT = (bfu*)take((size_t)1024 * 1024 * 2);
  p.WgluT = (bfu*)take((size_t)512 * 512 * 2);
  p.K1 = (bfu*)take(65536 * 2);
  p.K2 = (bfu*)take(65536 * 2);
  p.mod = (float*)take((size_t)NSQ * 6144 * 4);
  p.rs1 = (float*)take(NTOK * 4);
  p.lbre = (float*)take(2048 * 4); p.lbim = (float*)take(2048 * 4);
  p.lbLre = (float*)take(2048 * 4); p.lbLim = (float*)take(2048 * 4);
  p.BBre = (float*)take(32768 * 4); p.BBim = (float*)take(32768 * 4);
  p.BON = (float*)take((size_t)NTOK * 8 * 4);
  p.BONX = (float*)take((size_t)NTOK * 8 * 4);
  p.w2T = (bfu*)take(512 * 64 * 2); p.a2T = (bfu*)take(512 * 64 * 2); p.g2T = (bfu*)take(512 * 128 * 2);
  p.BBh = (bfu*)take(32 * 128 * 16 * 2); p.CCh = (bfu*)take(32 * 16 * 128 * 2);
  p.E = (float*)take((size_t)8 * 32 * 32 * 128 * 4);
  unsigned char* regC = take((size_t)NTOK * INC * 2);
  p.PJ = (bfu*)regC; p.X1 = (float*)regC;
  unsigned char* regDE = take((size_t)NTOK * 1024 * 2);
  p.LD = (bfu*)regDE; p.AA = (bfu*)(regDE + (size_t)NTOK * 512 * 2); p.Q = (bfu*)regDE;
  unsigned char* regF = take((size_t)NTOK * 128 * 8);
  p.GG = (bfu*)regF; p.EI = (unsigned*)regF; p.EG = (float*)(regF + (size_t)NTOK * 128 * 4);
  unsigned char* regY = take((size_t)NTOK * 512 * 4);
  p.Y5 = (float*)regY; p.H2 = (bfu*)regY; p.H1 = (bfu*)regY; p.CAT = (bfu*)regDE;
  if (off > ws_size) { fprintf(stderr, "workspace too small: need %zu have %zu\n", off, ws_size); return; }
  p.never = 0;

  (void)hipMemsetAsync(p.bar, 0, XCD_BAR_WORDS * 4, stream);
  (void)hipMemsetAsync(p.mod, 0, (size_t)NSQ * 6144 * 4, stream);
#if MULTI
  const int G = 512;
  phase_kernel<0><<<G, NT, 0, stream>>>(p);
  phase_kernel<1><<<G, NT, 0, stream>>>(p);
  phase_kernel<2><<<G, NT, 0, stream>>>(p);
  phase_kernel<3><<<G, NT, 0, stream>>>(p);
  phase_kernel<4><<<G, NT, 0, stream>>>(p);
  phase_kernel<5><<<G, NT, 0, stream>>>(p);
  phase_kernel<6><<<G, NT, 0, stream>>>(p);
  phase_kernel<7><<<G, NT, 0, stream>>>(p);
  phase_kernel<8><<<G, NT, 0, stream>>>(p);
  phase_kernel<9><<<G, NT, 0, stream>>>(p);
#else
  static int grid_blocks = 0;
  if (!grid_blocks) {
    int dev = 0, cus = 0, per_cu = 0;
    hipGetDevice(&dev);
    hipDeviceGetAttribute(&cus, hipDeviceAttributeMultiprocessorCount, dev);
    hipOccupancyMaxActiveBlocksPerMultiprocessor(&per_cu, mega_kernel, NT, 0);
    if (per_cu > 2) per_cu = 2;
    if (per_cu < 1) per_cu = 1;
    grid_blocks = cus * per_cu;
  }
  void* args[] = {&p};
  hipError_t e = hipLaunchCooperativeKernel((void*)mega_kernel, dim3(grid_blocks), dim3(NT), args, 0, stream);
  if (e != hipSuccess) fprintf(stderr, "cooperative launch failed: %s (grid %d)\n", hipGetErrorString(e), grid_blocks);
#endif
}
```
